# Optimizing an MI355X kernel written in HIP

```python
import math
import jax, jax.numpy as jnp
from jax import lax
import numpy as np

D_MODEL = 1024
BATCH = 8
SEQ = 8192
DEPTH = 4
DEC_BATCH = 8
DEC_SEQ = 4096
PAST_LEN = 128

HEAD_DIM = 64
CONV_WIDTH = D_MODEL // 2
CONV_K = 3
SWA_HEADS = D_MODEL // 128
SWA_KV_HEADS = SWA_HEADS // 4
WINDOW = 128
AX_HEADS = D_MODEL // 128
AX_KV_HEADS = AX_HEADS // 4
DIFF_HEADS = D_MODEL // 256
MEM_HEADS = 4
N_MEM = 256
GRID_W = 64
Q_BLOCK = 128
ROPE_THETA = 10000.0
EPS = 1e-6
NEG = -1e30

SWA_Q = SWA_HEADS * HEAD_DIM
SWA_KV = SWA_KV_HEADS * HEAD_DIM
AX_Q = AX_HEADS * HEAD_DIM
AX_KV = AX_KV_HEADS * HEAD_DIM
DIFF_QK = 2 * DIFF_HEADS * HEAD_DIM
DIFF_V = DIFF_HEADS * 2 * HEAD_DIM
MEM_WIDTH = MEM_HEADS * HEAD_DIM
MIX_WIDTH = CONV_WIDTH + SWA_Q + MEM_WIDTH
EVEN_SPLITS = (CONV_WIDTH, CONV_WIDTH, CONV_WIDTH, SWA_Q, SWA_KV, SWA_KV, MEM_WIDTH, MIX_WIDTH)
ODD_SPLITS = (AX_Q, AX_KV, AX_KV, DIFF_QK, DIFF_QK, DIFF_V, MEM_WIDTH, MIX_WIDTH)
IN_WIDTH = sum(EVEN_SPLITS)
N_EVEN = (DEPTH + 1) // 2
N_ODD = DEPTH // 2

kernel_name = 'hybrid_conv_swa_axial_diff_encoder'


def rms_norm(x, g):
    xf = x.astype(jnp.float32)
    y = xf * lax.rsqrt(jnp.mean(xf * xf, axis=-1, keepdims=True) + EPS)
    return (y * g.astype(jnp.float32)).astype(x.dtype)


def heads(t, n):
    return t.reshape(t.shape[:-1] + (n, t.shape[-1] // n))


def split_cols(u, sizes):
    idx = [int(i) for i in np.cumsum(sizes)[:-1]]
    return jnp.split(u, idx, axis=-1)


def rope_angles(pos, dim):
    inv = ROPE_THETA ** (-jnp.arange(0, dim, 2, dtype=jnp.float32) / dim)
    return pos.astype(jnp.float32)[:, None] * inv[None, :]


def apply_rope(x, ang):
    cos = jnp.cos(ang)[None, :, None, :].astype(x.dtype)
    sin = jnp.sin(ang)[None, :, None, :].astype(x.dtype)
    x1, x2 = jnp.split(x, 2, axis=-1)
    return jnp.concatenate([x1 * cos - x2 * sin, x2 * cos + x1 * sin], axis=-1)


def axial_rope(x, row_ang, col_ang):
    half = HEAD_DIM // 2
    return jnp.concatenate([apply_rope(x[..., :half], row_ang),
                            apply_rope(x[..., half:], col_ang)], axis=-1)


def sweep_query_blocks(fn, q):
    b, s = q.shape[:2]
    nb = s // Q_BLOCK
    qb = jnp.moveaxis(q.reshape((b, nb, Q_BLOCK) + q.shape[2:]), 1, 0)
    out = jnp.moveaxis(lax.map(fn, qb), 0, 1)
    return out.reshape((b, s) + out.shape[3:])


def short_conv(gb, gc, hc, w):
    inner = gc * hc
    p = jnp.pad(inner, ((0, 0), (1, 1), (0, 0)))
    conv = p[:, :-2] * w[0] + p[:, 1:-1] * w[1] + p[:, 2:] * w[2]
    return gb * conv


def window_attention(q, k, v, sink):
    b, s, h, d = q.shape
    hkv = k.shape[2]
    g = h // hkv
    nb = s // WINDOW
    qb = q.reshape(b, nb, WINDOW, hkv, g, d)

    def band(t):
        tp = jnp.pad(t.reshape(b, nb, WINDOW, hkv, d), ((0, 0), (1, 1), (0, 0), (0, 0), (0, 0)))
        return jnp.concatenate([tp[:, :-2], tp[:, 1:-1], tp[:, 2:]], axis=2)

    kb, vb = band(k), band(v)
    sc = jnp.einsum('bnqkgd,bnjkd->bnkgqj', qb, kb, preferred_element_type=jnp.float32) * (d ** -0.5)
    blk = jnp.arange(nb)[:, None, None]
    qpos = blk * WINDOW + jnp.arange(WINDOW)[None, :, None]
    kpos = (blk - 1) * WINDOW + jnp.arange(3 * WINDOW)[None, None, :]
    mask = (jnp.abs(qpos - kpos) <= WINDOW) & (kpos >= 0) & (kpos < s)
    sc = jnp.where(mask[None, :, None, None], sc, NEG)
    sink_l = jnp.broadcast_to(sink.astype(jnp.float32).reshape(1, 1, hkv, g, 1, 1), sc.shape[:-1] + (1,))
    p = jax.nn.softmax(jnp.concatenate([sc, sink_l], axis=-1), axis=-1)[..., :-1]
    o = jnp.einsum('bnkgqj,bnjkd->bnqkgd', p.astype(v.dtype), vb)
    return o.reshape(b, s, h * d)


def dense_gqa(q, k, v):
    b, s, h, d = q.shape
    hkv = k.shape[2]
    g = h // hkv
    scale = d ** -0.5

    def block(qi):
        sc = jnp.einsum('bqkgd,bskd->bkgqs', qi, k, preferred_element_type=jnp.float32) * scale
        p = jax.nn.softmax(sc, axis=-1).astype(v.dtype)
        return jnp.einsum('bkgqs,bskd->bqkgd', p, v)

    o = sweep_query_blocks(block, q.reshape(b, s, hkv, g, d))
    return o.reshape(b, s, h * d)


def diff_attention(q, k, v, lam_vec, subln_g, layer):
    b, s, h2, d = q.shape
    h = h2 // 2
    lambda_init = 0.8 - 0.6 * math.exp(-0.3 * layer)
    lv = lam_vec.astype(jnp.float32)
    lam = jnp.exp(jnp.sum(lv[0] * lv[1])) - jnp.exp(jnp.sum(lv[2] * lv[3])) + lambda_init
    scale = d ** -0.5

    def block(qi):
        sc = jnp.einsum('bqhd,bshd->bhqs', qi, k, preferred_element_type=jnp.float32) * scale
        p = jax.nn.softmax(sc, axis=-1).reshape(b, h, 2, qi.shape[1], s)
        a = p[:, :, 0] - lam * p[:, :, 1]
        return jnp.einsum('bhqs,bshe->bqhe', a.astype(v.dtype), v)

    o = sweep_query_blocks(block, q)
    o = rms_norm(o, subln_g) * (1.0 - lambda_init)
    return o.reshape(b, s, h * 2 * d)


def memory_attention(q, mk, mv):
    b, s, hm, d = q.shape
    sc = jnp.einsum('bqhd,bmhd->bhqm', q, mk, preferred_element_type=jnp.float32) * (d ** -0.5)
    p = jax.nn.softmax(sc, axis=-1).astype(mv.dtype)
    return jnp.einsum('bhqm,bmhd->bqhd', p, mv).reshape(b, s, hm * d)


def trunk(x, mem, norm_g, w_in, w_out, mem_norm_g, w_mem_kv, mem_qk_g, conv_w, swa_qk_g,
          swa_sink, ax_qk_g, diff_qk_g, diff_lambda, diff_subln_g):
    b, s, _ = x.shape
    rows = s // GRID_W
    ang_1d = rope_angles(jnp.arange(s), HEAD_DIM)
    row_ang = rope_angles(jnp.repeat(jnp.arange(rows), GRID_W), HEAD_DIM // 2)
    col_ang = rope_angles(jnp.tile(jnp.arange(GRID_W), rows), HEAD_DIM // 2)
    for l in range(DEPTH):
        h = rms_norm(x, norm_g[l])
        u = h @ w_in[l]
        mkv = rms_norm(mem, mem_norm_g[l]) @ w_mem_kv[l]
        mk, mv = jnp.split(mkv, 2, axis=-1)
        mk = rms_norm(heads(mk, MEM_HEADS), mem_qk_g[l, 1])
        mv = heads(mv, MEM_HEADS)
        if l % 2 == 0:
            e = l // 2
            gb, gc, hc, q, k, v, mq, z = split_cols(u, EVEN_SPLITS)
            y1 = short_conv(gb, gc, hc, conv_w[e])
            q = apply_rope(rms_norm(heads(q, SWA_HEADS), swa_qk_g[e, 0]), ang_1d)
            k = apply_rope(rms_norm(heads(k, SWA_KV_HEADS), swa_qk_g[e, 1]), ang_1d)
            y2 = window_attention(q, k, heads(v, SWA_KV_HEADS), swa_sink[e])
        else:
            o = l // 2
            q, k, v, dq, dk, dv, mq, z = split_cols(u, ODD_SPLITS)
            q = axial_rope(rms_norm(heads(q, AX_HEADS), ax_qk_g[o, 0]), row_ang, col_ang)
            k = axial_rope(rms_norm(heads(k, AX_KV_HEADS), ax_qk_g[o, 1]), row_ang, col_ang)
            y1 = dense_gqa(q, k, heads(v, AX_KV_HEADS))
            dq = apply_rope(rms_norm(heads(dq, 2 * DIFF_HEADS), diff_qk_g[o, 0]), ang_1d)
            dk = apply_rope(rms_norm(heads(dk, 2 * DIFF_HEADS), diff_qk_g[o, 1]), ang_1d)
            y2 = diff_attention(dq, dk, heads(dv, DIFF_HEADS), diff_lambda[o], diff_subln_g[o], l)
        mq = rms_norm(heads(mq, MEM_HEADS), mem_qk_g[l, 0])
        ym = memory_attention(mq, mk, mv)
        y = jnp.concatenate([y1, y2, ym], axis=-1)
        x = x + (y * jax.nn.silu(z)) @ w_out[l]
    return x


def setup_inputs(seed: int = 0) -> dict:
    key = jax.random.key(seed)
    ks = jax.random.split(key, 18)
    f32 = jnp.float32
    nrm = lambda k, shp, sc: jax.random.normal(k, shp, f32) * sc
    gain = lambda k, shp: 1.0 + 0.02 * jax.random.normal(k, shp, f32)
    return {
        'x_prompt': nrm(ks[0], (BATCH, SEQ, D_MODEL), 1.0),
        'x_sample': nrm(ks[1], (DEC_BATCH, DEC_SEQ, D_MODEL), 1.0),
        'mem_prompt': nrm(ks[2], (BATCH, N_MEM, D_MODEL), 1.0),
        'mem_sample': nrm(ks[3], (DEC_BATCH, N_MEM, D_MODEL), 1.0),
        'norm_g': gain(ks[4], (DEPTH, D_MODEL)),
        'w_in': nrm(ks[5], (DEPTH, D_MODEL, IN_WIDTH), D_MODEL ** -0.5),
        'w_out': nrm(ks[6], (DEPTH, MIX_WIDTH, D_MODEL), MIX_WIDTH ** -0.5),
        'mem_norm_g': gain(ks[7], (DEPTH, D_MODEL)),
        'w_mem_kv': nrm(ks[8], (DEPTH, D_MODEL, 2 * MEM_WIDTH), D_MODEL ** -0.5),
        'mem_qk_g': gain(ks[9], (DEPTH, 2, HEAD_DIM)),
        'conv_w': nrm(ks[10], (N_EVEN, CONV_K, CONV_WIDTH), CONV_K ** -0.5),
        'swa_qk_g': gain(ks[11], (N_EVEN, 2, HEAD_DIM)),
        'swa_sink': nrm(ks[12], (N_EVEN, SWA_HEADS), 0.5),
        'ax_qk_g': gain(ks[13], (N_ODD, 2, HEAD_DIM)),
        'diff_qk_g': gain(ks[14], (N_ODD, 2, HEAD_DIM)),
        'diff_lambda': nrm(ks[15], (N_ODD, 4, HEAD_DIM), 0.1),
        'diff_subln_g': gain(ks[16], (N_ODD, 2 * HEAD_DIM)),
    }


def reference(x_prompt, x_sample, mem_prompt, mem_sample, norm_g, w_in, w_out, mem_norm_g,
              w_mem_kv, mem_qk_g, conv_w, swa_qk_g, swa_sink, ax_qk_g, diff_qk_g,
              diff_lambda, diff_subln_g):
    y_prompt = trunk(x_prompt, mem_prompt, norm_g, w_in, w_out, mem_norm_g, w_mem_kv, mem_qk_g,
                     conv_w, swa_qk_g, swa_sink, ax_qk_g, diff_qk_g, diff_lambda, diff_subln_g)
    y_sample = trunk(x_sample, mem_sample, norm_g, w_in, w_out, mem_norm_g, w_mem_kv, mem_qk_g,
                     conv_w, swa_qk_g, swa_sink, ax_qk_g, diff_qk_g, diff_lambda, diff_subln_g)
    return (y_prompt, y_sample)
```

```cpp
#include <hip/hip_runtime.h>
#include <hip/hip_cooperative_groups.h>
#include <cstdint>
#include <cstdio>
namespace cg = cooperative_groups;

#ifndef MULTI_LAUNCH
#define MULTI_LAUNCH 0
#endif

#define DI __device__ __forceinline__
#define LAS __attribute__((address_space(3)))
typedef unsigned short bf16_t;
typedef short bf16x8 __attribute__((ext_vector_type(8)));
typedef short s16x4 __attribute__((ext_vector_type(4)));
typedef float f32x16 __attribute__((ext_vector_type(16)));
typedef float f32x4 __attribute__((ext_vector_type(4)));
typedef unsigned u32x4 __attribute__((ext_vector_type(4)));
typedef unsigned u32x2 __attribute__((ext_vector_type(2)));

constexpr int NTOK = 98304, NTOKP = 65536, UW = 3840, DM = 1024, MIXW = 1280;
constexpr int NTHREADS = 256;
constexpr int LDS_BYTES = 65536;
constexpr float EPSF = 1e-6f;
constexpr float LOG2E = 1.4426950408889634f;
constexpr int NPHASE = 16;

struct Params {
  const float *xp, *xs, *memp, *mems, *norm_g, *w_in, *w_out, *mem_norm_g, *w_mem_kv, *mem_qk_g, *conv_w, *swa_qk_g,
      *swa_sink, *ax_qk_g, *diff_qk_g, *diff_lambda, *diff_subln_g;
  float* out;
  bf16_t *u, *xb, *wt_in, *wt_out, *wt_mem, *memb, *memkv;
  float *rstd, *rstd_mem, *tab1c, *tab1s, *tabac, *tabas, *lam;
  int phase_lo, phase_hi;
};

DI unsigned cvtpk(float lo, float hi) { unsigned r; asm("v_cvt_pk_bf16_f32 %0, %1, %2" : "=v"(r) : "v"(lo), "v"(hi)); return r; }
DI float bf2f(unsigned short b) { return __uint_as_float(((unsigned)b) << 16); }
DI float bflo(unsigned w) { return __uint_as_float(w << 16); }
DI float bfhi(unsigned w) { return __uint_as_float(w & 0xffff0000u); }
DI int ltid() { int t; asm volatile("v_mov_b32 %0, %1" : "=v"(t) : "v"(threadIdx.x)); return t; }
DI int crow(int i, int h) { return (i & 3) + 8 * (i >> 2) + 4 * h; }
DI float swapmax(float v) { auto rr = __builtin_amdgcn_permlane32_swap(__float_as_uint(v), __float_as_uint(v), false, false); return fmaxf(__uint_as_float(rr[0]), __uint_as_float(rr[1])); }
DI float swapsum(float v) { auto rr = __builtin_amdgcn_permlane32_swap(__float_as_uint(v), __float_as_uint(v), false, false); return __uint_as_float(rr[0]) + __uint_as_float(rr[1]); }
DI float silu(float z) { return z / (1.f + __expf(-z)); }
#define MFMA32(a, b, c) __builtin_amdgcn_mfma_f32_32x32x16_bf16((a), (b), (c), 0, 0, 0)

DI void tok_info(int t, int& S, int& seq0, int& pos, int& sq) {
  if (t < NTOKP) { S = 8192; seq0 = t & ~8191; pos = t & 8191; sq = t >> 13; }
  else { int tt = t - NTOKP; S = 4096; seq0 = NTOKP + (tt & ~4095); pos = tt & 4095; sq = 8 + (tt >> 12); }
}

DI void transpose_tile(char* lds, const float* src, const float* g, bf16_t* dst, int K, int N, int k0, int n0) {
  float* tile = (float*)lds;
  const int tid = ltid(), a = tid >> 6, b = tid & 63;
#pragma unroll 4
  for (int i = 0; i < 16; ++i) { int kk = i * 4 + a; float v = src[(size_t)(k0 + kk) * N + n0 + b]; if (g) v *= g[k0 + kk]; tile[kk * 65 + b] = v; }
  __syncthreads();
#pragma unroll 4
  for (int i = 0; i < 16; ++i) { int nn = i * 4 + a; float v = tile[b * 65 + nn]; dst[(size_t)(n0 + nn) * K + k0 + b] = (bf16_t)(cvtpk(v, v) & 0xffffu); }
  __syncthreads();
}

DI void norm_rows(const float* src, bf16_t* dst, float* rstd, int row_begin, int row_end, int gw, int nw) {
  const int lane = ltid() & 63;
  for (int row = row_begin + gw; row < row_end; row += nw) {
    const float* s = src + (size_t)(row - row_begin) * DM; bf16_t* d = dst + (size_t)row * DM;
    f32x4 v[4]; float ss = 0.f;
#pragma unroll
    for (int j = 0; j < 4; ++j) { v[j] = *(const f32x4*)(s + (lane + 64 * j) * 4); ss += v[j][0] * v[j][0] + v[j][1] * v[j][1] + v[j][2] * v[j][2] + v[j][3] * v[j][3]; }
#pragma unroll
    for (int o = 32; o > 0; o >>= 1) ss += __shfl_xor(ss, o);
#pragma unroll
    for (int j = 0; j < 4; ++j) { u32x2 w; w.x = cvtpk(v[j][0], v[j][1]); w.y = cvtpk(v[j][2], v[j][3]); *(u32x2*)(d + (lane + 64 * j) * 4) = w; }
    if (lane == 0) rstd[row] = rsqrtf(ss * (1.f / DM) + EPSF);
  }
}

DI void phase_prep(char* lds, const Params& p) {
  const int T_IN = 4 * 16 * 60, T_OUT = 4 * 20 * 16, T_MEM = 4 * 16 * 8;
  for (int t = blockIdx.x; t < T_IN + T_OUT + T_MEM; t += gridDim.x) {
    if (t < T_IN) { int l = t / 960, r = t % 960, kt = r / 60, nt = r % 60;
      transpose_tile(lds, p.w_in + (size_t)l * DM * UW, p.norm_g + l * DM, p.wt_in + (size_t)l * UW * DM, DM, UW, kt * 64, nt * 64); }
    else if (t < T_IN + T_OUT) { int tt = t - T_IN; int l = tt / 320, r = tt % 320, kt = r / 16, nt = r % 16;
      transpose_tile(lds, p.w_out + (size_t)l * MIXW * DM, nullptr, p.wt_out + (size_t)l * DM * MIXW, MIXW, DM, kt * 64, nt * 64); }
    else { int tt = t - T_IN - T_OUT; int l = tt / 128, r = tt % 128, kt = r / 8, nt = r % 8;
      transpose_tile(lds, p.w_mem_kv + (size_t)l * DM * 512, p.mem_norm_g + l * DM, p.wt_mem + (size_t)l * 512 * DM, DM, 512, kt * 64, nt * 64); }
  }
  const int gw = blockIdx.x * 4 + (ltid() >> 6), nw = gridDim.x * 4;
  norm_rows(p.memp, p.memb, p.rstd_mem, 0, 2048, gw, nw);
  norm_rows(p.mems, p.memb, p.rstd_mem, 2048, 4096, gw, nw);
  norm_rows(p.xp, p.xb, p.rstd, 0, NTOKP, gw, nw);
  norm_rows(p.xs, p.xb, p.rstd, NTOKP, NTOK, gw, nw);
  const int gt = blockIdx.x * NTHREADS + ltid(), nt_ = gridDim.x * NTHREADS;
  for (int i = gt; i < 8192 * 32; i += nt_) { int pos = i >> 5, f = i & 31; float inv = powf(10000.f, -(float)(2 * f) / 64.f); float ang = (float)pos * inv; p.tab1c[i] = cosf(ang); p.tab1s[i] = sinf(ang); }
  for (int i = gt; i < 128 * 16; i += nt_) { int pos = i >> 4, f = i & 15; float inv = powf(10000.f, -(float)(2 * f) / 32.f); float ang = (float)pos * inv; p.tabac[i] = cosf(ang); p.tabas[i] = sinf(ang); }
  if (blockIdx.x == 0 && ltid() < 64) {
    const int lane = ltid();
    for (int o = 0; o < 2; ++o) {
      const float* lv = p.diff_lambda + o * 256;
      float a = lv[lane] * lv[64 + lane], b = lv[128 + lane] * lv[192 + lane];
#pragma unroll
      for (int s = 32; s > 0; s >>= 1) { a += __shfl_xor(a, s); b += __shfl_xor(b, s); }
      float li = 0.8f - 0.6f * expf(-0.3f * (float)(2 * o + 1));
      if (lane == 0) { p.lam[o * 2] = expf(a) - expf(b) + li; p.lam[o * 2 + 1] = 1.f - li; }
    }
  }
}

struct GemmDesc { const bf16_t* A; const bf16_t* Bt; int lda, K, mtiles, ntiles, remap, seg2; };
enum { EPI_IN = 0, EPI_MEM = 1, EPI_OUT = 2 };

DI void head_store(f32x16 v0, f32x16 v1, float rs, int mode, const float* gain, const Params& p, int pos, bf16_t* orow, int h) {
  v0 *= rs; v1 *= rs;
  if (mode) {
    float ss = 0.f;
#pragma unroll
    for (int i = 0; i < 16; ++i) ss += v0[i] * v0[i] + v1[i] * v1[i];
    ss = swapsum(ss);
    const float inv = rsqrtf(ss * (1.f / 64.f) + EPSF);
#pragma unroll
    for (int g4 = 0; g4 < 4; ++g4) {
      const f32x4 ga = *(const f32x4*)(gain + 8 * g4 + 4 * h), gb = *(const f32x4*)(gain + 32 + 8 * g4 + 4 * h);
#pragma unroll
      for (int j = 0; j < 4; ++j) { v0[4 * g4 + j] *= inv * ga[j]; v1[4 * g4 + j] *= inv * gb[j]; }
    }
    if (mode == 2) {
#pragma unroll
      for (int g4 = 0; g4 < 4; ++g4) {
        const f32x4 c = *(const f32x4*)(p.tab1c + pos * 32 + 8 * g4 + 4 * h), s = *(const f32x4*)(p.tab1s + pos * 32 + 8 * g4 + 4 * h);
#pragma unroll
        for (int j = 0; j < 4; ++j) { const int i = 4 * g4 + j; const float x1 = v0[i], x2 = v1[i]; v0[i] = x1 * c[j] - x2 * s[j]; v1[i] = x2 * c[j] + x1 * s[j]; }
      }
    } else if (mode == 3) {
      const int row = pos >> 6, col = pos & 63;
#pragma unroll
      for (int g4 = 0; g4 < 2; ++g4) {
        const f32x4 c0 = *(const f32x4*)(p.tabac + row * 16 + 8 * g4 + 4 * h), s0 = *(const f32x4*)(p.tabas + row * 16 + 8 * g4 + 4 * h);
        const f32x4 c1 = *(const f32x4*)(p.tabac + col * 16 + 8 * g4 + 4 * h), s1 = *(const f32x4*)(p.tabas + col * 16 + 8 * g4 + 4 * h);
#pragma unroll
        for (int j = 0; j < 4; ++j) { const int i = 4 * g4 + j;
          float x1 = v0[i], x2 = v0[i + 8]; v0[i] = x1 * c0[j] - x2 * s0[j]; v0[i + 8] = x2 * c0[j] + x1 * s0[j];
          x1 = v1[i]; x2 = v1[i + 8]; v1[i] = x1 * c1[j] - x2 * s1[j]; v1[i + 8] = x2 * c1[j] + x1 * s1[j]; }
      }
    }
  }
#pragma unroll
  for (int g4 = 0; g4 < 4; ++g4) {
    u32x2 w0, w1; w0.x = cvtpk(v0[4 * g4], v0[4 * g4 + 1]); w0.y = cvtpk(v0[4 * g4 + 2], v0[4 * g4 + 3]);
    w1.x = cvtpk(v1[4 * g4], v1[4 * g4 + 1]); w1.y = cvtpk(v1[4 * g4 + 2], v1[4 * g4 + 3]);
    *(u32x2*)(orow + 8 * g4 + 4 * h) = w0; *(u32x2*)(orow + 32 + 8 * g4 + 4 * h) = w1;
  }
}

template <int EPI>
DI void gemm_phase(char* lds, const Params& p, const GemmDesc g, int layer) {
  const int tid = ltid(), lane = tid & 63, wid = tid >> 6, wm = wid >> 1, wn = wid & 1, r = lane & 31, h = lane >> 5;
  const int srow = tid >> 3, sch = tid & 7;
  const int soff = srow * 128 + ((sch ^ (srow & 7)) << 4);
  const int nk = g.K >> 6;
  const int ntile = g.mtiles * g.ntiles;
  for (int tile = blockIdx.x; tile < ntile; tile += gridDim.x) {
    const int mt = tile / g.ntiles, nt = tile - mt * g.ntiles;
    const bf16_t* Ag = g.A + (size_t)(mt * 128 + srow) * g.lda + sch * 8;
    const bf16_t* Bg = g.Bt + (size_t)(nt * 128 + srow) * g.K + sch * 8;
    u32x4 ra[4], rb[4];
    f32x16 acc[2][2];
#pragma unroll
    for (int a = 0; a < 2; ++a)
#pragma unroll
      for (int b = 0; b < 2; ++b)
#pragma unroll
        for (int i = 0; i < 16; ++i) acc[a][b][i] = 0.f;
#define G_LOAD(kt) do { const int k0_ = (kt) * 64; int ac_ = k0_; if (g.remap) ac_ = k0_ < 512 ? k0_ : (k0_ < 1024 ? g.seg2 + k0_ - 512 : 2304 + k0_ - 1024); \
    _Pragma("unroll") for (int i = 0; i < 4; ++i) { ra[i] = *(const u32x4*)(Ag + (size_t)(32 * i) * g.lda + ac_); rb[i] = *(const u32x4*)(Bg + (size_t)(32 * i) * g.K + k0_); } } while (0)
#define G_WRITE(buf) do { _Pragma("unroll") for (int i = 0; i < 4; ++i) { *(u32x4*)(lds + (buf) * 32768 + i * 4096 + soff) = ra[i]; *(u32x4*)(lds + (buf) * 32768 + 16384 + i * 4096 + soff) = rb[i]; } } while (0)
    G_LOAD(0); G_WRITE(0); __syncthreads();
    for (int kt = 0; kt < nk; ++kt) {
      if (kt + 1 < nk) G_LOAD(kt + 1);
      const char* la = lds + (kt & 1) * 32768 + (wm * 64 + r) * 128;
      const char* lb = lds + (kt & 1) * 32768 + 16384 + (wn * 64 + r) * 128;
#pragma unroll
      for (int ks = 0; ks < 4; ++ks) {
        const int co = ((2 * ks + h) ^ (r & 7)) << 4;
        const bf16x8 a0 = *(const bf16x8*)(la + co), a1 = *(const bf16x8*)(la + 4096 + co);
        const bf16x8 b0 = *(const bf16x8*)(lb + co), b1 = *(const bf16x8*)(lb + 4096 + co);
        acc[0][0] = MFMA32(b0, a0, acc[0][0]); acc[0][1] = MFMA32(b1, a0, acc[0][1]);
        acc[1][0] = MFMA32(b0, a1, acc[1][0]); acc[1][1] = MFMA32(b1, a1, acc[1][1]);
      }
      if (kt + 1 < nk) G_WRITE((kt + 1) & 1);
      __syncthreads();
    }
#undef G_LOAD
#undef G_WRITE
    const int n_w = nt * 128 + wn * 64;
    if (EPI == EPI_IN) {
      int mode = 0; const float* gain = p.mem_qk_g;
      if ((layer & 1) == 0) { const int e = layer >> 1;
        if (n_w >= 1536 && n_w < 2048) { mode = 2; gain = p.swa_qk_g + (e * 2) * 64; }
        else if (n_w >= 2048 && n_w < 2176) { mode = 2; gain = p.swa_qk_g + (e * 2 + 1) * 64; }
        else if (n_w >= 2304 && n_w < 2560) { mode = 1; gain = p.mem_qk_g + (layer * 2) * 64; }
      } else { const int o = layer >> 1;
        if (n_w < 512) { mode = 3; gain = p.ax_qk_g + (o * 2) * 64; }
        else if (n_w < 640) { mode = 3; gain = p.ax_qk_g + (o * 2 + 1) * 64; }
        else if (n_w >= 768 && n_w < 1280) { mode = 2; gain = p.diff_qk_g + (o * 2) * 64; }
        else if (n_w >= 1280 && n_w < 1792) { mode = 2; gain = p.diff_qk_g + (o * 2 + 1) * 64; }
        else if (n_w >= 2304 && n_w < 2560) { mode = 1; gain = p.mem_qk_g + (layer * 2) * 64; }
      }
#pragma unroll
      for (int mi = 0; mi < 2; ++mi) {
        const int t = mt * 128 + wm * 64 + mi * 32 + r;
        int S, seq0, pos, sq; tok_info(t, S, seq0, pos, sq);
        head_store(acc[mi][0], acc[mi][1], p.rstd[t], mode, gain, p, pos, p.u + (size_t)t * UW + n_w, h);
      }
    } else if (EPI == EPI_MEM) {
      const int l = n_w >> 9, c = n_w & 511;
      const int mode = c < 256 ? 1 : 0; const float* gain = p.mem_qk_g + (l * 2 + 1) * 64;
#pragma unroll
      for (int mi = 0; mi < 2; ++mi) {
        const int row = mt * 128 + wm * 64 + mi * 32 + r;
        head_store(acc[mi][0], acc[mi][1], p.rstd_mem[row], mode, gain, p, 0, p.memkv + (size_t)row * 2048 + n_w, h);
      }
    } else {
#pragma unroll
      for (int mi = 0; mi < 2; ++mi) {
        const int t = mt * 128 + wm * 64 + mi * 32 + r;
        const float* xin = layer == 0 ? (t < NTOKP ? p.xp + (size_t)t * DM : p.xs + (size_t)(t - NTOKP) * DM) : p.out + (size_t)t * DM;
        float* xo = p.out + (size_t)t * DM;
#pragma unroll
        for (int ni = 0; ni < 2; ++ni)
#pragma unroll
          for (int g4 = 0; g4 < 4; ++g4) {
            const int n = n_w + ni * 32 + 8 * g4 + 4 * h;
            f32x4 xv = *(const f32x4*)(xin + n);
#pragma unroll
            for (int j = 0; j < 4; ++j) xv[j] += acc[mi][ni][4 * g4 + j];
            *(f32x4*)(xo + n) = xv;
          }
      }
    }
  }
}

enum { AM_PLAIN = 0, AM_SWA = 1, AM_DIFF = 2 };
struct AttnJob {
  const bf16_t* q;
  const bf16_t* k[2];
  const bf16_t* v;
  int ldk, ldv;
  int tile_lo, tile_hi;
  float m_init, l_init;
  int qpos0;
  bf16_t* o;
  const bf16_t* z;
  float lam, oscale;
  const float* subg;
};

template <int DV, int NK, int MODE>
DI void attn_job(char* lds, const AttnJob& J) {
  constexpr int NDV = DV / 32;
  constexpr float C = 0.125f * LOG2E;
  const int tid = ltid(), lane = tid & 63, wid = tid >> 6, r = lane & 31, h = lane >> 5;
  const int kstream = (NK == 2) ? (wid & 1) : 0;
  bf16x8 qf[4];
  { const bf16_t* qrow = J.q + (size_t)r * UW + 8 * h;
#pragma unroll
    for (int ds = 0; ds < 4; ++ds) qf[ds] = *(const bf16x8*)(qrow + 16 * ds); }
  f32x16 O[NDV];
#pragma unroll
  for (int d = 0; d < NDV; ++d)
#pragma unroll
    for (int i = 0; i < 16; ++i) O[d][i] = 0.f;
  float m = J.m_init, l = (h == 0) ? J.l_init : 0.f;
  const int ksrow = tid >> 3, ksch = tid & 7;
  const int kpi = (ksrow & ~12) | ((ksrow & 4) << 1) | ((ksrow & 8) >> 1);
  const int ksoff = kpi * 128 + ((ksch ^ (kpi & 7)) << 4);
  constexpr int VCH = DV / 8;
  constexpr int VI = (64 * VCH) / NTHREADS;
  const int vkey0 = tid / VCH, vc8 = (tid % VCH) * 8;
  u32x4 rk[NK][2], rv[VI];
#define A_LOAD(t) do { const size_t kb_ = (size_t)(t) * 64; \
    _Pragma("unroll") for (int s = 0; s < NK; ++s) _Pragma("unroll") for (int i = 0; i < 2; ++i) rk[s][i] = *(const u32x4*)(J.k[s] + (kb_ + ksrow + 32 * i) * J.ldk + ksch * 8); \
    _Pragma("unroll") for (int i = 0; i < VI; ++i) rv[i] = *(const u32x4*)(J.v + (kb_ + vkey0 + (NTHREADS / VCH) * i) * J.ldv + vc8); } while (0)
#define A_WRITE(st) do { char* b_ = lds + (st) * 32768; \
    _Pragma("unroll") for (int s = 0; s < NK; ++s) _Pragma("unroll") for (int i = 0; i < 2; ++i) *(u32x4*)(b_ + s * 8192 + i * 4096 + ksoff) = rk[s][i]; \
    _Pragma("unroll") for (int i = 0; i < VI; ++i) { const int key_ = vkey0 + (NTHREADS / VCH) * i; \
      *(u32x4*)(b_ + NK * 8192 + ((key_ >> 3) * NDV + (vc8 >> 5)) * 512 + (key_ & 7) * 64 + (vc8 & 31) * 2) = rv[i]; } } while (0)
  const int nt = J.tile_hi - J.tile_lo;
  A_LOAD(J.tile_lo); A_WRITE(0); __syncthreads();
  const int i16 = lane & 15;
  const int vrd = h * NDV * 512 + (i16 >> 2) * 64 + (((lane >> 4) & 1) * 16 + (i16 & 3) * 4) * 2;
  for (int it = 0; it < nt; ++it) {
    if (it + 1 < nt) A_LOAD(J.tile_lo + it + 1);
    const int tile = J.tile_lo + it;
    bool active = true;
    if (MODE == AM_SWA) { const int k0 = tile * 64; active = !(k0 > J.qpos0 + 31 + 128 || k0 + 63 < J.qpos0 - 128); }
    if (active) {
      const char* Kl = lds + (it & 1) * 32768 + kstream * 8192 + r * 128;
      f32x16 sA, sB;
#pragma unroll
      for (int i = 0; i < 16; ++i) { sA[i] = 0.f; sB[i] = 0.f; }
#pragma unroll
      for (int ds = 0; ds < 4; ++ds) {
        const int co = ((2 * ds + h) ^ (r & 7)) << 4;
        const bf16x8 ka = *(const bf16x8*)(Kl + co), kb = *(const bf16x8*)(Kl + 4096 + co);
        sA = MFMA32(ka, qf[ds], sA); sB = MFMA32(kb, qf[ds], sB);
      }
      if (MODE == AM_SWA) {
        const int qa = J.qpos0 + r, kbase = tile * 64 + 8 * h;
#pragma unroll
        for (int i = 0; i < 16; ++i) {
          const int ka_ = kbase + 16 * (i >> 3) + (i & 7);
          int d0 = qa - ka_; d0 = d0 < 0 ? -d0 : d0; if (d0 > 128) sA[i] = -INFINITY;
          int d1 = qa - (ka_ + 32); d1 = d1 < 0 ? -d1 : d1; if (d1 > 128) sB[i] = -INFINITY;
        }
      }
      float mx = sA[0];
#pragma unroll
      for (int i = 1; i < 16; ++i) mx = fmaxf(mx, sA[i]);
#pragma unroll
      for (int i = 0; i < 16; ++i) mx = fmaxf(mx, sB[i]);
      mx = swapmax(mx);
      const float mn = fmaxf(m, mx * C);
      const float alpha = __builtin_amdgcn_exp2f(m - mn);
      m = mn;
      float ps = 0.f;
#pragma unroll
      for (int i = 0; i < 16; ++i) { sA[i] = __builtin_amdgcn_exp2f(fmaf(sA[i], C, -mn)); sB[i] = __builtin_amdgcn_exp2f(fmaf(sB[i], C, -mn)); ps += sA[i] + sB[i]; }
      l = l * alpha + ps;
#pragma unroll
      for (int d = 0; d < NDV; ++d)
#pragma unroll
        for (int i = 0; i < 16; ++i) O[d][i] *= alpha;
      bf16x8 pf[4];
      { u32x4 w;
        w.x = cvtpk(sA[0], sA[1]); w.y = cvtpk(sA[2], sA[3]); w.z = cvtpk(sA[4], sA[5]); w.w = cvtpk(sA[6], sA[7]); pf[0] = __builtin_bit_cast(bf16x8, w);
        w.x = cvtpk(sA[8], sA[9]); w.y = cvtpk(sA[10], sA[11]); w.z = cvtpk(sA[12], sA[13]); w.w = cvtpk(sA[14], sA[15]); pf[1] = __builtin_bit_cast(bf16x8, w);
        w.x = cvtpk(sB[0], sB[1]); w.y = cvtpk(sB[2], sB[3]); w.z = cvtpk(sB[4], sB[5]); w.w = cvtpk(sB[6], sB[7]); pf[2] = __builtin_bit_cast(bf16x8, w);
        w.x = cvtpk(sB[8], sB[9]); w.y = cvtpk(sB[10], sB[11]); w.z = cvtpk(sB[12], sB[13]); w.w = cvtpk(sB[14], sB[15]); pf[3] = __builtin_bit_cast(bf16x8, w); }
      const char* Vl = lds + (it & 1) * 32768 + NK * 8192 + vrd;
#pragma unroll
      for (int ks = 0; ks < 4; ++ks)
#pragma unroll
        for (int d = 0; d < NDV; ++d) {
          const s16x4 lo = __builtin_amdgcn_ds_read_tr16_b64_v4i16((LAS s16x4*)(Vl + ks * 2 * NDV * 512 + d * 512));
          const s16x4 hi = __builtin_amdgcn_ds_read_tr16_b64_v4i16((LAS s16x4*)(Vl + ks * 2 * NDV * 512 + d * 512 + 256));
          const bf16x8 vf = __builtin_shufflevector(lo, hi, 0, 1, 2, 3, 4, 5, 6, 7);
          O[d] = MFMA32(vf, pf[ks], O[d]);
        }
    }
    if (it + 1 < nt) A_WRITE((it + 1) & 1);
    __syncthreads();
  }
#undef A_LOAD
#undef A_WRITE
  const float lt = swapsum(l);
  const float inv = 1.f / lt;
  if (MODE != AM_DIFF) {
    bf16_t* orow = J.o + (size_t)r * UW; const bf16_t* zrow = J.z + (size_t)r * UW;
#pragma unroll
    for (int d = 0; d < NDV; ++d)
#pragma unroll
      for (int g4 = 0; g4 < 4; ++g4) {
        const int dv = 32 * d + 8 * g4 + 4 * h;
        const u32x2 zw = *(const u32x2*)(zrow + dv);
        const float y0 = O[d][4 * g4] * inv * silu(bflo(zw.x)), y1 = O[d][4 * g4 + 1] * inv * silu(bfhi(zw.x));
        const float y2 = O[d][4 * g4 + 2] * inv * silu(bflo(zw.y)), y3 = O[d][4 * g4 + 3] * inv * silu(bfhi(zw.y));
        u32x2 w; w.x = cvtpk(y0, y1); w.y = cvtpk(y2, y3);
        *(u32x2*)(orow + dv) = w;
      }
  } else {
    float* sc = (float*)(lds + 32768) + (wid >> 1) * (DV * 32);
    if (wid & 1) {
      const float f = inv * J.lam;
#pragma unroll
      for (int d = 0; d < NDV; ++d)
#pragma unroll
        for (int i = 0; i < 16; ++i) sc[(32 * d + crow(i, h)) * 32 + r] = O[d][i] * f;
    }
    __syncthreads();
    if (!(wid & 1)) {
      float ss = 0.f;
#pragma unroll
      for (int d = 0; d < NDV; ++d)
#pragma unroll
        for (int i = 0; i < 16; ++i) { const float a = O[d][i] * inv - sc[(32 * d + crow(i, h)) * 32 + r]; O[d][i] = a; ss += a * a; }
      ss = swapsum(ss);
      const float rn = rsqrtf(ss * (1.f / DV) + EPSF) * J.oscale;
      bf16_t* orow = J.o + (size_t)r * UW; const bf16_t* zrow = J.z + (size_t)r * UW;
#pragma unroll
      for (int d = 0; d < NDV; ++d)
#pragma unroll
        for (int g4 = 0; g4 < 4; ++g4) {
          const int dv = 32 * d + 8 * g4 + 4 * h;
          const u32x2 zw = *(const u32x2*)(zrow + dv);
          const f32x4 sg = *(const f32x4*)(J.subg + dv);
          const float y0 = O[d][4 * g4] * rn * sg[0] * silu(bflo(zw.x)), y1 = O[d][4 * g4 + 1] * rn * sg[1] * silu(bfhi(zw.x));
          const float y2 = O[d][4 * g4 + 2] * rn * sg[2] * silu(bflo(zw.y)), y3 = O[d][4 * g4 + 3] * rn * sg[3] * silu(bfhi(zw.y));
          u32x2 w; w.x = cvtpk(y0, y1); w.y = cvtpk(y2, y3);
          *(u32x2*)(orow + dv) = w;
        }
    }
  }
}

DI void mem_jobs(char* lds, const Params& p, int layer) {
  const int wid = ltid() >> 6;
  for (int job = blockIdx.x; job < 768 * 4; job += gridDim.x) {
    const int qb = job >> 2, hm = job & 3, t0 = qb * 128;
    int S, seq0, pos, sq; tok_info(t0, S, seq0, pos, sq);
    AttnJob J;
    bf16_t* qo = p.u + (size_t)(t0 + 32 * wid) * UW + 2304 + hm * 64;
    J.q = qo; J.o = qo; J.z = p.u + (size_t)(t0 + 32 * wid) * UW + 2560 + 1024 + hm * 64;
    J.k[0] = J.k[1] = p.memkv + (size_t)(sq * 256) * 2048 + layer * 512 + hm * 64; J.v = J.k[0] + 256; J.ldk = J.ldv = 2048;
    J.tile_lo = 0; J.tile_hi = 4; J.m_init = -1e30f; J.l_init = 0.f; J.qpos0 = 0; J.lam = 0.f; J.oscale = 0.f; J.subg = nullptr;
    attn_job<64, 1, AM_PLAIN>(lds, J);
  }
}

DI void phase_mix_even(char* lds, const Params& p, int layer) {
  const int e = layer >> 1, wid = ltid() >> 6;
  for (int job = blockIdx.x; job < 768 * 8; job += gridDim.x) {
    const int qb = job >> 3, hq = job & 7, kvh = hq >> 2, t0 = qb * 128;
    int S, seq0, pos, sq; tok_info(t0, S, seq0, pos, sq);
    AttnJob J;
    bf16_t* qo = p.u + (size_t)(t0 + 32 * wid) * UW + 1536 + hq * 64;
    J.q = qo; J.o = qo; J.z = p.u + (size_t)(t0 + 32 * wid) * UW + 2560 + 512 + hq * 64;
    J.k[0] = J.k[1] = p.u + (size_t)seq0 * UW + 2048 + kvh * 64; J.v = p.u + (size_t)seq0 * UW + 2176 + kvh * 64; J.ldk = J.ldv = UW;
    const int pt = pos >> 6;
    J.tile_lo = pt - 2 < 0 ? 0 : pt - 2; J.tile_hi = pt + 4 > (S >> 6) ? (S >> 6) : pt + 4;
    J.m_init = p.swa_sink[e * 8 + hq] * LOG2E; J.l_init = 1.f; J.qpos0 = pos + 32 * wid; J.lam = 0.f; J.oscale = 0.f; J.subg = nullptr;
    attn_job<64, 1, AM_SWA>(lds, J);
  }
  mem_jobs(lds, p, layer);
  const float* cw = p.conv_w + e * 3 * 512;
  for (int idx = blockIdx.x * NTHREADS + ltid(); idx < NTOK * 64; idx += gridDim.x * NTHREADS) {
    const int t = idx >> 6, c0 = (idx & 63) * 8;
    int S, seq0, pos, sq; tok_info(t, S, seq0, pos, sq);
    bf16_t* ur = p.u + (size_t)t * UW;
    float ic[8], il[8], ir[8];
    { const u32x4 a = *(const u32x4*)(ur + 512 + c0), b = *(const u32x4*)(ur + 1024 + c0);
#pragma unroll
      for (int j = 0; j < 4; ++j) { ic[2 * j] = bflo(a[j]) * bflo(b[j]); ic[2 * j + 1] = bfhi(a[j]) * bfhi(b[j]); } }
    if (pos > 0) { const u32x4 a = *(const u32x4*)(ur - UW + 512 + c0), b = *(const u32x4*)(ur - UW + 1024 + c0);
#pragma unroll
      for (int j = 0; j < 4; ++j) { il[2 * j] = bflo(a[j]) * bflo(b[j]); il[2 * j + 1] = bfhi(a[j]) * bfhi(b[j]); } }
    else {
#pragma unroll
      for (int j = 0; j < 8; ++j) il[j] = 0.f; }
    if (pos < S - 1) { const u32x4 a = *(const u32x4*)(ur + UW + 512 + c0), b = *(const u32x4*)(ur + UW + 1024 + c0);
#pragma unroll
      for (int j = 0; j < 4; ++j) { ir[2 * j] = bflo(a[j]) * bflo(b[j]); ir[2 * j + 1] = bfhi(a[j]) * bfhi(b[j]); } }
    else {
#pragma unroll
      for (int j = 0; j < 8; ++j) ir[j] = 0.f; }
    const u32x4 gbw = *(const u32x4*)(ur + c0), zw = *(const u32x4*)(ur + 2560 + c0);
    float y[8];
#pragma unroll
    for (int j = 0; j < 8; ++j) {
      const float gb = (j & 1) ? bfhi(gbw[j >> 1]) : bflo(gbw[j >> 1]);
      const float z = (j & 1) ? bfhi(zw[j >> 1]) : bflo(zw[j >> 1]);
      const float cv = il[j] * cw[c0 + j] + ic[j] * cw[512 + c0 + j] + ir[j] * cw[1024 + c0 + j];
      y[j] = gb * cv * silu(z);
    }
    u32x4 w; w.x = cvtpk(y[0], y[1]); w.y = cvtpk(y[2], y[3]); w.z = cvtpk(y[4], y[5]); w.w = cvtpk(y[6], y[7]);
    *(u32x4*)(ur + c0) = w;
  }
}

DI void phase_mix_odd(char* lds, const Params& p, int layer) {
  const int o = layer >> 1, wid = ltid() >> 6;
  for (int job = blockIdx.x; job < 6144; job += gridDim.x) {
    int g, qb, kvh, seq0, S;
    if (job < 4096) { g = job & 3; qb = (job >> 2) & 63; kvh = (job >> 8) & 1; seq0 = (job >> 9) * 8192; S = 8192; }
    else { const int j = job - 4096; g = j & 3; qb = (j >> 2) & 31; kvh = (j >> 7) & 1; seq0 = NTOKP + (j >> 8) * 4096; S = 4096; }
    const int hq = kvh * 4 + g, t0 = seq0 + qb * 128 + 32 * wid;
    AttnJob J;
    bf16_t* qo = p.u + (size_t)t0 * UW + hq * 64;
    J.q = qo; J.o = qo; J.z = p.u + (size_t)t0 * UW + 2560 + hq * 64;
    J.k[0] = J.k[1] = p.u + (size_t)seq0 * UW + 512 + kvh * 64; J.v = p.u + (size_t)seq0 * UW + 640 + kvh * 64; J.ldk = J.ldv = UW;
    J.tile_lo = 0; J.tile_hi = S >> 6; J.m_init = -1e30f; J.l_init = 0.f; J.qpos0 = 0; J.lam = 0.f; J.oscale = 0.f; J.subg = nullptr;
    attn_job<64, 1, AM_PLAIN>(lds, J);
  }
  const float lam = p.lam[o * 2], osc = p.lam[o * 2 + 1];
  for (int job = blockIdx.x; job < 6144; job += gridDim.x) {
    int qb, hh, seq0, S;
    if (job < 4096) { qb = job & 127; hh = (job >> 7) & 3; seq0 = (job >> 9) * 8192; S = 8192; }
    else { const int j = job - 4096; qb = j & 63; hh = (j >> 6) & 3; seq0 = NTOKP + (j >> 8) * 4096; S = 4096; }
    const int mp = wid & 1, sub = wid >> 1, t0 = seq0 + qb * 64 + sub * 32;
    AttnJob J;
    J.q = p.u + (size_t)t0 * UW + 768 + (2 * hh + mp) * 64;
    J.o = p.u + (size_t)t0 * UW + 768 + hh * 128; J.z = p.u + (size_t)t0 * UW + 2560 + 512 + hh * 128;
    J.k[0] = p.u + (size_t)seq0 * UW + 1280 + (2 * hh) * 64; J.k[1] = J.k[0] + 64; J.v = p.u + (size_t)seq0 * UW + 1792 + hh * 128; J.ldk = J.ldv = UW;
    J.tile_lo = 0; J.tile_hi = S >> 6; J.m_init = -1e30f; J.l_init = 0.f; J.qpos0 = 0; J.lam = lam; J.oscale = osc; J.subg = p.diff_subln_g + o * 128;
    attn_job<128, 2, AM_DIFF>(lds, J);
  }
  mem_jobs(lds, p, layer);
}

DI void phase_norm(const Params& p) {
  const int gw = blockIdx.x * 4 + (ltid() >> 6), nw = gridDim.x * 4;
  norm_rows(p.out, p.xb, p.rstd, 0, NTOK, gw, nw);
}

__global__ void __launch_bounds__(NTHREADS, 2) fwd_kernel(Params p) {
  __shared__ __attribute__((aligned(16))) char lds[LDS_BYTES];
  for (int ph = p.phase_lo; ph < p.phase_hi; ++ph) {
    if (ph == 0) phase_prep(lds, p);
    else {
      const int l = (ph - 1) >> 2, s = (ph - 1) & 3;
      if (s == 0) {
        if (l == 0) { GemmDesc g{p.memb, p.wt_mem, DM, DM, 32, 16, 0, 0}; gemm_phase<EPI_MEM>(lds, p, g, 0); }
        GemmDesc g{p.xb, p.wt_in + (size_t)l * UW * DM, DM, DM, NTOK / 128, UW / 128, 0, 0};
        gemm_phase<EPI_IN>(lds, p, g, l);
      } else if (s == 1) {
        if (l & 1) phase_mix_odd(lds, p, l); else phase_mix_even(lds, p, l);
      } else if (s == 2) {
        GemmDesc g{p.u, p.wt_out + (size_t)l * DM * MIXW, UW, MIXW, NTOK / 128, DM / 128, 1, (l & 1) ? 768 : 1536};
        gemm_phase<EPI_OUT>(lds, p, g, l);
      } else phase_norm(p);
    }
#if !MULTI_LAUNCH
    if (ph + 1 < p.phase_hi) cg::this_grid().sync();
#endif
  }
}

extern "C" void kernel_launch(void* const* d_in, const int* in_sizes, int n_in, void* d_out, int out_size, void* d_ws, size_t ws_size,
                              hipStream_t stream) {
  static int grid_blocks = 0;
  if (!grid_blocks) {
    int dev = 0, cus = 0, per_cu = 0;
    hipGetDevice(&dev);
    hipDeviceGetAttribute(&cus, hipDeviceAttributeMultiprocessorCount, dev);
    hipOccupancyMaxActiveBlocksPerMultiprocessor(&per_cu, fwd_kernel, NTHREADS, 0);
    if (per_cu > 2) per_cu = 2;
    if (per_cu < 1) per_cu = 1;
    grid_blocks = cus * per_cu;
  }
  Params p{};
  p.xp = (const float*)d_in[0]; p.xs = (const float*)d_in[1]; p.memp = (const float*)d_in[2]; p.mems = (const float*)d_in[3];
  p.norm_g = (const float*)d_in[4]; p.w_in = (const float*)d_in[5]; p.w_out = (const float*)d_in[6]; p.mem_norm_g = (const float*)d_in[7];
  p.w_mem_kv = (const float*)d_in[8]; p.mem_qk_g = (const float*)d_in[9]; p.conv_w = (const float*)d_in[10]; p.swa_qk_g = (const float*)d_in[11];
  p.swa_sink = (const float*)d_in[12]; p.ax_qk_g = (const float*)d_in[13]; p.diff_qk_g = (const float*)d_in[14]; p.diff_lambda = (const float*)d_in[15];
  p.diff_subln_g = (const float*)d_in[16];
  p.out = (float*)d_out;
  char* w = (char*)d_ws; size_t off = 0;
  auto take = [&](size_t bytes) { char* r = w + off; off += (bytes + 255) & ~(size_t)255; return r; };
  p.u = (bf16_t*)take((size_t)NTOK * UW * 2);
  p.xb = (bf16_t*)take((size_t)NTOK * DM * 2);
  p.wt_in = (bf16_t*)take((size_t)4 * UW * DM * 2);
  p.wt_out = (bf16_t*)take((size_t)4 * DM * MIXW * 2);
  p.wt_mem = (bf16_t*)take((size_t)2048 * DM * 2);
  p.memb = (bf16_t*)take((size_t)4096 * DM * 2);
  p.memkv = (bf16_t*)take((size_t)4096 * 2048 * 2);
  p.rstd = (float*)take((size_t)NTOK * 4);
  p.rstd_mem = (float*)take(4096 * 4);
  p.tab1c = (float*)take(8192 * 32 * 4); p.tab1s = (float*)take(8192 * 32 * 4);
  p.tabac = (float*)take(128 * 16 * 4); p.tabas = (float*)take(128 * 16 * 4);
  p.lam = (float*)take(256);
  if (off > ws_size) { fprintf(stderr, "workspace too small: need %zu have %zu\n", off, ws_size); return; }
#if MULTI_LAUNCH
  for (int ph = 0; ph < NPHASE; ++ph) {
    p.phase_lo = ph; p.phase_hi = ph + 1;
    hipLaunchKernelGGL(fwd_kernel, dim3(grid_blocks), dim3(NTHREADS), 0, stream, p);
  }
#else
  p.phase_lo = 0; p.phase_hi = NPHASE;
  void* args[] = {&p};
  hipError_t e = hipLaunchCooperativeKernel((void*)fwd_kernel, dim3(grid_blocks), dim3(NTHREADS), args, 0, stream);
  if (e != hipSuccess) fprintf(stderr, "cooperative launch failed: %s (grid %d)\n", hipGetErrorString(e), grid_blocks);
#endif
}
```

```cpp
#include <hip/hip_runtime.h>
#include <hip/hip_cooperative_groups.h>
#include <cstdint>
#include <cstdio>
namespace cg = cooperative_groups;

#ifndef MULTI_LAUNCH
#define MULTI_LAUNCH 0
#endif

#ifndef PROBE_ODD
#define PROBE_ODD 0
#endif
#ifndef PROBE_EVEN
#define PROBE_EVEN 0
#endif
#ifndef PROBE_GIN
#define PROBE_GIN 0
#endif
#define DI __device__ __forceinline__
#define LAS __attribute__((address_space(3)))
typedef unsigned short bf16_t;
typedef short bf16x8 __attribute__((ext_vector_type(8)));
typedef short s16x4 __attribute__((ext_vector_type(4)));
typedef float f32x16 __attribute__((ext_vector_type(16)));
typedef float f32x4 __attribute__((ext_vector_type(4)));
typedef unsigned u32x4 __attribute__((ext_vector_type(4)));
typedef unsigned u32x2 __attribute__((ext_vector_type(2)));

constexpr int NTOK = 98304, NTOKP = 65536, UW = 3840, DM = 1024, MIXW = 1280;
constexpr int NTHREADS = 512;
constexpr int AT = 256;
constexpr int LDS_BYTES = 131072;
constexpr float EPSF = 1e-6f;
constexpr float LOG2E = 1.4426950408889634f;
constexpr int NPHASE = 16;

struct Params {
  const float *xp, *xs, *memp, *mems, *norm_g, *w_in, *w_out, *mem_norm_g, *w_mem_kv, *mem_qk_g, *conv_w, *swa_qk_g,
      *swa_sink, *ax_qk_g, *diff_qk_g, *diff_lambda, *diff_subln_g;
  float* out;
  bf16_t *u, *xb, *wt_in, *wt_out, *wt_mem, *memb, *memkv;
  float *rstd, *rstd_mem, *tab1c, *tab1s, *tabac, *tabas, *lam;
  int phase_lo, phase_hi, probe, pad_;
};

typedef __bf16 bf16x2_t __attribute__((ext_vector_type(2)));
typedef float f32x2 __attribute__((ext_vector_type(2)));
DI unsigned cvtpk(float lo, float hi) { f32x2 v = {lo, hi}; bf16x2_t b = __builtin_convertvector(v, bf16x2_t); return __builtin_bit_cast(unsigned, b); }
DI float bf2f(unsigned short b) { return __uint_as_float(((unsigned)b) << 16); }
DI float bflo(unsigned w) { return __uint_as_float(w << 16); }
DI float bfhi(unsigned w) { return __uint_as_float(w & 0xffff0000u); }
DI int ltid() { int t; asm volatile("v_mov_b32 %0, %1" : "=v"(t) : "v"(threadIdx.x)); return t; }
DI int crow(int i, int h) { return (i & 3) + 8 * (i >> 2) + 4 * h; }
DI float swapmax(float v) { auto rr = __builtin_amdgcn_permlane32_swap(__float_as_uint(v), __float_as_uint(v), false, false); return fmaxf(__uint_as_float(rr[0]), __uint_as_float(rr[1])); }
DI float swapsum(float v) { auto rr = __builtin_amdgcn_permlane32_swap(__float_as_uint(v), __float_as_uint(v), false, false); return __uint_as_float(rr[0]) + __uint_as_float(rr[1]); }
DI float shx(float v, int lane, int o) { return __int_as_float(__builtin_amdgcn_ds_bpermute(((lane ^ o) & 63) << 2, __float_as_int(v))); }
DI float silu(float z) { return z / (1.f + __expf(-z)); }
#define MFMA32(a, b, c) __builtin_amdgcn_mfma_f32_32x32x16_bf16((a), (b), (c), 0, 0, 0)

DI void tok_info(int t, int& S, int& seq0, int& pos, int& sq) {
  if (t < NTOKP) { S = 8192; seq0 = t & ~8191; pos = t & 8191; sq = t >> 13; }
  else { int tt = t - NTOKP; S = 4096; seq0 = NTOKP + (tt & ~4095); pos = tt & 4095; sq = 8 + (tt >> 12); }
}

DI void transpose_tile(char* lds, const float* src, const float* g, bf16_t* dst, int K, int N, int k0, int n0) {
  float* tile = (float*)lds;
  const int tid = ltid(), a = tid >> 6, b = tid & 63;
#pragma unroll 4
  for (int i = 0; i < 8; ++i) { int kk = i * 8 + a; float v = src[(size_t)(k0 + kk) * N + n0 + b]; if (g) v *= g[k0 + kk]; tile[kk * 65 + b] = v; }
  __syncthreads();
#pragma unroll 4
  for (int i = 0; i < 8; ++i) { int nn = i * 8 + a; float v = tile[b * 65 + nn]; dst[(size_t)(n0 + nn) * K + k0 + b] = (bf16_t)(cvtpk(v, v) & 0xffffu); }
  __syncthreads();
}

DI void norm_rows(const float* src, bf16_t* dst, float* rstd, int row_begin, int row_end, int gw, int nw) {
  const int lane = ltid() & 63;
  for (int row = row_begin + gw; row < row_end; row += nw) {
    const float* s = src + (size_t)(row - row_begin) * DM; bf16_t* d = dst + (size_t)row * DM;
    f32x4 v[4]; float ss = 0.f;
#pragma unroll
    for (int j = 0; j < 4; ++j) { v[j] = *(const f32x4*)(s + (lane + 64 * j) * 4); ss += v[j][0] * v[j][0] + v[j][1] * v[j][1] + v[j][2] * v[j][2] + v[j][3] * v[j][3]; }
#pragma unroll
    for (int o = 32; o > 0; o >>= 1) ss += shx(ss, lane, o);
#pragma unroll
    for (int j = 0; j < 4; ++j) { u32x2 w; w.x = cvtpk(v[j][0], v[j][1]); w.y = cvtpk(v[j][2], v[j][3]); *(u32x2*)(d + (lane + 64 * j) * 4) = w; }
    if (lane == 0) rstd[row] = rsqrtf(ss * (1.f / DM) + EPSF);
  }
}

DI void phase_prep(char* lds, const Params& p) {
  const int T_IN = 4 * 16 * 60, T_OUT = 4 * 20 * 16, T_MEM = 4 * 16 * 8;
  for (int t = blockIdx.x; t < T_IN + T_OUT + T_MEM; t += gridDim.x) {
    if (t < T_IN) { int l = t / 960, r = t % 960, kt = r / 60, nt = r % 60;
      transpose_tile(lds, p.w_in + (size_t)l * DM * UW, p.norm_g + l * DM, p.wt_in + (size_t)l * UW * DM, DM, UW, kt * 64, nt * 64); }
    else if (t < T_IN + T_OUT) { int tt = t - T_IN; int l = tt / 320, r = tt % 320, kt = r / 16, nt = r % 16;
      transpose_tile(lds, p.w_out + (size_t)l * MIXW * DM, nullptr, p.wt_out + (size_t)l * DM * MIXW, MIXW, DM, kt * 64, nt * 64); }
    else { int tt = t - T_IN - T_OUT; int l = tt / 128, r = tt % 128, kt = r / 8, nt = r % 8;
      transpose_tile(lds, p.w_mem_kv + (size_t)l * DM * 512, p.mem_norm_g + l * DM, p.wt_mem + (size_t)l * 512 * DM, DM, 512, kt * 64, nt * 64); }
  }
  const int gw = blockIdx.x * 8 + (ltid() >> 6), nw = gridDim.x * 8;
  norm_rows(p.memp, p.memb, p.rstd_mem, 0, 2048, gw, nw);
  norm_rows(p.mems, p.memb, p.rstd_mem, 2048, 4096, gw, nw);
  norm_rows(p.xp, p.xb, p.rstd, 0, NTOKP, gw, nw);
  norm_rows(p.xs, p.xb, p.rstd, NTOKP, NTOK, gw, nw);
  const int gt = blockIdx.x * NTHREADS + ltid(), nt_ = gridDim.x * NTHREADS;
  for (int i = gt; i < 8192 * 32; i += nt_) { int pos = i >> 5, f = i & 31; float inv = powf(10000.f, -(float)(2 * f) / 64.f); float ang = (float)pos * inv; p.tab1c[i] = cosf(ang); p.tab1s[i] = sinf(ang); }
  for (int i = gt; i < 128 * 16; i += nt_) { int pos = i >> 4, f = i & 15; float inv = powf(10000.f, -(float)(2 * f) / 32.f); float ang = (float)pos * inv; p.tabac[i] = cosf(ang); p.tabas[i] = sinf(ang); }
  if (blockIdx.x == 0 && ltid() < 64) {
    const int lane = ltid();
    for (int o = 0; o < 2; ++o) {
      const float* lv = p.diff_lambda + o * 256;
      float a = lv[lane] * lv[64 + lane], b = lv[128 + lane] * lv[192 + lane];
#pragma unroll
      for (int s = 32; s > 0; s >>= 1) { a += shx(a, lane, s); b += shx(b, lane, s); }
      float li = 0.8f - 0.6f * expf(-0.3f * (float)(2 * o + 1));
      if (lane == 0) { p.lam[o * 2] = expf(a) - expf(b) + li; p.lam[o * 2 + 1] = 1.f - li; }
      float g0 = fabsf(p.ax_qk_g[o * 128 + lane]), g1 = fabsf(p.ax_qk_g[o * 128 + 64 + lane]);
      float g2 = fabsf(p.diff_qk_g[o * 128 + lane]), g3 = fabsf(p.diff_qk_g[o * 128 + 64 + lane]);
#pragma unroll
      for (int s = 32; s > 0; s >>= 1) { g0 = fmaxf(g0, shx(g0, lane, s)); g1 = fmaxf(g1, shx(g1, lane, s)); g2 = fmaxf(g2, shx(g2, lane, s)); g3 = fmaxf(g3, shx(g3, lane, s)); }
      if (lane == 0) { p.lam[8 + o * 2] = 8.f * g0 * g1 * 1.02f * LOG2E; p.lam[8 + o * 2 + 1] = 8.f * g2 * g3 * 1.02f * LOG2E; }
    }
  }
}

struct GemmDesc { const bf16_t* A; const bf16_t* Bt; int lda, K, mtiles, ntiles, remap, seg2; };
enum { EPI_IN = 0, EPI_MEM = 1, EPI_OUT = 2 };

DI void head_store(f32x16 v0, f32x16 v1, float rs, int mode, const float* gain, const Params& p, int pos, bf16_t* orow, int h) {
  v0 *= rs; v1 *= rs;
  if (mode) {
    float ss = 0.f;
#pragma unroll
    for (int i = 0; i < 16; ++i) ss += v0[i] * v0[i] + v1[i] * v1[i];
    ss = swapsum(ss);
    const float inv = rsqrtf(ss * (1.f / 64.f) + EPSF);
#pragma unroll
    for (int g4 = 0; g4 < 4; ++g4) {
      const f32x4 ga = *(const f32x4*)(gain + 8 * g4 + 4 * h), gb = *(const f32x4*)(gain + 32 + 8 * g4 + 4 * h);
#pragma unroll
      for (int j = 0; j < 4; ++j) { v0[4 * g4 + j] *= inv * ga[j]; v1[4 * g4 + j] *= inv * gb[j]; }
    }
    if (mode == 2) {
#pragma unroll
      for (int g4 = 0; g4 < 4; ++g4) {
        const f32x4 c = *(const f32x4*)(p.tab1c + pos * 32 + 8 * g4 + 4 * h), s = *(const f32x4*)(p.tab1s + pos * 32 + 8 * g4 + 4 * h);
#pragma unroll
        for (int j = 0; j < 4; ++j) { const int i = 4 * g4 + j; const float x1 = v0[i], x2 = v1[i]; v0[i] = x1 * c[j] - x2 * s[j]; v1[i] = x2 * c[j] + x1 * s[j]; }
      }
    } else if (mode == 3) {
      const int row = pos >> 6, col = pos & 63;
#pragma unroll
      for (int g4 = 0; g4 < 2; ++g4) {
        const f32x4 c0 = *(const f32x4*)(p.tabac + row * 16 + 8 * g4 + 4 * h), s0 = *(const f32x4*)(p.tabas + row * 16 + 8 * g4 + 4 * h);
        const f32x4 c1 = *(const f32x4*)(p.tabac + col * 16 + 8 * g4 + 4 * h), s1 = *(const f32x4*)(p.tabas + col * 16 + 8 * g4 + 4 * h);
#pragma unroll
        for (int j = 0; j < 4; ++j) { const int i = 4 * g4 + j;
          float x1 = v0[i], x2 = v0[i + 8]; v0[i] = x1 * c0[j] - x2 * s0[j]; v0[i + 8] = x2 * c0[j] + x1 * s0[j];
          x1 = v1[i]; x2 = v1[i + 8]; v1[i] = x1 * c1[j] - x2 * s1[j]; v1[i + 8] = x2 * c1[j] + x1 * s1[j]; }
      }
    }
  }
#pragma unroll
  for (int g4 = 0; g4 < 4; ++g4) {
    u32x2 w0, w1; w0.x = cvtpk(v0[4 * g4], v0[4 * g4 + 1]); w0.y = cvtpk(v0[4 * g4 + 2], v0[4 * g4 + 3]);
    w1.x = cvtpk(v1[4 * g4], v1[4 * g4 + 1]); w1.y = cvtpk(v1[4 * g4 + 2], v1[4 * g4 + 3]);
    *(u32x2*)(orow + 8 * g4 + 4 * h) = w0; *(u32x2*)(orow + 32 + 8 * g4 + 4 * h) = w1;
  }
}

DI int in_mode(const Params& p, int layer, int n_h, const float*& gain) {
  int mode = 0; gain = p.mem_qk_g;
  if ((layer & 1) == 0) { const int e = layer >> 1;
    if (n_h >= 1536 && n_h < 2048) { mode = 2; gain = p.swa_qk_g + (e * 2) * 64; }
    else if (n_h >= 2048 && n_h < 2176) { mode = 2; gain = p.swa_qk_g + (e * 2 + 1) * 64; }
    else if (n_h >= 2304 && n_h < 2560) { mode = 1; gain = p.mem_qk_g + (layer * 2) * 64; }
  } else { const int o = layer >> 1;
    if (n_h < 512) { mode = 3; gain = p.ax_qk_g + (o * 2) * 64; }
    else if (n_h < 640) { mode = 3; gain = p.ax_qk_g + (o * 2 + 1) * 64; }
    else if (n_h >= 768 && n_h < 1280) { mode = 2; gain = p.diff_qk_g + (o * 2) * 64; }
    else if (n_h >= 1280 && n_h < 1792) { mode = 2; gain = p.diff_qk_g + (o * 2 + 1) * 64; }
    else if (n_h >= 2304 && n_h < 2560) { mode = 1; gain = p.mem_qk_g + (layer * 2) * 64; }
  }
  return mode;
}

template <int EPI>
DI void gemm_phase(char* lds, const Params& p, const GemmDesc g, int layer) {
  const int tid = ltid(), lane = tid & 63, wid = tid >> 6, wm = wid >> 1, wn = wid & 1, r = lane & 31, h = lane >> 5;
  const int srow = tid >> 3, sch = tid & 7;
  const int soff = srow * 128 + ((sch ^ ((srow >> 1) & 7)) << 4);
  const int nk = g.K >> 6;
  const int ntile = g.mtiles * g.ntiles;
  const bool banded = ((gridDim.x & 7) == 0) && ((g.mtiles & 63) == 0);
  const int nx = banded ? 8 : 1, bx = blockIdx.x % nx, bi = blockIdx.x / nx, nbx = gridDim.x / nx;
  const int per_band = 8 * g.ntiles;
  const int qtot = ntile / nx;
  int q = bi;
  if (q >= qtot) return;
  int mt, nt;
#define G_TILE(qq, MT, NT) do { if (banded) { const int bl_ = (qq) / per_band, rem_ = (qq) - bl_ * per_band; NT = rem_ >> 3; MT = (bl_ * 8 + bx) * 8 + (rem_ & 7); } \
    else { MT = (qq) / g.ntiles; NT = (qq) - MT * g.ntiles; } } while (0)
#define G_LOAD(AG, BG, kt, RA, RB) do { const int k0_ = (kt) * 64; int ac_ = k0_; if (g.remap) ac_ = k0_ < 512 ? k0_ : (k0_ < 1024 ? g.seg2 + k0_ - 512 : 2304 + k0_ - 1024); \
    _Pragma("unroll") for (int i = 0; i < 4; ++i) { RA[i] = *(const u32x4*)(AG + (size_t)(64 * i) * g.lda + ac_); RB[i] = *(const u32x4*)(BG + (size_t)(64 * i) * g.K + k0_); } } while (0)
#define G_WRITE(buf, RA, RB) do { _Pragma("unroll") for (int i = 0; i < 4; ++i) { *(u32x4*)(lds + (buf) * 65536 + i * 8192 + soff) = RA[i]; *(u32x4*)(lds + (buf) * 65536 + 32768 + i * 8192 + soff) = RB[i]; } } while (0)
#define G_COMPUTE(buf) do { _Pragma("unroll") for (int ks = 0; ks < 4; ++ks) { const int co_ = ((2 * ks + h) ^ ((r >> 1) & 7)) << 4; \
      const char* la_ = lds + (buf) * 65536 + (wm * 64 + r) * 128 + co_; const char* lb_ = lds + (buf) * 65536 + 32768 + (wn * 128 + r) * 128 + co_; \
      bf16x8 fa_[2], fb_[4]; fa_[0] = *(const bf16x8*)(la_); fa_[1] = *(const bf16x8*)(la_ + 4096); \
      _Pragma("unroll") for (int ni = 0; ni < 4; ++ni) fb_[ni] = *(const bf16x8*)(lb_ + ni * 4096); \
      _Pragma("unroll") for (int ni = 0; ni < 4; ++ni) { acc[0][ni] = MFMA32(fb_[ni], fa_[0], acc[0][ni]); acc[1][ni] = MFMA32(fb_[ni], fa_[1], acc[1][ni]); } } } while (0)
  G_TILE(q, mt, nt);
  const bf16_t* Ag = g.A + (size_t)(mt * 256 + srow) * g.lda + sch * 8;
  const bf16_t* Bg = g.Bt + (size_t)(nt * 256 + srow) * g.K + sch * 8;
  u32x4 ra0[4], rb0[4];
  G_LOAD(Ag, Bg, 0, ra0, rb0); G_WRITE(0, ra0, rb0); __syncthreads();
  for (;;) {
    const int qn = q + nbx; const bool has_next = qn < qtot;
    int mtn = mt, ntn = nt; if (has_next) G_TILE(qn, mtn, ntn);
    const bf16_t* Agn = g.A + (size_t)(mtn * 256 + srow) * g.lda + sch * 8;
    const bf16_t* Bgn = g.Bt + (size_t)(ntn * 256 + srow) * g.K + sch * 8;
    f32x16 acc[2][4];
#pragma unroll
    for (int a = 0; a < 2; ++a)
#pragma unroll
      for (int b = 0; b < 4; ++b)
#pragma unroll
        for (int i = 0; i < 16; ++i) acc[a][b][i] = 0.f;
    for (int kt = 0; kt < nk; kt += 2) {
      const bool last = kt + 2 >= nk;
      G_LOAD(Ag, Bg, kt + 1, ra0, rb0);
      __builtin_amdgcn_sched_barrier(0);
      G_COMPUTE(0);
      G_WRITE(1, ra0, rb0);
      __syncthreads();
      if (!last) G_LOAD(Ag, Bg, kt + 2, ra0, rb0); else if (has_next) G_LOAD(Agn, Bgn, 0, ra0, rb0);
      __builtin_amdgcn_sched_barrier(0);
      G_COMPUTE(1);
      if (!last || has_next) G_WRITE(0, ra0, rb0);
      __syncthreads();
    }
    const int n_w = nt * 256 + wn * 128;
    if (EPI == EPI_IN) {
#pragma unroll
      for (int hu = 0; hu < 2; ++hu) {
        const int n_h = n_w + 64 * hu; const float* gain; const int mode = in_mode(p, layer, n_h, gain);
#pragma unroll
        for (int mi = 0; mi < 2; ++mi) {
          const int t = mt * 256 + wm * 64 + mi * 32 + r;
          int S, seq0, pos, sq; tok_info(t, S, seq0, pos, sq);
          head_store(acc[mi][2 * hu], acc[mi][2 * hu + 1], p.rstd[t], mode, gain, p, pos, p.u + (size_t)t * UW + n_h, h);
        }
      }
    } else if (EPI == EPI_MEM) {
#pragma unroll
      for (int hu = 0; hu < 2; ++hu) {
        const int n_h = n_w + 64 * hu, l = n_h >> 9, c = n_h & 511;
        const int mode = c < 256 ? 1 : 0; const float* gain = p.mem_qk_g + (l * 2 + 1) * 64;
#pragma unroll
        for (int mi = 0; mi < 2; ++mi) {
          const int row = mt * 256 + wm * 64 + mi * 32 + r;
          head_store(acc[mi][2 * hu], acc[mi][2 * hu + 1], p.rstd_mem[row], mode, gain, p, 0, p.memkv + (size_t)row * 2048 + n_h, h);
        }
      }
    } else {
#pragma unroll
      for (int mi = 0; mi < 2; ++mi) {
        const int t = mt * 256 + wm * 64 + mi * 32 + r;
        const float* xin = layer == 0 ? (t < NTOKP ? p.xp + (size_t)t * DM : p.xs + (size_t)(t - NTOKP) * DM) : p.out + (size_t)t * DM;
        float* xo = p.out + (size_t)t * DM;
#pragma unroll
        for (int ni = 0; ni < 4; ++ni)
#pragma unroll
          for (int g4 = 0; g4 < 4; ++g4) {
            const int n = n_w + ni * 32 + 8 * g4 + 4 * h;
            f32x4 xv = *(const f32x4*)(xin + n);
#pragma unroll
            for (int j = 0; j < 4; ++j) xv[j] += acc[mi][ni][4 * g4 + j];
            *(f32x4*)(xo + n) = xv;
          }
      }
    }
    if (!has_next) break;
    q = qn; mt = mtn; nt = ntn; Ag = Agn; Bg = Bgn;
  }
#undef G_TILE
#undef G_LOAD
#undef G_WRITE
#undef G_COMPUTE
}

enum { AM_PLAIN = 0, AM_SWA = 1, AM_DIFF = 2 };
struct AttnJob {
  const bf16_t* q;
  const bf16_t* k[2];
  const bf16_t* v;
  int ldk, ldv;
  int tile_lo, tile_hi;
  float m_init, l_init;
  int qpos0;
  bf16_t* o;
  const bf16_t* z;
  float lam, oscale;
  const float* subg;
  int dry;
};

template <int DV, int NK, int MODE, bool FIXM, int GRP>
DI void attn_job(char* lds_wg, const AttnJob& J) {
  constexpr int NDV = DV / 32;
  constexpr float C = 0.125f * LOG2E;
  const int tid_wg = ltid(), tid = tid_wg & (AT - 1), lane = tid & 63, wid = tid >> 6, r = lane & 31, h = lane >> 5;
  char* lds = lds_wg + GRP * 65536;
  const int kstream = (NK == 2) ? (wid & 1) : 0;
  bf16x8 qf[4];
  const bf16_t* qrow = J.q + (size_t)r * UW + 8 * h;
#pragma unroll
  for (int ds = 0; ds < 4; ++ds) qf[ds] = *(const bf16x8*)(qrow + 16 * ds);
  f32x16 O[NDV];
#pragma unroll
  for (int d = 0; d < NDV; ++d)
#pragma unroll
    for (int i = 0; i < 16; ++i) O[d][i] = 0.f;
  float m = J.m_init, l = (h == 0) ? J.l_init : 0.f;
  f32x16 Osum;
#pragma unroll
  for (int i = 0; i < 16; ++i) Osum[i] = 0.f;
  const bf16x8 ones = {0x3F80, 0x3F80, 0x3F80, 0x3F80, 0x3F80, 0x3F80, 0x3F80, 0x3F80};
  const int ksrow = tid >> 3, ksch = tid & 7;
  const int kpi = (ksrow & ~12) | ((ksrow & 4) << 1) | ((ksrow & 8) >> 1);
  const int ksoff = kpi * 128 + ((ksch ^ ((kpi >> 1) & 7)) << 4);
  constexpr int VCH = DV / 8;
  constexpr int VI = (64 * VCH) / AT;
  const int vkey0 = tid / VCH, vc8 = (tid % VCH) * 8;
  u32x4 rk0[NK][2], rv0[VI], rk1[NK][2], rv1[VI];
#define A_LOAD(t, rk, rv) do { const size_t kb_ = (size_t)(t) * 64; \
    _Pragma("unroll") for (int s = 0; s < NK; ++s) _Pragma("unroll") for (int i = 0; i < 2; ++i) rk[s][i] = *(const u32x4*)(J.k[s] + (kb_ + ksrow + 32 * i) * J.ldk + ksch * 8); \
    _Pragma("unroll") for (int i = 0; i < VI; ++i) rv[i] = *(const u32x4*)(J.v + (kb_ + vkey0 + (AT / VCH) * i) * J.ldv + vc8); } while (0)
#define A_WRITE(st, rk, rv) do { char* b_ = lds + (st) * 32768; \
    _Pragma("unroll") for (int s = 0; s < NK; ++s) _Pragma("unroll") for (int i = 0; i < 2; ++i) *(u32x4*)(b_ + s * 8192 + i * 4096 + ksoff) = rk[s][i]; \
    _Pragma("unroll") for (int i = 0; i < VI; ++i) { const int key_ = vkey0 + (AT / VCH) * i; \
      *(u32x4*)(b_ + NK * 8192 + ((key_ >> 3) * NDV + (vc8 >> 5)) * 512 + (key_ & 7) * 64 + (vc8 & 31) * 2) = rv[i]; } } while (0)
  const int nt = J.tile_hi - J.tile_lo;
  constexpr bool DEEP2 = FIXM || MODE != AM_DIFF;
  A_LOAD(J.tile_lo, rk0, rv0); A_WRITE(0, rk0, rv0); if (DEEP2) A_LOAD(J.tile_lo + 1, rk1, rv1); __syncthreads();
  const int i16 = lane & 15;
  const int vrd = h * NDV * 512 + (i16 >> 2) * 64 + (((lane >> 4) & 1) * 16 + (i16 & 3) * 4) * 2;
  auto compute = [&](const int stage, const int tile) __attribute__((always_inline)) {
    bool active = true;
    if (MODE == AM_SWA) { const int k0 = tile * 64; active = !(k0 > J.qpos0 + 31 + 128 || k0 + 63 < J.qpos0 - 128); }
    if (active) {
      const char* Kl = lds + stage * 32768 + kstream * 8192 + r * 128;
      f32x16 sA, sB;
#pragma unroll
      for (int i = 0; i < 16; ++i) { sA[i] = 0.f; sB[i] = 0.f; }
      if (NDV == 2) {
        bf16x8 ka[4], kb[4];
#pragma unroll
        for (int ds = 0; ds < 4; ++ds) { const int co = ((2 * ds + h) ^ ((r >> 1) & 7)) << 4; ka[ds] = *(const bf16x8*)(Kl + co); kb[ds] = *(const bf16x8*)(Kl + 4096 + co); }
#pragma unroll
        for (int ds = 0; ds < 4; ++ds) { sA = MFMA32(ka[ds], qf[ds], sA); sB = MFMA32(kb[ds], qf[ds], sB); }
        __builtin_amdgcn_sched_group_barrier(0x100, 4, 0); __builtin_amdgcn_sched_group_barrier(0x008, 2, 0);
        __builtin_amdgcn_sched_group_barrier(0x100, 2, 0); __builtin_amdgcn_sched_group_barrier(0x008, 2, 0);
        __builtin_amdgcn_sched_group_barrier(0x100, 2, 0); __builtin_amdgcn_sched_group_barrier(0x008, 4, 0);
      } else {
#pragma unroll
        for (int ds = 0; ds < 4; ++ds) {
          const int co = ((2 * ds + h) ^ ((r >> 1) & 7)) << 4;
          const bf16x8 ka = *(const bf16x8*)(Kl + co), kb = *(const bf16x8*)(Kl + 4096 + co);
          sA = MFMA32(ka, qf[ds], sA); sB = MFMA32(kb, qf[ds], sB);
        }
      }
      if (MODE == AM_SWA) {
        const int qa = J.qpos0 + r, kbase = tile * 64 + 8 * h;
#pragma unroll
        for (int i = 0; i < 16; ++i) {
          const int ka_ = kbase + 16 * (i >> 3) + (i & 7);
          int d0 = qa - ka_; d0 = d0 < 0 ? -d0 : d0; if (d0 > 128) sA[i] = -INFINITY;
          int d1 = qa - (ka_ + 32); d1 = d1 < 0 ? -d1 : d1; if (d1 > 128) sB[i] = -INFINITY;
        }
      }
      if (FIXM) {
        const float nm = -J.m_init;
#pragma unroll
        for (int i = 0; i < 16; ++i) { sA[i] = __builtin_amdgcn_exp2f(fmaf(sA[i], C, nm)); sB[i] = __builtin_amdgcn_exp2f(fmaf(sB[i], C, nm)); }
      } else {
      float mx = sA[0];
#pragma unroll
      for (int i = 1; i < 16; ++i) mx = fmaxf(mx, sA[i]);
#pragma unroll
      for (int i = 0; i < 16; ++i) mx = fmaxf(mx, sB[i]);
      mx = swapmax(mx);
      const float mn = fmaxf(m, mx * C);
      const float alpha = __builtin_amdgcn_exp2f(m - mn);
      m = mn;
      float ps = 0.f;
#pragma unroll
      for (int i = 0; i < 16; ++i) { sA[i] = __builtin_amdgcn_exp2f(fmaf(sA[i], C, -mn)); sB[i] = __builtin_amdgcn_exp2f(fmaf(sB[i], C, -mn)); ps += sA[i] + sB[i]; }
      l = l * alpha + ps;
#pragma unroll
      for (int d = 0; d < NDV; ++d)
#pragma unroll
        for (int i = 0; i < 16; ++i) O[d][i] *= alpha;
      }
      bf16x8 pf[4];
      { u32x4 w;
        w.x = cvtpk(sA[0], sA[1]); w.y = cvtpk(sA[2], sA[3]); w.z = cvtpk(sA[4], sA[5]); w.w = cvtpk(sA[6], sA[7]); pf[0] = __builtin_bit_cast(bf16x8, w);
        w.x = cvtpk(sA[8], sA[9]); w.y = cvtpk(sA[10], sA[11]); w.z = cvtpk(sA[12], sA[13]); w.w = cvtpk(sA[14], sA[15]); pf[1] = __builtin_bit_cast(bf16x8, w);
        w.x = cvtpk(sB[0], sB[1]); w.y = cvtpk(sB[2], sB[3]); w.z = cvtpk(sB[4], sB[5]); w.w = cvtpk(sB[6], sB[7]); pf[2] = __builtin_bit_cast(bf16x8, w);
        w.x = cvtpk(sB[8], sB[9]); w.y = cvtpk(sB[10], sB[11]); w.z = cvtpk(sB[12], sB[13]); w.w = cvtpk(sB[14], sB[15]); pf[3] = __builtin_bit_cast(bf16x8, w); }
      const char* Vl = lds + stage * 32768 + NK * 8192 + vrd;
      if (FIXM) {
#pragma unroll
        for (int ks = 0; ks < 4; ++ks) Osum = MFMA32(ones, pf[ks], Osum);
      }
#pragma unroll
      for (int ks = 0; ks < 4; ++ks)
#pragma unroll
        for (int d = 0; d < NDV; ++d) {
          const s16x4 lo = __builtin_amdgcn_ds_read_tr16_b64_v4i16((LAS s16x4*)(Vl + ks * 2 * NDV * 512 + d * 512));
          const s16x4 hi = __builtin_amdgcn_ds_read_tr16_b64_v4i16((LAS s16x4*)(Vl + ks * 2 * NDV * 512 + d * 512 + 256));
          const bf16x8 vf = __builtin_shufflevector(lo, hi, 0, 1, 2, 3, 4, 5, 6, 7);
          O[d] = MFMA32(vf, pf[ks], O[d]);
        }
    }
  };
  for (int it = 0; it < nt; it += 2) {
    if (DEEP2) {
      if (it + 2 < nt) A_LOAD(J.tile_lo + it + 2, rk0, rv0);
      compute(0, J.tile_lo + it);
      A_WRITE(1, rk1, rv1);
      __syncthreads();
      if (it + 3 < nt) A_LOAD(J.tile_lo + it + 3, rk1, rv1);
      compute(1, J.tile_lo + it + 1);
      if (it + 2 < nt) A_WRITE(0, rk0, rv0);
      __syncthreads();
    } else {
      compute(0, J.tile_lo + it);
      __builtin_amdgcn_sched_barrier(0);
      A_LOAD(J.tile_lo + it + 1, rk0, rv0); A_WRITE(1, rk0, rv0);
      __syncthreads();
      compute(1, J.tile_lo + it + 1);
      __builtin_amdgcn_sched_barrier(0);
      if (it + 2 < nt) { A_LOAD(J.tile_lo + it + 2, rk0, rv0); A_WRITE(0, rk0, rv0); }
      __syncthreads();
    }
  }
#undef A_LOAD
#undef A_WRITE
  if (J.dry) return;
  const float lt = FIXM ? Osum[0] : swapsum(l);
  const float inv = 1.f / lt;
  if (MODE != AM_DIFF) {
    bf16_t* orow = J.o + (size_t)r * UW; const bf16_t* zrow = J.z + (size_t)r * UW;
#pragma unroll
    for (int d = 0; d < NDV; ++d)
#pragma unroll
      for (int g4 = 0; g4 < 4; ++g4) {
        const int dv = 32 * d + 8 * g4 + 4 * h;
        const u32x2 zw = *(const u32x2*)(zrow + dv);
        const float y0 = O[d][4 * g4] * inv * silu(bflo(zw.x)), y1 = O[d][4 * g4 + 1] * inv * silu(bfhi(zw.x));
        const float y2 = O[d][4 * g4 + 2] * inv * silu(bflo(zw.y)), y3 = O[d][4 * g4 + 3] * inv * silu(bfhi(zw.y));
        u32x2 w; w.x = cvtpk(y0, y1); w.y = cvtpk(y2, y3);
        *(u32x2*)(orow + dv) = w;
      }
  } else {
    float* sc = (float*)(lds + 32768) + (wid >> 1) * (DV * 32);
    if (wid & 1) {
      const float f = inv * J.lam;
#pragma unroll
      for (int d = 0; d < NDV; ++d)
#pragma unroll
        for (int i = 0; i < 16; ++i) sc[(32 * d + crow(i, h)) * 32 + r] = O[d][i] * f;
    }
    __syncthreads();
    if (!(wid & 1)) {
      float ss = 0.f;
#pragma unroll
      for (int d = 0; d < NDV; ++d)
#pragma unroll
        for (int i = 0; i < 16; ++i) { const float a = O[d][i] * inv - sc[(32 * d + crow(i, h)) * 32 + r]; O[d][i] = a; ss += a * a; }
      ss = swapsum(ss);
      const float rn = rsqrtf(ss * (1.f / DV) + EPSF) * J.oscale;
      bf16_t* orow = J.o + (size_t)r * UW; const bf16_t* zrow = J.z + (size_t)r * UW;
#pragma unroll
      for (int d = 0; d < NDV; ++d)
#pragma unroll
        for (int g4 = 0; g4 < 4; ++g4) {
          const int dv = 32 * d + 8 * g4 + 4 * h;
          const u32x2 zw = *(const u32x2*)(zrow + dv);
          const f32x4 sg = *(const f32x4*)(J.subg + dv);
          const float y0 = O[d][4 * g4] * rn * sg[0] * silu(bflo(zw.x)), y1 = O[d][4 * g4 + 1] * rn * sg[1] * silu(bfhi(zw.x));
          const float y2 = O[d][4 * g4 + 2] * rn * sg[2] * silu(bflo(zw.y)), y3 = O[d][4 * g4 + 3] * rn * sg[3] * silu(bfhi(zw.y));
          u32x2 w; w.x = cvtpk(y0, y1); w.y = cvtpk(y2, y3);
          *(u32x2*)(orow + dv) = w;
        }
    }
  }
}

#define ATTN_CALL(DV, NK, MODE, FIXM) do { if (grp) attn_job<DV, NK, MODE, FIXM, 1>(lds, J); else attn_job<DV, NK, MODE, FIXM, 0>(lds, J); } while (0)
DI void mem_jobs(char* lds, const Params& p, int layer, int dry) {
  const int grp = __builtin_amdgcn_readfirstlane(ltid() >> 8);
  const int wid = (ltid() >> 6) & 3, vb = blockIdx.x * 2 + grp, vg = gridDim.x * 2;
  for (int job = vb; job < 768 * 4; job += vg) {
    const int qb = job >> 2, hm = job & 3, t0 = qb * 128;
    int S, seq0, pos, sq; tok_info(t0, S, seq0, pos, sq);
    AttnJob J;
    bf16_t* qo = p.u + (size_t)(t0 + 32 * wid) * UW + 2304 + hm * 64;
    J.q = qo; J.o = qo; J.z = p.u + (size_t)(t0 + 32 * wid) * UW + 2560 + 1024 + hm * 64;
    J.k[0] = J.k[1] = p.memkv + (size_t)(sq * 256) * 2048 + layer * 512 + hm * 64; J.v = J.k[0] + 256; J.ldk = J.ldv = 2048;
    J.tile_lo = 0; J.tile_hi = 4; J.m_init = -1e30f; J.l_init = 0.f; J.qpos0 = 0; J.lam = 0.f; J.oscale = 0.f; J.subg = nullptr; J.dry = dry;
    ATTN_CALL(64, 1, AM_PLAIN, false);
  }
}

DI void phase_mix_even(char* lds, const Params& p, int layer, int dry) {
  const int grp = __builtin_amdgcn_readfirstlane(ltid() >> 8);
  const int e = layer >> 1, wid = (ltid() >> 6) & 3, vb = blockIdx.x * 2 + grp, vg = gridDim.x * 2;
  for (int job = vb; job < 768 * 8; job += vg) {
    const int qb = job >> 3, hq = job & 7, kvh = hq >> 2, t0 = qb * 128;
    int S, seq0, pos, sq; tok_info(t0, S, seq0, pos, sq);
    AttnJob J;
    bf16_t* qo = p.u + (size_t)(t0 + 32 * wid) * UW + 1536 + hq * 64;
    J.q = qo; J.o = qo; J.z = p.u + (size_t)(t0 + 32 * wid) * UW + 2560 + 512 + hq * 64;
    J.k[0] = J.k[1] = p.u + (size_t)seq0 * UW + 2048 + kvh * 64; J.v = p.u + (size_t)seq0 * UW + 2176 + kvh * 64; J.ldk = J.ldv = UW;
    const int pt = pos >> 6;
    J.tile_lo = pt - 2 < 0 ? 0 : pt - 2; J.tile_hi = pt + 4 > (S >> 6) ? (S >> 6) : pt + 4;
    J.m_init = p.swa_sink[e * 8 + hq] * LOG2E; J.l_init = 1.f; J.qpos0 = pos + 32 * wid; J.lam = 0.f; J.oscale = 0.f; J.subg = nullptr; J.dry = dry;
    ATTN_CALL(64, 1, AM_SWA, false);
  }
  mem_jobs(lds, p, layer, dry);
  const float* cw = p.conv_w + e * 3 * 512;
  for (int idx = blockIdx.x * NTHREADS + ltid(); idx < NTOK * 64; idx += gridDim.x * NTHREADS) {
    const int t = idx >> 6, c0 = (idx & 63) * 8;
    int S, seq0, pos, sq; tok_info(t, S, seq0, pos, sq);
    bf16_t* ur = p.u + (size_t)t * UW;
    float ic[8], il[8], ir[8];
    { const u32x4 a = *(const u32x4*)(ur + 512 + c0), b = *(const u32x4*)(ur + 1024 + c0);
#pragma unroll
      for (int j = 0; j < 4; ++j) { ic[2 * j] = bflo(a[j]) * bflo(b[j]); ic[2 * j + 1] = bfhi(a[j]) * bfhi(b[j]); } }
    if (pos > 0) { const u32x4 a = *(const u32x4*)(ur - UW + 512 + c0), b = *(const u32x4*)(ur - UW + 1024 + c0);
#pragma unroll
      for (int j = 0; j < 4; ++j) { il[2 * j] = bflo(a[j]) * bflo(b[j]); il[2 * j + 1] = bfhi(a[j]) * bfhi(b[j]); } }
    else {
#pragma unroll
      for (int j = 0; j < 8; ++j) il[j] = 0.f; }
    if (pos < S - 1) { const u32x4 a = *(const u32x4*)(ur + UW + 512 + c0), b = *(const u32x4*)(ur + UW + 1024 + c0);
#pragma unroll
      for (int j = 0; j < 4; ++j) { ir[2 * j] = bflo(a[j]) * bflo(b[j]); ir[2 * j + 1] = bfhi(a[j]) * bfhi(b[j]); } }
    else {
#pragma unroll
      for (int j = 0; j < 8; ++j) ir[j] = 0.f; }
    const u32x4 gbw = *(const u32x4*)(ur + c0), zw = *(const u32x4*)(ur + 2560 + c0);
    float y[8];
#pragma unroll
    for (int j = 0; j < 8; ++j) {
      const float gb = (j & 1) ? bfhi(gbw[j >> 1]) : bflo(gbw[j >> 1]);
      const float z = (j & 1) ? bfhi(zw[j >> 1]) : bflo(zw[j >> 1]);
      const float cv = il[j] * cw[c0 + j] + ic[j] * cw[512 + c0 + j] + ir[j] * cw[1024 + c0 + j];
      y[j] = gb * cv * silu(z);
    }
    u32x4 w; w.x = cvtpk(y[0], y[1]); w.y = cvtpk(y[2], y[3]); w.z = cvtpk(y[4], y[5]); w.w = cvtpk(y[6], y[7]);
    if (!dry) *(u32x4*)(ur + c0) = w;
  }
}

DI void phase_mix_odd(char* lds, const Params& p, int layer, int dry) {
  const int grp = __builtin_amdgcn_readfirstlane(ltid() >> 8);
  const int o = layer >> 1, wid = (ltid() >> 6) & 3;
  const int nx = (gridDim.x & 7) == 0 ? 8 : 1, bx = blockIdx.x % nx, bi = (blockIdx.x / nx) * 2 + grp, nbx = (gridDim.x / nx) * 2;
  const float mb_dense = p.lam[8 + o * 2], mb_diff = p.lam[8 + o * 2 + 1];
  const bool fix_dense = mb_dense < 43.f, fix_diff = mb_diff < 43.f;
#pragma unroll 1
  for (int part = 0; part < 2; ++part) {
    const int gshift = part ? 7 : 8, nv = (16 / nx) << gshift;
#pragma unroll 1
    for (int v = bi; v < nv; v += nbx) {
      const int j = ((bx + nx * (v >> gshift)) << gshift) + (v & ((1 << gshift) - 1));
      int g, qb, kvh, seq0, S;
      if (!part) { g = j & 3; qb = (j >> 2) & 63; kvh = (j >> 8) & 1; seq0 = (j >> 9) * 8192; S = 8192; }
      else { g = j & 3; qb = (j >> 2) & 31; kvh = (j >> 7) & 1; seq0 = NTOKP + (j >> 8) * 4096; S = 4096; }
      const int hq = kvh * 4 + g, t0 = seq0 + qb * 128 + 32 * wid;
      AttnJob J;
      bf16_t* qo = p.u + (size_t)t0 * UW + hq * 64;
      J.q = qo; J.o = qo; J.z = p.u + (size_t)t0 * UW + 2560 + hq * 64;
      J.k[0] = J.k[1] = p.u + (size_t)seq0 * UW + 512 + kvh * 64; J.v = p.u + (size_t)seq0 * UW + 640 + kvh * 64; J.ldk = J.ldv = UW;
      J.tile_lo = 0; J.tile_hi = S >> 6; J.l_init = 0.f; J.qpos0 = 0; J.lam = 0.f; J.oscale = 0.f; J.subg = nullptr; J.dry = dry;
      if (fix_dense) { J.m_init = mb_dense; ATTN_CALL(64, 1, AM_PLAIN, true); }
      else { J.m_init = -1e30f; ATTN_CALL(64, 1, AM_PLAIN, false); }
    }
  }
  const float lam = p.lam[o * 2], osc = p.lam[o * 2 + 1];
#pragma unroll 1
  for (int part = 0; part < 2; ++part) {
    const int gshift = part ? 6 : 7, nv = (32 / nx) << gshift;
#pragma unroll 1
    for (int v = bi; v < nv; v += nbx) {
      const int j = ((bx + nx * (v >> gshift)) << gshift) + (v & ((1 << gshift) - 1));
      int qb, hh, seq0, S;
      if (!part) { qb = j & 127; hh = (j >> 7) & 3; seq0 = (j >> 9) * 8192; S = 8192; }
      else { qb = j & 63; hh = (j >> 6) & 3; seq0 = NTOKP + (j >> 8) * 4096; S = 4096; }
      const int mp = wid & 1, sub = wid >> 1, t0 = seq0 + qb * 64 + sub * 32;
      AttnJob J;
      J.q = p.u + (size_t)t0 * UW + 768 + (2 * hh + mp) * 64;
      J.o = p.u + (size_t)t0 * UW + 768 + hh * 128; J.z = p.u + (size_t)t0 * UW + 2560 + 512 + hh * 128;
      J.k[0] = p.u + (size_t)seq0 * UW + 1280 + (2 * hh) * 64; J.k[1] = J.k[0] + 64; J.v = p.u + (size_t)seq0 * UW + 1792 + hh * 128; J.ldk = J.ldv = UW;
      J.tile_lo = 0; J.tile_hi = S >> 6; J.l_init = 0.f; J.qpos0 = 0; J.lam = lam; J.oscale = osc; J.subg = p.diff_subln_g + o * 128; J.dry = dry;
      if (fix_diff) { J.m_init = mb_diff; ATTN_CALL(128, 2, AM_DIFF, true); }
      else { J.m_init = -1e30f; ATTN_CALL(128, 2, AM_DIFF, false); }
    }
  }
  mem_jobs(lds, p, layer, dry);
}

DI void phase_norm(const Params& p) {
  const int gw = blockIdx.x * 8 + (ltid() >> 6), nw = gridDim.x * 8;
  norm_rows(p.out, p.xb, p.rstd, 0, NTOK, gw, nw);
}

__global__ void __launch_bounds__(NTHREADS, 2) fwd_kernel(Params p) {
  __shared__ __attribute__((aligned(16))) char lds[LDS_BYTES];
  int ph = p.phase_lo;
  if (ph == 0) {
    phase_prep(lds, p);
    ph = 1;
#if !MULTI_LAUNCH
    if (ph < p.phase_hi) cg::this_grid().sync();
#endif
  }
  for (; ph < p.phase_hi; ++ph) {
    {
      const int l = (ph - 1) >> 2, s = (ph - 1) & 3;
      if (s == 0) {
        if (l == 0) { GemmDesc g{p.memb, p.wt_mem, DM, DM, 16, 8, 0, 0}; gemm_phase<EPI_MEM>(lds, p, g, 0); }
        GemmDesc g{p.xb, p.wt_in + (size_t)l * UW * DM, DM, DM, NTOK / 256, UW / 256, 0, 0};
        const int nrep = ((p.probe >> 2) & 1) + 1;
#pragma unroll 1
        for (int rep = 0; rep < nrep; ++rep) gemm_phase<EPI_IN>(lds, p, g, l);
      } else if (s == 1) {
        const int nrep = ((l & 1) ? (p.probe & 1) : ((p.probe >> 1) & 1)) + 1;
#pragma unroll 1
        for (int rep = 0; rep < nrep; ++rep) {
          const int dry = rep + 1 < nrep;
          if (l & 1) phase_mix_odd(lds, p, l, dry); else phase_mix_even(lds, p, l, dry);
        }
      } else if (s == 2) {
        GemmDesc g{p.u, p.wt_out + (size_t)l * DM * MIXW, UW, MIXW, NTOK / 256, DM / 256, 1, (l & 1) ? 768 : 1536};
        gemm_phase<EPI_OUT>(lds, p, g, l);
      } else phase_norm(p);
    }
#if !MULTI_LAUNCH
    if (ph + 1 < p.phase_hi) cg::this_grid().sync();
#endif
  }
}

extern "C" void kernel_launch(void* const* d_in, const int* in_sizes, int n_in, void* d_out, int out_size, void* d_ws, size_t ws_size,
                              hipStream_t stream) {
  static int grid_blocks = 0;
  if (!grid_blocks) {
    int dev = 0, cus = 0, per_cu = 0;
    hipGetDevice(&dev);
    hipDeviceGetAttribute(&cus, hipDeviceAttributeMultiprocessorCount, dev);
    hipOccupancyMaxActiveBlocksPerMultiprocessor(&per_cu, fwd_kernel, NTHREADS, 0);
    if (per_cu > 1) per_cu = 1;
    if (per_cu < 1) per_cu = 1;
    grid_blocks = cus * per_cu;
  }
  Params p{};
  p.xp = (const float*)d_in[0]; p.xs = (const float*)d_in[1]; p.memp = (const float*)d_in[2]; p.mems = (const float*)d_in[3];
  p.norm_g = (const float*)d_in[4]; p.w_in = (const float*)d_in[5]; p.w_out = (const float*)d_in[6]; p.mem_norm_g = (const float*)d_in[7];
  p.w_mem_kv = (const float*)d_in[8]; p.mem_qk_g = (const float*)d_in[9]; p.conv_w = (const float*)d_in[10]; p.swa_qk_g = (const float*)d_in[11];
  p.swa_sink = (const float*)d_in[12]; p.ax_qk_g = (const float*)d_in[13]; p.diff_qk_g = (const float*)d_in[14]; p.diff_lambda = (const float*)d_in[15];
  p.diff_subln_g = (const float*)d_in[16];
  p.out = (float*)d_out;
  char* w = (char*)d_ws; size_t off = 0;
  auto take = [&](size_t bytes) { char* r = w + off; off += (bytes + 255) & ~(size_t)255; return r; };
  p.u = (bf16_t*)take((size_t)NTOK * UW * 2);
  p.xb = (bf16_t*)take((size_t)NTOK * DM * 2);
  p.wt_in = (bf16_t*)take((size_t)4 * UW * DM * 2);
  p.wt_out = (bf16_t*)take((size_t)4 * DM * MIXW * 2);
  p.wt_mem = (bf16_t*)take((size_t)2048 * DM * 2);
  p.memb = (bf16_t*)take((size_t)4096 * DM * 2);
  p.memkv = (bf16_t*)take((size_t)4096 * 2048 * 2);
  p.rstd = (float*)take((size_t)NTOK * 4);
  p.rstd_mem = (float*)take(4096 * 4);
  p.tab1c = (float*)take(8192 * 32 * 4); p.tab1s = (float*)take(8192 * 32 * 4);
  p.tabac = (float*)take(128 * 16 * 4); p.tabas = (float*)take(128 * 16 * 4);
  p.lam = (float*)take(256);
  if (off > ws_size) { fprintf(stderr, "workspace too small: need %zu have %zu\n", off, ws_size); return; }
#if MULTI_LAUNCH
  for (int ph = 0; ph < NPHASE; ++ph) {
    p.phase_lo = ph; p.phase_hi = ph + 1;
    hipLaunchKernelGGL(fwd_kernel, dim3(grid_blocks), dim3(NTHREADS), 0, stream, p);
  }
#else
  p.phase_lo = 0; p.phase_hi = NPHASE; p.probe = PROBE_ODD | (PROBE_EVEN << 1) | (PROBE_GIN << 2);
  void* args[] = {&p};
  hipError_t e = hipLaunchCooperativeKernel((void*)fwd_kernel, dim3(grid_blocks), dim3(NTHREADS), args, 0, stream);
  if (e != hipSuccess) fprintf(stderr, "cooperative launch failed: %s (grid %d)\n", hipGetErrorString(e), grid_blocks);
#endif
}
```

```cpp
#include <hip/hip_runtime.h>
#include <hip/hip_cooperative_groups.h>
#include <cstdint>
#include <cstdio>
namespace cg = cooperative_groups;

#ifndef MULTI_LAUNCH
#define MULTI_LAUNCH 0
#endif

#ifndef PROBE_ODD
#define PROBE_ODD 0
#endif
#ifndef PROBE_EVEN
#define PROBE_EVEN 0
#endif
#ifndef PROBE_GIN
#define PROBE_GIN 0
#endif
#define DI __device__ __forceinline__
#define LAS __attribute__((address_space(3)))
typedef unsigned short bf16_t;
typedef short bf16x8 __attribute__((ext_vector_type(8)));
typedef short s16x4 __attribute__((ext_vector_type(4)));
typedef float f32x16 __attribute__((ext_vector_type(16)));
typedef float f32x4 __attribute__((ext_vector_type(4)));
typedef unsigned u32x4 __attribute__((ext_vector_type(4)));
typedef unsigned u32x2 __attribute__((ext_vector_type(2)));

constexpr int NTOK = 98304, NTOKP = 65536, UW = 3840, DM = 1024, MIXW = 1280;
constexpr int NTHREADS = 512;
constexpr int AT = 256;
constexpr int LDS_BYTES = 131072 + 32768;
constexpr float EPSF = 1e-6f;
constexpr float LOG2E = 1.4426950408889634f;
constexpr int NPHASE = 16;

struct Params {
  const float *xp, *xs, *memp, *mems, *norm_g, *w_in, *w_out, *mem_norm_g, *w_mem_kv, *mem_qk_g, *conv_w, *swa_qk_g,
      *swa_sink, *ax_qk_g, *diff_qk_g, *diff_lambda, *diff_subln_g;
  float* out;
  bf16_t *u, *xb, *wt_in, *wt_out, *wt_mem, *memb, *memkv;
  float *rstd, *rstd_mem, *tab1c, *tab1s, *tabac, *tabas, *lam;
  int phase_lo, phase_hi, probe, pad_;
};

typedef __bf16 bf16x2_t __attribute__((ext_vector_type(2)));
typedef float f32x2 __attribute__((ext_vector_type(2)));
DI unsigned cvtpk(float lo, float hi) { f32x2 v = {lo, hi}; bf16x2_t b = __builtin_convertvector(v, bf16x2_t); return __builtin_bit_cast(unsigned, b); }
DI float bf2f(unsigned short b) { return __uint_as_float(((unsigned)b) << 16); }
DI float bflo(unsigned w) { return __uint_as_float(w << 16); }
DI float bfhi(unsigned w) { return __uint_as_float(w & 0xffff0000u); }
DI int ltid() { int t; asm volatile("v_mov_b32 %0, %1" : "=v"(t) : "v"(threadIdx.x)); return t; }
DI int crow(int i, int h) { return (i & 3) + 8 * (i >> 2) + 4 * h; }
DI float swapmax(float v) { auto rr = __builtin_amdgcn_permlane32_swap(__float_as_uint(v), __float_as_uint(v), false, false); return fmaxf(__uint_as_float(rr[0]), __uint_as_float(rr[1])); }
DI float swapsum(float v) { auto rr = __builtin_amdgcn_permlane32_swap(__float_as_uint(v), __float_as_uint(v), false, false); return __uint_as_float(rr[0]) + __uint_as_float(rr[1]); }
DI float shx(float v, int lane, int o) { return __int_as_float(__builtin_amdgcn_ds_bpermute(((lane ^ o) & 63) << 2, __float_as_int(v))); }
DI float silu(float z) { return z / (1.f + __expf(-z)); }
#define MFMA32(a, b, c) __builtin_amdgcn_mfma_f32_32x32x16_bf16((a), (b), (c), 0, 0, 0)

DI void tok_info(int t, int& S, int& seq0, int& pos, int& sq) {
  if (t < NTOKP) { S = 8192; seq0 = t & ~8191; pos = t & 8191; sq = t >> 13; }
  else { int tt = t - NTOKP; S = 4096; seq0 = NTOKP + (tt & ~4095); pos = tt & 4095; sq = 8 + (tt >> 12); }
}

DI void transpose_tile(char* lds, const float* src, const float* g, bf16_t* dst, int K, int N, int k0, int n0) {
  float* tile = (float*)lds;
  const int tid = ltid(), a = tid >> 6, b = tid & 63;
#pragma unroll 4
  for (int i = 0; i < 8; ++i) { int kk = i * 8 + a; float v = src[(size_t)(k0 + kk) * N + n0 + b]; if (g) v *= g[k0 + kk]; tile[kk * 65 + b] = v; }
  __syncthreads();
#pragma unroll 4
  for (int i = 0; i < 8; ++i) { int nn = i * 8 + a; float v = tile[b * 65 + nn]; dst[(size_t)(n0 + nn) * K + k0 + b] = (bf16_t)(cvtpk(v, v) & 0xffffu); }
  __syncthreads();
}

DI void norm_rows(const float* src, bf16_t* dst, float* rstd, int row_begin, int row_end, int gw, int nw) {
  const int lane = ltid() & 63;
  for (int row = row_begin + gw; row < row_end; row += nw) {
    const float* s = src + (size_t)(row - row_begin) * DM; bf16_t* d = dst + (size_t)row * DM;
    f32x4 v[4]; float ss = 0.f;
#pragma unroll
    for (int j = 0; j < 4; ++j) { v[j] = *(const f32x4*)(s + (lane + 64 * j) * 4); ss += v[j][0] * v[j][0] + v[j][1] * v[j][1] + v[j][2] * v[j][2] + v[j][3] * v[j][3]; }
#pragma unroll
    for (int o = 32; o > 0; o >>= 1) ss += shx(ss, lane, o);
    const float rs = rsqrtf(ss * (1.f / DM) + EPSF);
#pragma unroll
    for (int j = 0; j < 4; ++j) { u32x2 w; w.x = cvtpk(v[j][0] * rs, v[j][1] * rs); w.y = cvtpk(v[j][2] * rs, v[j][3] * rs); *(u32x2*)(d + (lane + 64 * j) * 4) = w; }
  }
}

DI void phase_prep(char* lds, const Params& p) {
  const int T_IN = 4 * 16 * 60, T_OUT = 4 * 20 * 16, T_MEM = 4 * 16 * 8;
  for (int t = blockIdx.x; t < T_IN + T_OUT + T_MEM; t += gridDim.x) {
    if (t < T_IN) { int l = t / 960, r = t % 960, kt = r / 60, nt = r % 60;
      transpose_tile(lds, p.w_in + (size_t)l * DM * UW, p.norm_g + l * DM, p.wt_in + (size_t)l * UW * DM, DM, UW, kt * 64, nt * 64); }
    else if (t < T_IN + T_OUT) { int tt = t - T_IN; int l = tt / 320, r = tt % 320, kt = r / 16, nt = r % 16;
      transpose_tile(lds, p.w_out + (size_t)l * MIXW * DM, nullptr, p.wt_out + (size_t)l * DM * MIXW, MIXW, DM, kt * 64, nt * 64); }
    else { int tt = t - T_IN - T_OUT; int l = tt / 128, r = tt % 128, kt = r / 8, nt = r % 8;
      transpose_tile(lds, p.w_mem_kv + (size_t)l * DM * 512, p.mem_norm_g + l * DM, p.wt_mem + (size_t)l * 512 * DM, DM, 512, kt * 64, nt * 64); }
  }
  const int gw = blockIdx.x * 8 + (ltid() >> 6), nw = gridDim.x * 8;
  norm_rows(p.memp, p.memb, p.rstd_mem, 0, 2048, gw, nw);
  norm_rows(p.mems, p.memb, p.rstd_mem, 2048, 4096, gw, nw);
  norm_rows(p.xp, p.xb, p.rstd, 0, NTOKP, gw, nw);
  norm_rows(p.xs, p.xb, p.rstd, NTOKP, NTOK, gw, nw);
  const int gt = blockIdx.x * NTHREADS + ltid(), nt_ = gridDim.x * NTHREADS;
  for (int i = gt; i < 8192 * 32; i += nt_) { int pos = i >> 5, f = i & 31; float inv = powf(10000.f, -(float)(2 * f) / 64.f); float ang = (float)pos * inv; p.tab1c[i] = cosf(ang); p.tab1s[i] = sinf(ang); }
  for (int i = gt; i < 128 * 16; i += nt_) { int pos = i >> 4, f = i & 15; float inv = powf(10000.f, -(float)(2 * f) / 32.f); float ang = (float)pos * inv; p.tabac[i] = cosf(ang); p.tabas[i] = sinf(ang); }
  if (blockIdx.x == 0 && ltid() < 64) {
    const int lane = ltid();
    for (int o = 0; o < 2; ++o) {
      const float* lv = p.diff_lambda + o * 256;
      float a = lv[lane] * lv[64 + lane], b = lv[128 + lane] * lv[192 + lane];
#pragma unroll
      for (int s = 32; s > 0; s >>= 1) { a += shx(a, lane, s); b += shx(b, lane, s); }
      float li = 0.8f - 0.6f * expf(-0.3f * (float)(2 * o + 1));
      if (lane == 0) { p.lam[o * 2] = expf(a) - expf(b) + li; p.lam[o * 2 + 1] = 1.f - li; }
      float g0 = fabsf(p.ax_qk_g[o * 128 + lane]), g1 = fabsf(p.ax_qk_g[o * 128 + 64 + lane]);
      float g2 = fabsf(p.diff_qk_g[o * 128 + lane]), g3 = fabsf(p.diff_qk_g[o * 128 + 64 + lane]);
#pragma unroll
      for (int s = 32; s > 0; s >>= 1) { g0 = fmaxf(g0, shx(g0, lane, s)); g1 = fmaxf(g1, shx(g1, lane, s)); g2 = fmaxf(g2, shx(g2, lane, s)); g3 = fmaxf(g3, shx(g3, lane, s)); }
      if (lane == 0) { p.lam[8 + o * 2] = 8.f * g0 * g1 * 1.02f * LOG2E; p.lam[8 + o * 2 + 1] = 8.f * g2 * g3 * 1.02f * LOG2E; }
    }
  }
}

struct GemmDesc { const bf16_t* A; const bf16_t* Bt; int lda, K, mtiles, ntiles, remap, seg2; };
enum { EPI_IN = 0, EPI_MEM = 1, EPI_OUT = 2 };

DI void head_store(f32x16 v0, f32x16 v1, float rs, int mode, const float* gain, const Params& p, int pos, bf16_t* obase, int ldo, char* stg_wg) {
  const int tid_ = ltid(), lane = tid_ & 63, r = lane & 31, h = lane >> 5;
  char* stg = stg_wg + (tid_ >> 6) * 4096;
  v0 *= rs; v1 *= rs;
  if (mode) {
    float ss = 0.f;
#pragma unroll
    for (int i = 0; i < 16; ++i) ss += v0[i] * v0[i] + v1[i] * v1[i];
    ss = swapsum(ss);
    const float inv = rsqrtf(ss * (1.f / 64.f) + EPSF);
#pragma unroll
    for (int g4 = 0; g4 < 4; ++g4) {
      const f32x4 ga = *(const f32x4*)(gain + 8 * g4 + 4 * h), gb = *(const f32x4*)(gain + 32 + 8 * g4 + 4 * h);
#pragma unroll
      for (int j = 0; j < 4; ++j) { v0[4 * g4 + j] *= inv * ga[j]; v1[4 * g4 + j] *= inv * gb[j]; }
    }
    if (mode == 2) {
#pragma unroll
      for (int g4 = 0; g4 < 4; ++g4) {
        const f32x4 c = *(const f32x4*)(p.tab1c + pos * 32 + 8 * g4 + 4 * h), s = *(const f32x4*)(p.tab1s + pos * 32 + 8 * g4 + 4 * h);
#pragma unroll
        for (int j = 0; j < 4; ++j) { const int i = 4 * g4 + j; const float x1 = v0[i], x2 = v1[i]; v0[i] = x1 * c[j] - x2 * s[j]; v1[i] = x2 * c[j] + x1 * s[j]; }
      }
    } else if (mode == 3) {
      const int row = pos >> 6, col = pos & 63;
#pragma unroll
      for (int g4 = 0; g4 < 2; ++g4) {
        const f32x4 c0 = *(const f32x4*)(p.tabac + row * 16 + 8 * g4 + 4 * h), s0 = *(const f32x4*)(p.tabas + row * 16 + 8 * g4 + 4 * h);
        const f32x4 c1 = *(const f32x4*)(p.tabac + col * 16 + 8 * g4 + 4 * h), s1 = *(const f32x4*)(p.tabas + col * 16 + 8 * g4 + 4 * h);
#pragma unroll
        for (int j = 0; j < 4; ++j) { const int i = 4 * g4 + j;
          float x1 = v0[i], x2 = v0[i + 8]; v0[i] = x1 * c0[j] - x2 * s0[j]; v0[i + 8] = x2 * c0[j] + x1 * s0[j];
          x1 = v1[i]; x2 = v1[i + 8]; v1[i] = x1 * c1[j] - x2 * s1[j]; v1[i + 8] = x2 * c1[j] + x1 * s1[j]; }
      }
    }
  }
#pragma unroll
  for (int g4 = 0; g4 < 4; ++g4) {
    u32x2 w0, w1; w0.x = cvtpk(v0[4 * g4], v0[4 * g4 + 1]); w0.y = cvtpk(v0[4 * g4 + 2], v0[4 * g4 + 3]);
    w1.x = cvtpk(v1[4 * g4], v1[4 * g4 + 1]); w1.y = cvtpk(v1[4 * g4 + 2], v1[4 * g4 + 3]);
    *(u32x2*)(stg + r * 128 + ((g4 ^ (r & 7)) << 4) + h * 8) = w0;
    *(u32x2*)(stg + r * 128 + (((4 + g4) ^ (r & 7)) << 4) + h * 8) = w1;
  }
#pragma unroll
  for (int j = 0; j < 4; ++j) {
    const int row = (lane >> 3) + 8 * j, ch = lane & 7;
    const u32x4 w = *(const u32x4*)(stg + row * 128 + ((ch ^ (row & 7)) << 4));
    *(u32x4*)(obase + (size_t)row * ldo + ch * 8) = w;
  }
}

DI int in_mode(const Params& p, int layer, int n_h, const float*& gain) {
  int mode = 0; gain = p.mem_qk_g;
  if ((layer & 1) == 0) { const int e = layer >> 1;
    if (n_h >= 1536 && n_h < 2048) { mode = 2; gain = p.swa_qk_g + (e * 2) * 64; }
    else if (n_h >= 2048 && n_h < 2176) { mode = 2; gain = p.swa_qk_g + (e * 2 + 1) * 64; }
    else if (n_h >= 2304 && n_h < 2560) { mode = 1; gain = p.mem_qk_g + (layer * 2) * 64; }
  } else { const int o = layer >> 1;
    if (n_h < 512) { mode = 3; gain = p.ax_qk_g + (o * 2) * 64; }
    else if (n_h < 640) { mode = 3; gain = p.ax_qk_g + (o * 2 + 1) * 64; }
    else if (n_h >= 768 && n_h < 1280) { mode = 2; gain = p.diff_qk_g + (o * 2) * 64; }
    else if (n_h >= 1280 && n_h < 1792) { mode = 2; gain = p.diff_qk_g + (o * 2 + 1) * 64; }
    else if (n_h >= 2304 && n_h < 2560) { mode = 1; gain = p.mem_qk_g + (layer * 2) * 64; }
  }
  return mode;
}

template <int EPI>
DI void gemm_phase(char* lds, const Params& p, const GemmDesc g, int layer) {
  const int tid = ltid(), lane = tid & 63, wid = tid >> 6, wm = wid >> 1, wn = wid & 1, r = lane & 31, h = lane >> 5;
  const int srow = tid >> 3, sch = tid & 7;
  const int soff = srow * 128 + ((sch ^ ((srow >> 1) & 7)) << 4);
  const int nk = g.K >> 6;
  const int ntile = g.mtiles * g.ntiles;
  const bool banded = ((gridDim.x & 7) == 0) && ((g.mtiles & 63) == 0);
  const int nx = banded ? 8 : 1, bx = blockIdx.x % nx, bi = blockIdx.x / nx, nbx = gridDim.x / nx;
  const int per_band = 8 * g.ntiles;
  const int qtot = ntile / nx;
  int q = bi;
  if (q >= qtot) return;
  int mt, nt;
#define G_TILE(qq, MT, NT) do { if (banded) { const int bl_ = (qq) / per_band, rem_ = (qq) - bl_ * per_band; NT = rem_ >> 3; MT = (bl_ * 8 + bx) * 8 + (rem_ & 7); } \
    else { MT = (qq) / g.ntiles; NT = (qq) - MT * g.ntiles; } } while (0)
#define G_LOAD(AG, BG, kt, RA, RB) do { const int k0_ = (kt) * 64; int ac_ = k0_; if (g.remap) ac_ = k0_ < 512 ? k0_ : (k0_ < 1024 ? g.seg2 + k0_ - 512 : 2304 + k0_ - 1024); \
    _Pragma("unroll") for (int i = 0; i < 4; ++i) { RA[i] = *(const u32x4*)(AG + (size_t)(64 * i) * g.lda + ac_); RB[i] = *(const u32x4*)(BG + (size_t)(64 * i) * g.K + k0_); } } while (0)
#define G_WRITE(buf, RA, RB) do { _Pragma("unroll") for (int i = 0; i < 4; ++i) { *(u32x4*)(lds + (buf) * 65536 + i * 8192 + soff) = RA[i]; *(u32x4*)(lds + (buf) * 65536 + 32768 + i * 8192 + soff) = RB[i]; } } while (0)
#define G_COMPUTE(buf) do { _Pragma("unroll") for (int ks = 0; ks < 4; ++ks) { const int co_ = ((2 * ks + h) ^ ((r >> 1) & 7)) << 4; \
      const char* la_ = lds + (buf) * 65536 + (wm * 64 + r) * 128 + co_; const char* lb_ = lds + (buf) * 65536 + 32768 + (wn * 128 + r) * 128 + co_; \
      bf16x8 fa_[2], fb_[4]; fa_[0] = *(const bf16x8*)(la_); fa_[1] = *(const bf16x8*)(la_ + 4096); \
      _Pragma("unroll") for (int ni = 0; ni < 4; ++ni) fb_[ni] = *(const bf16x8*)(lb_ + ni * 4096); \
      _Pragma("unroll") for (int ni = 0; ni < 4; ++ni) { acc[0][ni] = MFMA32(fb_[ni], fa_[0], acc[0][ni]); acc[1][ni] = MFMA32(fb_[ni], fa_[1], acc[1][ni]); } } } while (0)
  G_TILE(q, mt, nt);
  const bf16_t* Ag = g.A + (size_t)(mt * 256 + srow) * g.lda + sch * 8;
  const bf16_t* Bg = g.Bt + (size_t)(nt * 256 + srow) * g.K + sch * 8;
  u32x4 ra0[4], rb0[4];
  G_LOAD(Ag, Bg, 0, ra0, rb0); G_WRITE(0, ra0, rb0); __syncthreads();
  for (;;) {
    const int qn = q + nbx; const bool has_next = qn < qtot;
    int mtn = mt, ntn = nt; if (has_next) G_TILE(qn, mtn, ntn);
    const bf16_t* Agn = g.A + (size_t)(mtn * 256 + srow) * g.lda + sch * 8;
    const bf16_t* Bgn = g.Bt + (size_t)(ntn * 256 + srow) * g.K + sch * 8;
    f32x16 acc[2][4];
#pragma unroll
    for (int a = 0; a < 2; ++a)
#pragma unroll
      for (int b = 0; b < 4; ++b)
#pragma unroll
        for (int i = 0; i < 16; ++i) acc[a][b][i] = 0.f;
    for (int kt = 0; kt < nk; kt += 2) {
      const bool last = kt + 2 >= nk;
      G_LOAD(Ag, Bg, kt + 1, ra0, rb0);
      __builtin_amdgcn_sched_barrier(0);
      G_COMPUTE(0);
      G_WRITE(1, ra0, rb0);
      __syncthreads();
      if (!last) G_LOAD(Ag, Bg, kt + 2, ra0, rb0); else if (has_next) G_LOAD(Agn, Bgn, 0, ra0, rb0);
      __builtin_amdgcn_sched_barrier(0);
      G_COMPUTE(1);
      if (!last || has_next) G_WRITE(0, ra0, rb0);
      __syncthreads();
    }
    const int n_w = nt * 256 + wn * 128;
    if (EPI == EPI_IN) {
#pragma unroll
      for (int hu = 0; hu < 2; ++hu) {
        const int n_h = n_w + 64 * hu; const float* gain; const int mode = in_mode(p, layer, n_h, gain);
#pragma unroll
        for (int mi = 0; mi < 2; ++mi) {
          const int t = mt * 256 + wm * 64 + mi * 32 + r;
          int S, seq0, pos, sq; tok_info(t, S, seq0, pos, sq);
          head_store(acc[mi][2 * hu], acc[mi][2 * hu + 1], 1.f, mode, gain, p, pos, p.u + (size_t)(t - r) * UW + n_h, UW, lds + 131072);
        }
      }
    } else if (EPI == EPI_MEM) {
#pragma unroll
      for (int hu = 0; hu < 2; ++hu) {
        const int n_h = n_w + 64 * hu, l = n_h >> 9, c = n_h & 511;
        const int mode = c < 256 ? 1 : 0; const float* gain = p.mem_qk_g + (l * 2 + 1) * 64;
#pragma unroll
        for (int mi = 0; mi < 2; ++mi) {
          const int row = mt * 256 + wm * 64 + mi * 32 + r;
          head_store(acc[mi][2 * hu], acc[mi][2 * hu + 1], 1.f, mode, gain, p, 0, p.memkv + (size_t)(row - r) * 2048 + n_h, 2048, lds + 131072);
        }
      }
    } else {
      const int tid_ = ltid(), lane = tid_ & 63, r = lane & 31, h = lane >> 5;
      char* stg = lds + 131072 + (tid_ >> 6) * 4096;
#pragma unroll
      for (int mi = 0; mi < 2; ++mi) {
        const int t0 = mt * 256 + wm * 64 + mi * 32;
        const float* xin0 = layer == 0 ? (t0 < NTOKP ? p.xp + (size_t)t0 * DM : p.xs + (size_t)(t0 - NTOKP) * DM) : p.out + (size_t)t0 * DM;
        float* xo0 = p.out + (size_t)t0 * DM;
#pragma unroll
        for (int ni = 0; ni < 4; ++ni) {
#pragma unroll
          for (int g4 = 0; g4 < 4; ++g4) {
            f32x4 v; v[0] = acc[mi][ni][4 * g4]; v[1] = acc[mi][ni][4 * g4 + 1]; v[2] = acc[mi][ni][4 * g4 + 2]; v[3] = acc[mi][ni][4 * g4 + 3];
            *(f32x4*)(stg + r * 128 + (((2 * g4 + h) ^ (r & 7)) << 4)) = v;
          }
#pragma unroll
          for (int j = 0; j < 4; ++j) {
            const int row = (lane >> 3) + 8 * j, ch = lane & 7;
            const f32x4 a = *(const f32x4*)(stg + row * 128 + ((ch ^ (row & 7)) << 4));
            const size_t off = (size_t)row * DM + n_w + ni * 32 + ch * 4;
            f32x4 xv = *(const f32x4*)(xin0 + off);
            xv += a;
            *(f32x4*)(xo0 + off) = xv;
          }
        }
      }
    }
    if (!has_next) break;
    q = qn; mt = mtn; nt = ntn; Ag = Agn; Bg = Bgn;
  }
#undef G_TILE
#undef G_LOAD
#undef G_WRITE
#undef G_COMPUTE
}

enum { AM_PLAIN = 0, AM_SWA = 1, AM_DIFF = 2 };
struct AttnJob {
  const bf16_t* q;
  const bf16_t* k[2];
  const bf16_t* v;
  int ldk, ldv;
  int tile_lo, tile_hi;
  float m_init, l_init;
  int qpos0;
  bf16_t* o;
  const bf16_t* z;
  float lam, oscale;
  const float* subg;
  int dry;
};

template <int DV, int MODE>
DI void attn_finalize(char* lds, const AttnJob& J, f32x16 (&O)[DV / 32], const float lt, const int wid, const int r, const int h) {
  constexpr int NDV = DV / 32;
  const float inv = 1.f / lt;
  if (MODE != AM_DIFF) {
    bf16_t* orow = J.o + (size_t)r * UW; const bf16_t* zrow = J.z + (size_t)r * UW;
#pragma unroll
    for (int d = 0; d < NDV; ++d)
#pragma unroll
      for (int g4 = 0; g4 < 4; ++g4) {
        const int dv = 32 * d + 8 * g4 + 4 * h;
        const u32x2 zw = *(const u32x2*)(zrow + dv);
        const float y0 = O[d][4 * g4] * inv * silu(bflo(zw.x)), y1 = O[d][4 * g4 + 1] * inv * silu(bfhi(zw.x));
        const float y2 = O[d][4 * g4 + 2] * inv * silu(bflo(zw.y)), y3 = O[d][4 * g4 + 3] * inv * silu(bfhi(zw.y));
        u32x2 w; w.x = cvtpk(y0, y1); w.y = cvtpk(y2, y3);
        *(u32x2*)(orow + dv) = w;
      }
  } else {
    float* sc = (float*)(lds + 32768) + (wid >> 1) * (DV * 32);
    if (wid & 1) {
      const float f = inv * J.lam;
#pragma unroll
      for (int d = 0; d < NDV; ++d)
#pragma unroll
        for (int i = 0; i < 16; ++i) sc[(32 * d + crow(i, h)) * 32 + r] = O[d][i] * f;
    }
    __syncthreads();
    if (!(wid & 1)) {
      float ss = 0.f;
#pragma unroll
      for (int d = 0; d < NDV; ++d)
#pragma unroll
        for (int i = 0; i < 16; ++i) { const float a = O[d][i] * inv - sc[(32 * d + crow(i, h)) * 32 + r]; O[d][i] = a; ss += a * a; }
      ss = swapsum(ss);
      const float rn = rsqrtf(ss * (1.f / DV) + EPSF) * J.oscale;
      bf16_t* orow = J.o + (size_t)r * UW; const bf16_t* zrow = J.z + (size_t)r * UW;
#pragma unroll
      for (int d = 0; d < NDV; ++d)
#pragma unroll
        for (int g4 = 0; g4 < 4; ++g4) {
          const int dv = 32 * d + 8 * g4 + 4 * h;
          const u32x2 zw = *(const u32x2*)(zrow + dv);
          const f32x4 sg = *(const f32x4*)(J.subg + dv);
          const float y0 = O[d][4 * g4] * rn * sg[0] * silu(bflo(zw.x)), y1 = O[d][4 * g4 + 1] * rn * sg[1] * silu(bfhi(zw.x));
          const float y2 = O[d][4 * g4 + 2] * rn * sg[2] * silu(bflo(zw.y)), y3 = O[d][4 * g4 + 3] * rn * sg[3] * silu(bfhi(zw.y));
          u32x2 w; w.x = cvtpk(y0, y1); w.y = cvtpk(y2, y3);
          *(u32x2*)(orow + dv) = w;
        }
    }
  }
}

template <int DV, int NK, int MODE, bool FIXM, int GRP>
DI void attn_job(char* lds_wg, const AttnJob& J) {
  constexpr int NDV = DV / 32;
  constexpr float C = 0.125f * LOG2E;
  const int tid_wg = ltid(), tid = tid_wg & (AT - 1), lane = tid & 63, wid = tid >> 6, r = lane & 31, h = lane >> 5;
  char* lds = lds_wg + GRP * 65536;
  const int kstream = (NK == 2) ? (wid & 1) : 0;
  bf16x8 qf[4];
  const bf16_t* qrow = J.q + (size_t)r * UW + 8 * h;
#pragma unroll
  for (int ds = 0; ds < 4; ++ds) qf[ds] = *(const bf16x8*)(qrow + 16 * ds);
  f32x16 O[NDV];
#pragma unroll
  for (int d = 0; d < NDV; ++d)
#pragma unroll
    for (int i = 0; i < 16; ++i) O[d][i] = 0.f;
  float m = J.m_init, l = (h == 0) ? J.l_init : 0.f;
  f32x16 Osum;
#pragma unroll
  for (int i = 0; i < 16; ++i) Osum[i] = 0.f;
  const bf16x8 ones = {0x3F80, 0x3F80, 0x3F80, 0x3F80, 0x3F80, 0x3F80, 0x3F80, 0x3F80};
  const int ksrow = tid >> 3, ksch = tid & 7;
  const int kpi = (ksrow & ~12) | ((ksrow & 4) << 1) | ((ksrow & 8) >> 1);
  const int ksoff = kpi * 128 + ((ksch ^ ((kpi >> 1) & 7)) << 4);
  constexpr int VCH = DV / 8;
  constexpr int VI = (64 * VCH) / AT;
  const int vkey0 = tid / VCH, vc8 = (tid % VCH) * 8;
  u32x4 rk0[NK][2], rv0[VI], rk1[NK][2], rv1[VI];
#define A_LOAD(t, rk, rv) do { const size_t kb_ = (size_t)(t) * 64; \
    _Pragma("unroll") for (int s = 0; s < NK; ++s) _Pragma("unroll") for (int i = 0; i < 2; ++i) rk[s][i] = *(const u32x4*)(J.k[s] + (kb_ + ksrow + 32 * i) * J.ldk + ksch * 8); \
    _Pragma("unroll") for (int i = 0; i < VI; ++i) rv[i] = *(const u32x4*)(J.v + (kb_ + vkey0 + (AT / VCH) * i) * J.ldv + vc8); } while (0)
#define A_WRITE(st, rk, rv) do { char* b_ = lds + (st) * 32768; \
    _Pragma("unroll") for (int s = 0; s < NK; ++s) _Pragma("unroll") for (int i = 0; i < 2; ++i) *(u32x4*)(b_ + s * 8192 + i * 4096 + ksoff) = rk[s][i]; \
    _Pragma("unroll") for (int i = 0; i < VI; ++i) { const int key_ = vkey0 + (AT / VCH) * i; \
      *(u32x4*)(b_ + NK * 8192 + ((key_ >> 3) * NDV + (vc8 >> 5)) * 512 + (key_ & 7) * 64 + (vc8 & 31) * 2) = rv[i]; } } while (0)
  const int nt = J.tile_hi - J.tile_lo;
  constexpr bool DEEP2 = FIXM || MODE != AM_DIFF;
  A_LOAD(J.tile_lo, rk0, rv0); A_WRITE(0, rk0, rv0); if (DEEP2) A_LOAD(J.tile_lo + 1, rk1, rv1); __syncthreads();
  const int i16 = lane & 15;
  const int vrd = h * NDV * 512 + (i16 >> 2) * 64 + (((lane >> 4) & 1) * 16 + (i16 & 3) * 4) * 2;
  auto compute = [&](const int stage, const int tile) __attribute__((always_inline)) {
    bool active = true;
    if (MODE == AM_SWA) { const int k0 = tile * 64; active = !(k0 > J.qpos0 + 31 + 128 || k0 + 63 < J.qpos0 - 128); }
    if (active) {
      const char* Kl = lds + stage * 32768 + kstream * 8192 + r * 128;
      f32x16 sA, sB;
#pragma unroll
      for (int i = 0; i < 16; ++i) { sA[i] = 0.f; sB[i] = 0.f; }
      if (NDV == 2) {
        bf16x8 ka[4], kb[4];
#pragma unroll
        for (int ds = 0; ds < 4; ++ds) { const int co = ((2 * ds + h) ^ ((r >> 1) & 7)) << 4; ka[ds] = *(const bf16x8*)(Kl + co); kb[ds] = *(const bf16x8*)(Kl + 4096 + co); }
#pragma unroll
        for (int ds = 0; ds < 4; ++ds) { sA = MFMA32(ka[ds], qf[ds], sA); sB = MFMA32(kb[ds], qf[ds], sB); }
        __builtin_amdgcn_sched_group_barrier(0x100, 4, 0); __builtin_amdgcn_sched_group_barrier(0x008, 2, 0);
        __builtin_amdgcn_sched_group_barrier(0x100, 2, 0); __builtin_amdgcn_sched_group_barrier(0x008, 2, 0);
        __builtin_amdgcn_sched_group_barrier(0x100, 2, 0); __builtin_amdgcn_sched_group_barrier(0x008, 4, 0);
      } else {
#pragma unroll
        for (int ds = 0; ds < 4; ++ds) {
          const int co = ((2 * ds + h) ^ ((r >> 1) & 7)) << 4;
          const bf16x8 ka = *(const bf16x8*)(Kl + co), kb = *(const bf16x8*)(Kl + 4096 + co);
          sA = MFMA32(ka, qf[ds], sA); sB = MFMA32(kb, qf[ds], sB);
        }
      }
      if (MODE == AM_SWA) {
        const int qa = J.qpos0 + r, kbase = tile * 64 + 8 * h;
#pragma unroll
        for (int i = 0; i < 16; ++i) {
          const int ka_ = kbase + 16 * (i >> 3) + (i & 7);
          int d0 = qa - ka_; d0 = d0 < 0 ? -d0 : d0; if (d0 > 128) sA[i] = -INFINITY;
          int d1 = qa - (ka_ + 32); d1 = d1 < 0 ? -d1 : d1; if (d1 > 128) sB[i] = -INFINITY;
        }
      }
      if (FIXM) {
        const float nm = -J.m_init;
#pragma unroll
        for (int i = 0; i < 16; ++i) { sA[i] = __builtin_amdgcn_exp2f(fmaf(sA[i], C, nm)); sB[i] = __builtin_amdgcn_exp2f(fmaf(sB[i], C, nm)); }
      } else {
      float mx = sA[0];
#pragma unroll
      for (int i = 1; i < 16; ++i) mx = fmaxf(mx, sA[i]);
#pragma unroll
      for (int i = 0; i < 16; ++i) mx = fmaxf(mx, sB[i]);
      mx = swapmax(mx);
      const float mn = fmaxf(m, mx * C);
      const float alpha = __builtin_amdgcn_exp2f(m - mn);
      m = mn;
      float ps = 0.f;
#pragma unroll
      for (int i = 0; i < 16; ++i) { sA[i] = __builtin_amdgcn_exp2f(fmaf(sA[i], C, -mn)); sB[i] = __builtin_amdgcn_exp2f(fmaf(sB[i], C, -mn)); ps += sA[i] + sB[i]; }
      l = l * alpha + ps;
#pragma unroll
      for (int d = 0; d < NDV; ++d)
#pragma unroll
        for (int i = 0; i < 16; ++i) O[d][i] *= alpha;
      }
      bf16x8 pf[4];
      { u32x4 w;
        w.x = cvtpk(sA[0], sA[1]); w.y = cvtpk(sA[2], sA[3]); w.z = cvtpk(sA[4], sA[5]); w.w = cvtpk(sA[6], sA[7]); pf[0] = __builtin_bit_cast(bf16x8, w);
        w.x = cvtpk(sA[8], sA[9]); w.y = cvtpk(sA[10], sA[11]); w.z = cvtpk(sA[12], sA[13]); w.w = cvtpk(sA[14], sA[15]); pf[1] = __builtin_bit_cast(bf16x8, w);
        w.x = cvtpk(sB[0], sB[1]); w.y = cvtpk(sB[2], sB[3]); w.z = cvtpk(sB[4], sB[5]); w.w = cvtpk(sB[6], sB[7]); pf[2] = __builtin_bit_cast(bf16x8, w);
        w.x = cvtpk(sB[8], sB[9]); w.y = cvtpk(sB[10], sB[11]); w.z = cvtpk(sB[12], sB[13]); w.w = cvtpk(sB[14], sB[15]); pf[3] = __builtin_bit_cast(bf16x8, w); }
      const char* Vl = lds + stage * 32768 + NK * 8192 + vrd;
      if (FIXM) {
#pragma unroll
        for (int ks = 0; ks < 4; ++ks) Osum = MFMA32(ones, pf[ks], Osum);
      }
#pragma unroll
      for (int ks = 0; ks < 4; ++ks)
#pragma unroll
        for (int d = 0; d < NDV; ++d) {
          const s16x4 lo = __builtin_amdgcn_ds_read_tr16_b64_v4i16((LAS s16x4*)(Vl + ks * 2 * NDV * 512 + d * 512));
          const s16x4 hi = __builtin_amdgcn_ds_read_tr16_b64_v4i16((LAS s16x4*)(Vl + ks * 2 * NDV * 512 + d * 512 + 256));
          const bf16x8 vf = __builtin_shufflevector(lo, hi, 0, 1, 2, 3, 4, 5, 6, 7);
          O[d] = MFMA32(vf, pf[ks], O[d]);
        }
    }
  };
  for (int it = 0; it < nt; it += 2) {
    if (DEEP2) {
      if (it + 2 < nt) A_LOAD(J.tile_lo + it + 2, rk0, rv0);
      compute(0, J.tile_lo + it);
      A_WRITE(1, rk1, rv1);
      __syncthreads();
      if (it + 3 < nt) A_LOAD(J.tile_lo + it + 3, rk1, rv1);
      compute(1, J.tile_lo + it + 1);
      if (it + 2 < nt) A_WRITE(0, rk0, rv0);
      __syncthreads();
    } else {
      compute(0, J.tile_lo + it);
      __builtin_amdgcn_sched_barrier(0);
      A_LOAD(J.tile_lo + it + 1, rk0, rv0); A_WRITE(1, rk0, rv0);
      __syncthreads();
      compute(1, J.tile_lo + it + 1);
      __builtin_amdgcn_sched_barrier(0);
      if (it + 2 < nt) { A_LOAD(J.tile_lo + it + 2, rk0, rv0); A_WRITE(0, rk0, rv0); }
      __syncthreads();
    }
  }
#undef A_LOAD
#undef A_WRITE
  if (J.dry) return;
  const float lt = FIXM ? Osum[0] : swapsum(l);
  attn_finalize<DV, MODE>(lds, J, O, lt, wid, r, h);
}

template <int DV, int NK, int MODE, int GRP>
DI void attn_pipe(char* lds_wg, const AttnJob& J) {
  constexpr int NDV = DV / 32;
  constexpr float C = 0.125f * LOG2E;
  constexpr int KST = NK * 8192, VST = DV * 128, VB = 2 * KST;
  const int tid_wg = ltid(), tid = tid_wg & (AT - 1), lane = tid & 63, wid = tid >> 6, r = lane & 31, h = lane >> 5;
  char* lds = lds_wg + GRP * 65536;
  const int kstream = (NK == 2) ? (wid & 1) : 0;
  bf16x8 qf[4];
  const bf16_t* qrow = J.q + (size_t)r * UW + 8 * h;
#pragma unroll
  for (int ds = 0; ds < 4; ++ds) qf[ds] = *(const bf16x8*)(qrow + 16 * ds);
  f32x16 O[NDV], Osum;
#pragma unroll
  for (int d = 0; d < NDV; ++d)
#pragma unroll
    for (int i = 0; i < 16; ++i) O[d][i] = 0.f;
#pragma unroll
  for (int i = 0; i < 16; ++i) Osum[i] = 0.f;
  const bf16x8 ones = {0x3F80, 0x3F80, 0x3F80, 0x3F80, 0x3F80, 0x3F80, 0x3F80, 0x3F80};
  const float nm = -J.m_init;
  const int ksrow = tid >> 3, ksch = tid & 7;
  const int kpi = (ksrow & ~12) | ((ksrow & 4) << 1) | ((ksrow & 8) >> 1);
  const int ksoff = kpi * 128 + ((ksch ^ ((kpi >> 1) & 7)) << 4);
  constexpr int VCH = DV / 8, VI = (64 * VCH) / AT;
  const int vkey0 = tid / VCH, vc8 = (tid % VCH) * 8;
  u32x4 rk0[NK][2], rv0[VI], rk1[NK][2], rv1[VI];
#define K_LOAD(t, rk) do { const size_t kb_ = (size_t)(t) * 64; \
    _Pragma("unroll") for (int s = 0; s < NK; ++s) _Pragma("unroll") for (int i = 0; i < 2; ++i) rk[s][i] = *(const u32x4*)(J.k[s] + (kb_ + ksrow + 32 * i) * J.ldk + ksch * 8); } while (0)
#define V_LOAD(t, rv) do { const size_t kb_ = (size_t)(t) * 64; \
    _Pragma("unroll") for (int i = 0; i < VI; ++i) rv[i] = *(const u32x4*)(J.v + (kb_ + vkey0 + (AT / VCH) * i) * J.ldv + vc8); } while (0)
#define K_WRITE(st, rk) do { char* b_ = lds + (st) * KST; \
    _Pragma("unroll") for (int s = 0; s < NK; ++s) _Pragma("unroll") for (int i = 0; i < 2; ++i) *(u32x4*)(b_ + s * 8192 + i * 4096 + ksoff) = rk[s][i]; } while (0)
#define V_WRITE(st, rv) do { char* b_ = lds + VB + (st) * VST; \
    _Pragma("unroll") for (int i = 0; i < VI; ++i) { const int key_ = vkey0 + (AT / VCH) * i; \
      *(u32x4*)(b_ + ((key_ >> 3) * NDV + (vc8 >> 5)) * 512 + (key_ & 7) * 64 + (vc8 & 31) * 2) = rv[i]; } } while (0)
  const int nt = J.tile_hi - J.tile_lo, t0 = J.tile_lo;
  const int i16 = lane & 15;
  const int vrd = h * NDV * 512 + (i16 >> 2) * 64 + (((lane >> 4) & 1) * 16 + (i16 & 3) * 4) * 2;
  auto qk = [&](const int kst, f32x16& sA, f32x16& sB) __attribute__((always_inline)) {
    const char* Kl = lds + kst * KST + kstream * 8192 + r * 128;
#pragma unroll
    for (int i = 0; i < 16; ++i) { sA[i] = 0.f; sB[i] = 0.f; }
    bf16x8 ka[4], kb[4];
#pragma unroll
    for (int ds = 0; ds < 4; ++ds) { const int co = ((2 * ds + h) ^ ((r >> 1) & 7)) << 4; ka[ds] = *(const bf16x8*)(Kl + co); kb[ds] = *(const bf16x8*)(Kl + 4096 + co); }
    __builtin_amdgcn_sched_barrier(0);
#pragma unroll
    for (int ds = 0; ds < 4; ++ds) { sA = MFMA32(ka[ds], qf[ds], sA); sB = MFMA32(kb[ds], qf[ds], sB); }
  };
  auto smpv = [&](const int vst, f32x16& sA, f32x16& sB) __attribute__((always_inline)) {
    const char* Vl = lds + VB + vst * VST + vrd;
    bf16x8 vf[4][NDV];
#pragma unroll
    for (int ks = 0; ks < 4; ++ks)
#pragma unroll
      for (int d = 0; d < NDV; ++d) {
        const s16x4 lo = __builtin_amdgcn_ds_read_tr16_b64_v4i16((LAS s16x4*)(Vl + ks * 2 * NDV * 512 + d * 512));
        const s16x4 hi = __builtin_amdgcn_ds_read_tr16_b64_v4i16((LAS s16x4*)(Vl + ks * 2 * NDV * 512 + d * 512 + 256));
        vf[ks][d] = __builtin_shufflevector(lo, hi, 0, 1, 2, 3, 4, 5, 6, 7);
      }
    __builtin_amdgcn_sched_barrier(0);
#pragma unroll
    for (int i = 0; i < 16; ++i) { sA[i] = __builtin_amdgcn_exp2f(fmaf(sA[i], C, nm)); sB[i] = __builtin_amdgcn_exp2f(fmaf(sB[i], C, nm)); }
    bf16x8 pf[4];
    { u32x4 w;
      w.x = cvtpk(sA[0], sA[1]); w.y = cvtpk(sA[2], sA[3]); w.z = cvtpk(sA[4], sA[5]); w.w = cvtpk(sA[6], sA[7]); pf[0] = __builtin_bit_cast(bf16x8, w);
      w.x = cvtpk(sA[8], sA[9]); w.y = cvtpk(sA[10], sA[11]); w.z = cvtpk(sA[12], sA[13]); w.w = cvtpk(sA[14], sA[15]); pf[1] = __builtin_bit_cast(bf16x8, w);
      w.x = cvtpk(sB[0], sB[1]); w.y = cvtpk(sB[2], sB[3]); w.z = cvtpk(sB[4], sB[5]); w.w = cvtpk(sB[6], sB[7]); pf[2] = __builtin_bit_cast(bf16x8, w);
      w.x = cvtpk(sB[8], sB[9]); w.y = cvtpk(sB[10], sB[11]); w.z = cvtpk(sB[12], sB[13]); w.w = cvtpk(sB[14], sB[15]); pf[3] = __builtin_bit_cast(bf16x8, w); }
#pragma unroll
    for (int ks = 0; ks < 4; ++ks) Osum = MFMA32(ones, pf[ks], Osum);
#pragma unroll
    for (int ks = 0; ks < 4; ++ks)
#pragma unroll
      for (int d = 0; d < NDV; ++d) O[d] = MFMA32(vf[ks][d], pf[ks], O[d]);
  };
  K_LOAD(t0, rk0); V_LOAD(t0, rv0); K_LOAD(t0 + 1, rk1);
  K_WRITE(0, rk0); V_WRITE(0, rv0); K_WRITE(1, rk1);
  if (2 < nt) K_LOAD(t0 + 2, rk0);
  V_LOAD(t0 + 1, rv0);
  __syncthreads();
  f32x16 eA, eB, oA, oB;
  qk(0, eA, eB);
  __syncthreads();
  for (int j = 0; j < nt; j += 2) {
    if (j + 3 < nt) K_LOAD(t0 + j + 3, rk1);
    if (j + 2 < nt) V_LOAD(t0 + j + 2, rv1);
    qk(1, oA, oB);
    __builtin_amdgcn_sched_barrier(0);
    smpv(0, eA, eB);
    if (j + 2 < nt) K_WRITE(0, rk0);
    V_WRITE(1, rv0);
    __syncthreads();
    if (j + 4 < nt) K_LOAD(t0 + j + 4, rk0);
    if (j + 3 < nt) V_LOAD(t0 + j + 3, rv0);
    if (j + 2 < nt) qk(0, eA, eB);
    __builtin_amdgcn_sched_barrier(0);
    smpv(1, oA, oB);
    if (j + 3 < nt) K_WRITE(1, rk1);
    if (j + 2 < nt) V_WRITE(0, rv1);
    __syncthreads();
  }
#undef K_LOAD
#undef V_LOAD
#undef K_WRITE
#undef V_WRITE
  if (J.dry) return;
  attn_finalize<DV, MODE>(lds, J, O, Osum[0], wid, r, h);
}

#define PIPE_CALL(DV, NK, MODE) do { if (grp) attn_pipe<DV, NK, MODE, 1>(lds, J); else attn_pipe<DV, NK, MODE, 0>(lds, J); } while (0)
#define ATTN_CALL(DV, NK, MODE, FIXM) do { if (grp) attn_job<DV, NK, MODE, FIXM, 1>(lds, J); else attn_job<DV, NK, MODE, FIXM, 0>(lds, J); } while (0)
DI void mem_jobs(char* lds, const Params& p, int layer, int dry) {
  const int grp = __builtin_amdgcn_readfirstlane(ltid() >> 8);
  const int wid = (ltid() >> 6) & 3, vb = blockIdx.x * 2 + grp, vg = gridDim.x * 2;
  for (int job = vb; job < 768 * 4; job += vg) {
    const int qb = job >> 2, hm = job & 3, t0 = qb * 128;
    int S, seq0, pos, sq; tok_info(t0, S, seq0, pos, sq);
    AttnJob J;
    bf16_t* qo = p.u + (size_t)(t0 + 32 * wid) * UW + 2304 + hm * 64;
    J.q = qo; J.o = qo; J.z = p.u + (size_t)(t0 + 32 * wid) * UW + 2560 + 1024 + hm * 64;
    J.k[0] = J.k[1] = p.memkv + (size_t)(sq * 256) * 2048 + layer * 512 + hm * 64; J.v = J.k[0] + 256; J.ldk = J.ldv = 2048;
    J.tile_lo = 0; J.tile_hi = 4; J.m_init = -1e30f; J.l_init = 0.f; J.qpos0 = 0; J.lam = 0.f; J.oscale = 0.f; J.subg = nullptr; J.dry = dry;
    ATTN_CALL(64, 1, AM_PLAIN, false);
  }
}

DI void phase_mix_even(char* lds, const Params& p, int layer, int dry) {
  const int grp = __builtin_amdgcn_readfirstlane(ltid() >> 8);
  const int e = layer >> 1, wid = (ltid() >> 6) & 3, vb = blockIdx.x * 2 + grp, vg = gridDim.x * 2;
  for (int job = vb; job < 768 * 8; job += vg) {
    const int qb = job >> 3, hq = job & 7, kvh = hq >> 2, t0 = qb * 128;
    int S, seq0, pos, sq; tok_info(t0, S, seq0, pos, sq);
    AttnJob J;
    bf16_t* qo = p.u + (size_t)(t0 + 32 * wid) * UW + 1536 + hq * 64;
    J.q = qo; J.o = qo; J.z = p.u + (size_t)(t0 + 32 * wid) * UW + 2560 + 512 + hq * 64;
    J.k[0] = J.k[1] = p.u + (size_t)seq0 * UW + 2048 + kvh * 64; J.v = p.u + (size_t)seq0 * UW + 2176 + kvh * 64; J.ldk = J.ldv = UW;
    const int pt = pos >> 6;
    J.tile_lo = pt - 2 < 0 ? 0 : pt - 2; J.tile_hi = pt + 4 > (S >> 6) ? (S >> 6) : pt + 4;
    J.m_init = p.swa_sink[e * 8 + hq] * LOG2E; J.l_init = 1.f; J.qpos0 = pos + 32 * wid; J.lam = 0.f; J.oscale = 0.f; J.subg = nullptr; J.dry = dry;
    ATTN_CALL(64, 1, AM_SWA, false);
  }
  mem_jobs(lds, p, layer, dry);
  const float* cw = p.conv_w + e * 3 * 512;
  for (int idx = blockIdx.x * NTHREADS + ltid(); idx < NTOK * 64; idx += gridDim.x * NTHREADS) {
    const int t = idx >> 6, c0 = (idx & 63) * 8;
    int S, seq0, pos, sq; tok_info(t, S, seq0, pos, sq);
    bf16_t* ur = p.u + (size_t)t * UW;
    float ic[8], il[8], ir[8];
    { const u32x4 a = *(const u32x4*)(ur + 512 + c0), b = *(const u32x4*)(ur + 1024 + c0);
#pragma unroll
      for (int j = 0; j < 4; ++j) { ic[2 * j] = bflo(a[j]) * bflo(b[j]); ic[2 * j + 1] = bfhi(a[j]) * bfhi(b[j]); } }
    if (pos > 0) { const u32x4 a = *(const u32x4*)(ur - UW + 512 + c0), b = *(const u32x4*)(ur - UW + 1024 + c0);
#pragma unroll
      for (int j = 0; j < 4; ++j) { il[2 * j] = bflo(a[j]) * bflo(b[j]); il[2 * j + 1] = bfhi(a[j]) * bfhi(b[j]); } }
    else {
#pragma unroll
      for (int j = 0; j < 8; ++j) il[j] = 0.f; }
    if (pos < S - 1) { const u32x4 a = *(const u32x4*)(ur + UW + 512 + c0), b = *(const u32x4*)(ur + UW + 1024 + c0);
#pragma unroll
      for (int j = 0; j < 4; ++j) { ir[2 * j] = bflo(a[j]) * bflo(b[j]); ir[2 * j + 1] = bfhi(a[j]) * bfhi(b[j]); } }
    else {
#pragma unroll
      for (int j = 0; j < 8; ++j) ir[j] = 0.f; }
    const u32x4 gbw = *(const u32x4*)(ur + c0), zw = *(const u32x4*)(ur + 2560 + c0);
    float y[8];
#pragma unroll
    for (int j = 0; j < 8; ++j) {
      const float gb = (j & 1) ? bfhi(gbw[j >> 1]) : bflo(gbw[j >> 1]);
      const float z = (j & 1) ? bfhi(zw[j >> 1]) : bflo(zw[j >> 1]);
      const float cv = il[j] * cw[c0 + j] + ic[j] * cw[512 + c0 + j] + ir[j] * cw[1024 + c0 + j];
      y[j] = gb * cv * silu(z);
    }
    u32x4 w; w.x = cvtpk(y[0], y[1]); w.y = cvtpk(y[2], y[3]); w.z = cvtpk(y[4], y[5]); w.w = cvtpk(y[6], y[7]);
    if (!dry) *(u32x4*)(ur + c0) = w;
  }
}

DI void phase_mix_odd(char* lds, const Params& p, int layer, int dry) {
  const int grp = __builtin_amdgcn_readfirstlane(ltid() >> 8);
  const int o = layer >> 1, wid = (ltid() >> 6) & 3;
  const int nx = (gridDim.x & 7) == 0 ? 8 : 1, bx = blockIdx.x % nx, bi = (blockIdx.x / nx) * 2 + grp, nbx = (gridDim.x / nx) * 2;
  const float mb_dense = p.lam[8 + o * 2], mb_diff = p.lam[8 + o * 2 + 1];
  const bool fix_dense = mb_dense < 43.f, fix_diff = mb_diff < 43.f;
#pragma unroll 1
  for (int part = 0; part < 2; ++part) {
    const int gshift = part ? 7 : 8, nv = (16 / nx) << gshift;
#pragma unroll 1
    for (int v = bi; v < nv; v += nbx) {
      const int j = ((bx + nx * (v >> gshift)) << gshift) + (v & ((1 << gshift) - 1));
      int g, qb, kvh, seq0, S;
      if (!part) { g = j & 3; qb = (j >> 2) & 63; kvh = (j >> 8) & 1; seq0 = (j >> 9) * 8192; S = 8192; }
      else { g = j & 3; qb = (j >> 2) & 31; kvh = (j >> 7) & 1; seq0 = NTOKP + (j >> 8) * 4096; S = 4096; }
      const int hq = kvh * 4 + g, t0 = seq0 + qb * 128 + 32 * wid;
      AttnJob J;
      bf16_t* qo = p.u + (size_t)t0 * UW + hq * 64;
      J.q = qo; J.o = qo; J.z = p.u + (size_t)t0 * UW + 2560 + hq * 64;
      J.k[0] = J.k[1] = p.u + (size_t)seq0 * UW + 512 + kvh * 64; J.v = p.u + (size_t)seq0 * UW + 640 + kvh * 64; J.ldk = J.ldv = UW;
      J.tile_lo = 0; J.tile_hi = S >> 6; J.l_init = 0.f; J.qpos0 = 0; J.lam = 0.f; J.oscale = 0.f; J.subg = nullptr; J.dry = dry;
      if (fix_dense) { J.m_init = mb_dense; PIPE_CALL(64, 1, AM_PLAIN); }
      else { J.m_init = -1e30f; ATTN_CALL(64, 1, AM_PLAIN, false); }
    }
  }
  const float lam = p.lam[o * 2], osc = p.lam[o * 2 + 1];
#pragma unroll 1
  for (int part = 0; part < 2; ++part) {
    const int gshift = part ? 6 : 7, nv = (32 / nx) << gshift;
#pragma unroll 1
    for (int v = bi; v < nv; v += nbx) {
      const int j = ((bx + nx * (v >> gshift)) << gshift) + (v & ((1 << gshift) - 1));
      int qb, hh, seq0, S;
      if (!part) { qb = j & 127; hh = (j >> 7) & 3; seq0 = (j >> 9) * 8192; S = 8192; }
      else { qb = j & 63; hh = (j >> 6) & 3; seq0 = NTOKP + (j >> 8) * 4096; S = 4096; }
      const int mp = wid & 1, sub = wid >> 1, t0 = seq0 + qb * 64 + sub * 32;
      AttnJob J;
      J.q = p.u + (size_t)t0 * UW + 768 + (2 * hh + mp) * 64;
      J.o = p.u + (size_t)t0 * UW + 768 + hh * 128; J.z = p.u + (size_t)t0 * UW + 2560 + 512 + hh * 128;
      J.k[0] = p.u + (size_t)seq0 * UW + 1280 + (2 * hh) * 64; J.k[1] = J.k[0] + 64; J.v = p.u + (size_t)seq0 * UW + 1792 + hh * 128; J.ldk = J.ldv = UW;
      J.tile_lo = 0; J.tile_hi = S >> 6; J.l_init = 0.f; J.qpos0 = 0; J.lam = lam; J.oscale = osc; J.subg = p.diff_subln_g + o * 128; J.dry = dry;
      if (fix_diff) { J.m_init = mb_diff; ATTN_CALL(128, 2, AM_DIFF, true); }
      else { J.m_init = -1e30f; ATTN_CALL(128, 2, AM_DIFF, false); }
    }
  }
  mem_jobs(lds, p, layer, dry);
}

DI void phase_norm(const Params& p) {
  const int gw = blockIdx.x * 8 + (ltid() >> 6), nw = gridDim.x * 8;
  norm_rows(p.out, p.xb, p.rstd, 0, NTOK, gw, nw);
}

__global__ void __launch_bounds__(NTHREADS, 2) fwd_kernel(Params p) {
  __shared__ __attribute__((aligned(16))) char lds[LDS_BYTES];
  int ph = p.phase_lo;
  if (ph == 0) {
    phase_prep(lds, p);
    ph = 1;
#if !MULTI_LAUNCH
    if (ph < p.phase_hi) cg::this_grid().sync();
#endif
  }
  for (; ph < p.phase_hi; ++ph) {
    {
      const int l = (ph - 1) >> 2, s = (ph - 1) & 3;
      if (s == 0) {
        if (l == 0) { GemmDesc g{p.memb, p.wt_mem, DM, DM, 16, 8, 0, 0}; gemm_phase<EPI_MEM>(lds, p, g, 0); }
        GemmDesc g{p.xb, p.wt_in + (size_t)l * UW * DM, DM, DM, NTOK / 256, UW / 256, 0, 0};
        const int nrep = ((p.probe >> 2) & 1) + 1;
#pragma unroll 1
        for (int rep = 0; rep < nrep; ++rep) gemm_phase<EPI_IN>(lds, p, g, l);
      } else if (s == 1) {
        const int nrep = ((l & 1) ? (p.probe & 1) : ((p.probe >> 1) & 1)) + 1;
#pragma unroll 1
        for (int rep = 0; rep < nrep; ++rep) {
          const int dry = rep + 1 < nrep;
          if (ltid() >> 8) __builtin_amdgcn_s_setprio(1);
          if (l & 1) phase_mix_odd(lds, p, l, dry); else phase_mix_even(lds, p, l, dry);
          __builtin_amdgcn_s_setprio(0);
        }
      } else if (s == 2) {
        GemmDesc g{p.u, p.wt_out + (size_t)l * DM * MIXW, UW, MIXW, NTOK / 256, DM / 256, 1, (l & 1) ? 768 : 1536};
        gemm_phase<EPI_OUT>(lds, p, g, l);
      } else phase_norm(p);
    }
#if !MULTI_LAUNCH
    if (ph + 1 < p.phase_hi) cg::this_grid().sync();
#endif
  }
}

extern "C" void kernel_launch(void* const* d_in, const int* in_sizes, int n_in, void* d_out, int out_size, void* d_ws, size_t ws_size,
                              hipStream_t stream) {
  static int grid_blocks = 0;
  if (!grid_blocks) {
    int dev = 0, cus = 0, per_cu = 0;
    hipGetDevice(&dev);
    hipDeviceGetAttribute(&cus, hipDeviceAttributeMultiprocessorCount, dev);
    hipOccupancyMaxActiveBlocksPerMultiprocessor(&per_cu, fwd_kernel, NTHREADS, 0);
    if (per_cu > 1) per_cu = 1;
    if (per_cu < 1) per_cu = 1;
    grid_blocks = cus * per_cu;
  }
  Params p{};
  p.xp = (const float*)d_in[0]; p.xs = (const float*)d_in[1]; p.memp = (const float*)d_in[2]; p.mems = (const float*)d_in[3];
  p.norm_g = (const float*)d_in[4]; p.w_in = (const float*)d_in[5]; p.w_out = (const float*)d_in[6]; p.mem_norm_g = (const float*)d_in[7];
  p.w_mem_kv = (const float*)d_in[8]; p.mem_qk_g = (const float*)d_in[9]; p.conv_w = (const float*)d_in[10]; p.swa_qk_g = (const float*)d_in[11];
  p.swa_sink = (const float*)d_in[12]; p.ax_qk_g = (const float*)d_in[13]; p.diff_qk_g = (const float*)d_in[14]; p.diff_lambda = (const float*)d_in[15];
  p.diff_subln_g = (const float*)d_in[16];
  p.out = (float*)d_out;
  char* w = (char*)d_ws; size_t off = 0;
  auto take = [&](size_t bytes) { char* r = w + off; off += (bytes + 255) & ~(size_t)255; return r; };
  p.u = (bf16_t*)take((size_t)NTOK * UW * 2);
  p.xb = (bf16_t*)take((size_t)NTOK * DM * 2);
  p.wt_in = (bf16_t*)take((size_t)4 * UW * DM * 2);
  p.wt_out = (bf16_t*)take((size_t)4 * DM * MIXW * 2);
  p.wt_mem = (bf16_t*)take((size_t)2048 * DM * 2);
  p.memb = (bf16_t*)take((size_t)4096 * DM * 2);
  p.memkv = (bf16_t*)take((size_t)4096 * 2048 * 2);
  p.rstd = (float*)take((size_t)NTOK * 4);
  p.rstd_mem = (float*)take(4096 * 4);
  p.tab1c = (float*)take(8192 * 32 * 4); p.tab1s = (float*)take(8192 * 32 * 4);
  p.tabac = (float*)take(128 * 16 * 4); p.tabas = (float*)take(128 * 16 * 4);
  p.lam = (float*)take(256);
  if (off > ws_size) { fprintf(stderr, "workspace too small: need %zu have %zu\n", off, ws_size); return; }
#if MULTI_LAUNCH
  for (int ph = 0; ph < NPHASE; ++ph) {
    p.phase_lo = ph; p.phase_hi = ph + 1;
    hipLaunchKernelGGL(fwd_kernel, dim3(grid_blocks), dim3(NTHREADS), 0, stream, p);
  }
#else
  p.phase_lo = 0; p.phase_hi = NPHASE; p.probe = PROBE_ODD | (PROBE_EVEN << 1) | (PROBE_GIN << 2);
  void* args[] = {&p};
  hipError_t e = hipLaunchCooperativeKernel((void*)fwd_kernel, dim3(grid_blocks), dim3(NTHREADS), args, 0, stream);
  if (e != hipSuccess) fprintf(stderr, "cooperative launch failed: %s (grid %d)\n", hipGetErrorString(e), grid_blocks);
#endif
}
```

```cpp
#include <hip/hip_runtime.h>
#include <hip/hip_cooperative_groups.h>
#include <cstdint>
#include <cstdio>
namespace cg = cooperative_groups;

#ifndef MULTI_LAUNCH
#define MULTI_LAUNCH 0
#endif

#ifndef PROBE_ODD
#define PROBE_ODD 0
#endif
#ifndef PROBE_EVEN
#define PROBE_EVEN 0
#endif
#ifndef PROBE_GIN
#define PROBE_GIN 0
#endif
#define DI __device__ __forceinline__
#define LAS __attribute__((address_space(3)))
typedef unsigned short bf16_t;
typedef short bf16x8 __attribute__((ext_vector_type(8)));
typedef short s16x4 __attribute__((ext_vector_type(4)));
typedef float f32x16 __attribute__((ext_vector_type(16)));
typedef float f32x4 __attribute__((ext_vector_type(4)));
typedef unsigned u32x4 __attribute__((ext_vector_type(4)));
typedef unsigned u32x2 __attribute__((ext_vector_type(2)));

constexpr int NTOK = 98304, NTOKP = 65536, UW = 3840, DM = 1024, MIXW = 1280;
constexpr int NTHREADS = 512;
constexpr int AT = 256;
constexpr int LDS_BYTES = 131072 + 32768;
constexpr float EPSF = 1e-6f;
constexpr float LOG2E = 1.4426950408889634f;
constexpr int NPHASE = 13;

struct Params {
  const float *xp, *xs, *memp, *mems, *norm_g, *w_in, *w_out, *mem_norm_g, *w_mem_kv, *mem_qk_g, *conv_w, *swa_qk_g,
      *swa_sink, *ax_qk_g, *diff_qk_g, *diff_lambda, *diff_subln_g;
  float* out;
  bf16_t *u, *xb, *wt_in, *wt_out, *wt_mem, *memb, *memkv;
  float *rstd, *rstd_mem, *tab1c, *tab1s, *tabac, *tabas, *lam;
  int phase_lo, phase_hi, probe, pad_;
};

typedef __bf16 bf16x2_t __attribute__((ext_vector_type(2)));
typedef float f32x2 __attribute__((ext_vector_type(2)));
DI unsigned cvtpk(float lo, float hi) { f32x2 v = {lo, hi}; bf16x2_t b = __builtin_convertvector(v, bf16x2_t); return __builtin_bit_cast(unsigned, b); }
DI float bf2f(unsigned short b) { return __uint_as_float(((unsigned)b) << 16); }
DI float bflo(unsigned w) { return __uint_as_float(w << 16); }
DI float bfhi(unsigned w) { return __uint_as_float(w & 0xffff0000u); }
DI int ltid() { int t; asm volatile("v_mov_b32 %0, %1" : "=v"(t) : "v"(threadIdx.x)); return t; }
DI int crow(int i, int h) { return (i & 3) + 8 * (i >> 2) + 4 * h; }
DI float swapmax(float v) { auto rr = __builtin_amdgcn_permlane32_swap(__float_as_uint(v), __float_as_uint(v), false, false); return fmaxf(__uint_as_float(rr[0]), __uint_as_float(rr[1])); }
DI float swapsum(float v) { auto rr = __builtin_amdgcn_permlane32_swap(__float_as_uint(v), __float_as_uint(v), false, false); return __uint_as_float(rr[0]) + __uint_as_float(rr[1]); }
DI float shx(float v, int lane, int o) { return __int_as_float(__builtin_amdgcn_ds_bpermute(((lane ^ o) & 63) << 2, __float_as_int(v))); }
DI float silu(float z) { return z / (1.f + __expf(-z)); }
#define MFMA32(a, b, c) __builtin_amdgcn_mfma_f32_32x32x16_bf16((a), (b), (c), 0, 0, 0)

DI void tok_info(int t, int& S, int& seq0, int& pos, int& sq) {
  if (t < NTOKP) { S = 8192; seq0 = t & ~8191; pos = t & 8191; sq = t >> 13; }
  else { int tt = t - NTOKP; S = 4096; seq0 = NTOKP + (tt & ~4095); pos = tt & 4095; sq = 8 + (tt >> 12); }
}

DI void transpose_tile(char* lds, const float* src, const float* g, bf16_t* dst, int K, int N, int k0, int n0) {
  float* tile = (float*)lds;
  const int tid = ltid(), a = tid >> 6, b = tid & 63;
#pragma unroll 4
  for (int i = 0; i < 8; ++i) { int kk = i * 8 + a; float v = src[(size_t)(k0 + kk) * N + n0 + b]; if (g) v *= g[k0 + kk]; tile[kk * 65 + b] = v; }
  __syncthreads();
#pragma unroll 4
  for (int i = 0; i < 8; ++i) { int nn = i * 8 + a; float v = tile[b * 65 + nn]; dst[(size_t)(n0 + nn) * K + k0 + b] = (bf16_t)(cvtpk(v, v) & 0xffffu); }
  __syncthreads();
}

DI void norm_rows(const float* src, bf16_t* dst, float* ssq, int row_begin, int row_end, int gw, int nw) {
  const int lane = ltid() & 63;
  for (int row = row_begin + gw; row < row_end; row += nw) {
    const float* s = src + (size_t)(row - row_begin) * DM; bf16_t* d = dst + (size_t)row * DM;
    f32x4 v[4]; float ss = 0.f;
#pragma unroll
    for (int j = 0; j < 4; ++j) { v[j] = *(const f32x4*)(s + (lane + 64 * j) * 4); ss += v[j][0] * v[j][0] + v[j][1] * v[j][1] + v[j][2] * v[j][2] + v[j][3] * v[j][3]; }
#pragma unroll
    for (int o = 32; o > 0; o >>= 1) ss += shx(ss, lane, o);
    const float rs = ssq ? 1.f : rsqrtf(ss * (1.f / DM) + EPSF);
#pragma unroll
    for (int j = 0; j < 4; ++j) { u32x2 w; w.x = cvtpk(v[j][0] * rs, v[j][1] * rs); w.y = cvtpk(v[j][2] * rs, v[j][3] * rs); *(u32x2*)(d + (lane + 64 * j) * 4) = w; }
    if (ssq && lane == 0) ssq[row] = ss;
  }
}

DI void phase_prep(char* lds, const Params& p) {
  const int T_IN = 4 * 16 * 60, T_OUT = 4 * 20 * 16, T_MEM = 4 * 16 * 8;
  for (int t = blockIdx.x; t < T_IN + T_OUT + T_MEM; t += gridDim.x) {
    if (t < T_IN) { int l = t / 960, r = t % 960, kt = r / 60, nt = r % 60;
      transpose_tile(lds, p.w_in + (size_t)l * DM * UW, p.norm_g + l * DM, p.wt_in + (size_t)l * UW * DM, DM, UW, kt * 64, nt * 64); }
    else if (t < T_IN + T_OUT) { int tt = t - T_IN; int l = tt / 320, r = tt % 320, kt = r / 16, nt = r % 16;
      transpose_tile(lds, p.w_out + (size_t)l * MIXW * DM, nullptr, p.wt_out + (size_t)l * DM * MIXW, MIXW, DM, kt * 64, nt * 64); }
    else { int tt = t - T_IN - T_OUT; int l = tt / 128, r = tt % 128, kt = r / 8, nt = r % 8;
      transpose_tile(lds, p.w_mem_kv + (size_t)l * DM * 512, p.mem_norm_g + l * DM, p.wt_mem + (size_t)l * 512 * DM, DM, 512, kt * 64, nt * 64); }
  }
  const int gw = blockIdx.x * 8 + (ltid() >> 6), nw = gridDim.x * 8;
  norm_rows(p.memp, p.memb, nullptr, 0, 2048, gw, nw);
  norm_rows(p.mems, p.memb, nullptr, 2048, 4096, gw, nw);
  norm_rows(p.xp, p.xb, p.rstd, 0, NTOKP, gw, nw);
  norm_rows(p.xs, p.xb, p.rstd, NTOKP, NTOK, gw, nw);
  const int gt = blockIdx.x * NTHREADS + ltid(), nt_ = gridDim.x * NTHREADS;
  for (int i = gt; i < 8192 * 32; i += nt_) { int pos = i >> 5, f = i & 31; float inv = powf(10000.f, -(float)(2 * f) / 64.f); float ang = (float)pos * inv; p.tab1c[i] = cosf(ang); p.tab1s[i] = sinf(ang); }
  for (int i = gt; i < 128 * 16; i += nt_) { int pos = i >> 4, f = i & 15; float inv = powf(10000.f, -(float)(2 * f) / 32.f); float ang = (float)pos * inv; p.tabac[i] = cosf(ang); p.tabas[i] = sinf(ang); }
  if (blockIdx.x == 0 && ltid() < 64) {
    const int lane = ltid();
    for (int o = 0; o < 2; ++o) {
      const float* lv = p.diff_lambda + o * 256;
      float a = lv[lane] * lv[64 + lane], b = lv[128 + lane] * lv[192 + lane];
#pragma unroll
      for (int s = 32; s > 0; s >>= 1) { a += shx(a, lane, s); b += shx(b, lane, s); }
      float li = 0.8f - 0.6f * expf(-0.3f * (float)(2 * o + 1));
      if (lane == 0) { p.lam[o * 2] = expf(a) - expf(b) + li; p.lam[o * 2 + 1] = 1.f - li; }
      float g0 = fabsf(p.ax_qk_g[o * 128 + lane]), g1 = fabsf(p.ax_qk_g[o * 128 + 64 + lane]);
      float g2 = fabsf(p.diff_qk_g[o * 128 + lane]), g3 = fabsf(p.diff_qk_g[o * 128 + 64 + lane]);
#pragma unroll
      for (int s = 32; s > 0; s >>= 1) { g0 = fmaxf(g0, shx(g0, lane, s)); g1 = fmaxf(g1, shx(g1, lane, s)); g2 = fmaxf(g2, shx(g2, lane, s)); g3 = fmaxf(g3, shx(g3, lane, s)); }
      if (lane == 0) { p.lam[8 + o * 2] = 8.f * g0 * g1 * 1.02f * LOG2E; p.lam[8 + o * 2 + 1] = 8.f * g2 * g3 * 1.02f * LOG2E; }
    }
  }
}

struct GemmDesc { const bf16_t* A; const bf16_t* Bt; int lda, K, mtiles, ntiles, remap, seg2; };
enum { EPI_IN = 0, EPI_MEM = 1, EPI_OUT = 2 };

DI void head_store(f32x16 v0, f32x16 v1, float rs, int mode, const float* gain, const Params& p, int pos, bf16_t* obase, int ldo, char* stg_wg) {
  const int tid_ = ltid(), lane = tid_ & 63, r = lane & 31, h = lane >> 5;
  char* stg = stg_wg + (tid_ >> 6) * 4096;
  v0 *= rs; v1 *= rs;
  if (mode) {
    float ss = 0.f;
#pragma unroll
    for (int i = 0; i < 16; ++i) ss += v0[i] * v0[i] + v1[i] * v1[i];
    ss = swapsum(ss);
    const float inv = rsqrtf(ss * (1.f / 64.f) + EPSF);
#pragma unroll
    for (int g4 = 0; g4 < 4; ++g4) {
      const f32x4 ga = *(const f32x4*)(gain + 8 * g4 + 4 * h), gb = *(const f32x4*)(gain + 32 + 8 * g4 + 4 * h);
#pragma unroll
      for (int j = 0; j < 4; ++j) { v0[4 * g4 + j] *= inv * ga[j]; v1[4 * g4 + j] *= inv * gb[j]; }
    }
    if (mode == 2) {
#pragma unroll
      for (int g4 = 0; g4 < 4; ++g4) {
        const f32x4 c = *(const f32x4*)(p.tab1c + pos * 32 + 8 * g4 + 4 * h), s = *(const f32x4*)(p.tab1s + pos * 32 + 8 * g4 + 4 * h);
#pragma unroll
        for (int j = 0; j < 4; ++j) { const int i = 4 * g4 + j; const float x1 = v0[i], x2 = v1[i]; v0[i] = x1 * c[j] - x2 * s[j]; v1[i] = x2 * c[j] + x1 * s[j]; }
      }
    } else if (mode == 3) {
      const int row = pos >> 6, col = pos & 63;
#pragma unroll
      for (int g4 = 0; g4 < 2; ++g4) {
        const f32x4 c0 = *(const f32x4*)(p.tabac + row * 16 + 8 * g4 + 4 * h), s0 = *(const f32x4*)(p.tabas + row * 16 + 8 * g4 + 4 * h);
        const f32x4 c1 = *(const f32x4*)(p.tabac + col * 16 + 8 * g4 + 4 * h), s1 = *(const f32x4*)(p.tabas + col * 16 + 8 * g4 + 4 * h);
#pragma unroll
        for (int j = 0; j < 4; ++j) { const int i = 4 * g4 + j;
          float x1 = v0[i], x2 = v0[i + 8]; v0[i] = x1 * c0[j] - x2 * s0[j]; v0[i + 8] = x2 * c0[j] + x1 * s0[j];
          x1 = v1[i]; x2 = v1[i + 8]; v1[i] = x1 * c1[j] - x2 * s1[j]; v1[i + 8] = x2 * c1[j] + x1 * s1[j]; }
      }
    }
  }
#pragma unroll
  for (int g4 = 0; g4 < 4; ++g4) {
    u32x2 w0, w1; w0.x = cvtpk(v0[4 * g4], v0[4 * g4 + 1]); w0.y = cvtpk(v0[4 * g4 + 2], v0[4 * g4 + 3]);
    w1.x = cvtpk(v1[4 * g4], v1[4 * g4 + 1]); w1.y = cvtpk(v1[4 * g4 + 2], v1[4 * g4 + 3]);
    *(u32x2*)(stg + r * 128 + ((g4 ^ (r & 7)) << 4) + h * 8) = w0;
    *(u32x2*)(stg + r * 128 + (((4 + g4) ^ (r & 7)) << 4) + h * 8) = w1;
  }
#pragma unroll
  for (int j = 0; j < 4; ++j) {
    const int row = (lane >> 3) + 8 * j, ch = lane & 7;
    const u32x4 w = *(const u32x4*)(stg + row * 128 + ((ch ^ (row & 7)) << 4));
    *(u32x4*)(obase + (size_t)row * ldo + ch * 8) = w;
  }
}

DI int in_mode(const Params& p, int layer, int n_h, const float*& gain) {
  int mode = 0; gain = p.mem_qk_g;
  if ((layer & 1) == 0) { const int e = layer >> 1;
    if (n_h >= 1536 && n_h < 2048) { mode = 2; gain = p.swa_qk_g + (e * 2) * 64; }
    else if (n_h >= 2048 && n_h < 2176) { mode = 2; gain = p.swa_qk_g + (e * 2 + 1) * 64; }
    else if (n_h >= 2304 && n_h < 2560) { mode = 1; gain = p.mem_qk_g + (layer * 2) * 64; }
  } else { const int o = layer >> 1;
    if (n_h < 512) { mode = 3; gain = p.ax_qk_g + (o * 2) * 64; }
    else if (n_h < 640) { mode = 3; gain = p.ax_qk_g + (o * 2 + 1) * 64; }
    else if (n_h >= 768 && n_h < 1280) { mode = 2; gain = p.diff_qk_g + (o * 2) * 64; }
    else if (n_h >= 1280 && n_h < 1792) { mode = 2; gain = p.diff_qk_g + (o * 2 + 1) * 64; }
    else if (n_h >= 2304 && n_h < 2560) { mode = 1; gain = p.mem_qk_g + (layer * 2) * 64; }
  }
  return mode;
}

template <int EPI>
DI void gemm_phase(char* lds, const Params& p, const GemmDesc g, int layer) {
  const int tid = ltid(), lane = tid & 63, wid = tid >> 6, wm = wid >> 1, wn = wid & 1, r = lane & 31, h = lane >> 5;
  const int srow = tid >> 3, sch = tid & 7;
  const int soff = srow * 128 + ((sch ^ ((srow >> 1) & 7)) << 4);
  const int nk = g.K >> 6;
  const int ntile = g.mtiles * g.ntiles;
  const bool banded = ((gridDim.x & 7) == 0) && ((g.mtiles & 63) == 0);
  const int nx = banded ? 8 : 1, bx = blockIdx.x % nx, bi = blockIdx.x / nx, nbx = gridDim.x / nx;
  const int per_band = 8 * g.ntiles;
  const int qtot = ntile / nx;
  int q = bi;
  if (q >= qtot) return;
  int mt, nt;
#define G_TILE(qq, MT, NT) do { if (banded) { const int bl_ = (qq) / per_band, rem_ = (qq) - bl_ * per_band; NT = rem_ >> 3; MT = (bl_ * 8 + bx) * 8 + (rem_ & 7); } \
    else { MT = (qq) / g.ntiles; NT = (qq) - MT * g.ntiles; } } while (0)
#define G_LOAD(AG, BG, kt, RA, RB) do { const int k0_ = (kt) * 64; int ac_ = k0_; if (g.remap) ac_ = k0_ < 512 ? k0_ : (k0_ < 1024 ? g.seg2 + k0_ - 512 : 2304 + k0_ - 1024); \
    _Pragma("unroll") for (int i = 0; i < 4; ++i) { RA[i] = *(const u32x4*)(AG + (size_t)(64 * i) * g.lda + ac_); RB[i] = *(const u32x4*)(BG + (size_t)(64 * i) * g.K + k0_); } } while (0)
#define G_WRITE(buf, RA, RB) do { _Pragma("unroll") for (int i = 0; i < 4; ++i) { *(u32x4*)(lds + (buf) * 65536 + i * 8192 + soff) = RA[i]; *(u32x4*)(lds + (buf) * 65536 + 32768 + i * 8192 + soff) = RB[i]; } } while (0)
#define G_COMPUTE(buf) do { _Pragma("unroll") for (int ks = 0; ks < 4; ++ks) { const int co_ = ((2 * ks + h) ^ ((r >> 1) & 7)) << 4; \
      const char* la_ = lds + (buf) * 65536 + (wm * 64 + r) * 128 + co_; const char* lb_ = lds + (buf) * 65536 + 32768 + (wn * 128 + r) * 128 + co_; \
      bf16x8 fa_[2], fb_[4]; fa_[0] = *(const bf16x8*)(la_); fa_[1] = *(const bf16x8*)(la_ + 4096); \
      _Pragma("unroll") for (int ni = 0; ni < 4; ++ni) fb_[ni] = *(const bf16x8*)(lb_ + ni * 4096); \
      _Pragma("unroll") for (int ni = 0; ni < 4; ++ni) { acc[0][ni] = MFMA32(fb_[ni], fa_[0], acc[0][ni]); acc[1][ni] = MFMA32(fb_[ni], fa_[1], acc[1][ni]); } } } while (0)
  G_TILE(q, mt, nt);
  const bf16_t* Ag = g.A + (size_t)(mt * 256 + srow) * g.lda + sch * 8;
  const bf16_t* Bg = g.Bt + (size_t)(nt * 256 + srow) * g.K + sch * 8;
  u32x4 ra0[4], rb0[4];
  G_LOAD(Ag, Bg, 0, ra0, rb0); G_WRITE(0, ra0, rb0); __syncthreads();
  for (;;) {
    const int qn = q + nbx; const bool has_next = qn < qtot;
    int mtn = mt, ntn = nt; if (has_next) G_TILE(qn, mtn, ntn);
    const bf16_t* Agn = g.A + (size_t)(mtn * 256 + srow) * g.lda + sch * 8;
    const bf16_t* Bgn = g.Bt + (size_t)(ntn * 256 + srow) * g.K + sch * 8;
    f32x16 acc[2][4];
#pragma unroll
    for (int a = 0; a < 2; ++a)
#pragma unroll
      for (int b = 0; b < 4; ++b)
#pragma unroll
        for (int i = 0; i < 16; ++i) acc[a][b][i] = 0.f;
    for (int kt = 0; kt < nk; kt += 2) {
      const bool last = kt + 2 >= nk;
      G_LOAD(Ag, Bg, kt + 1, ra0, rb0);
      __builtin_amdgcn_sched_barrier(0);
      G_COMPUTE(0);
      G_WRITE(1, ra0, rb0);
      __syncthreads();
      if (!last) G_LOAD(Ag, Bg, kt + 2, ra0, rb0); else if (has_next) G_LOAD(Agn, Bgn, 0, ra0, rb0);
      __builtin_amdgcn_sched_barrier(0);
      G_COMPUTE(1);
      if (!last || has_next) G_WRITE(0, ra0, rb0);
      __syncthreads();
    }
    const int n_w = nt * 256 + wn * 128;
    if (EPI == EPI_IN) {
#pragma unroll
      for (int hu = 0; hu < 2; ++hu) {
        const int n_h = n_w + 64 * hu; const float* gain; const int mode = in_mode(p, layer, n_h, gain);
#pragma unroll
        for (int mi = 0; mi < 2; ++mi) {
          const int t = mt * 256 + wm * 64 + mi * 32 + r;
          int S, seq0, pos, sq; tok_info(t, S, seq0, pos, sq);
          const float rs = rsqrtf(p.rstd[(layer & 1) * NTOK + t] * (1.f / DM) + EPSF);
          head_store(acc[mi][2 * hu], acc[mi][2 * hu + 1], rs, mode, gain, p, pos, p.u + (size_t)(t - r) * UW + n_h, UW, lds + 131072);
        }
      }
    } else if (EPI == EPI_MEM) {
#pragma unroll
      for (int hu = 0; hu < 2; ++hu) {
        const int n_h = n_w + 64 * hu, l = n_h >> 9, c = n_h & 511;
        const int mode = c < 256 ? 1 : 0; const float* gain = p.mem_qk_g + (l * 2 + 1) * 64;
#pragma unroll
        for (int mi = 0; mi < 2; ++mi) {
          const int row = mt * 256 + wm * 64 + mi * 32 + r;
          head_store(acc[mi][2 * hu], acc[mi][2 * hu + 1], 1.f, mode, gain, p, 0, p.memkv + (size_t)(row - r) * 2048 + n_h, 2048, lds + 131072);
        }
      }
    } else {
      const int tid_ = ltid(), lane = tid_ & 63, r = lane & 31, h = lane >> 5;
      char* stg = lds + 131072 + (tid_ >> 6) * 4096;
#pragma unroll
      for (int mi = 0; mi < 2; ++mi) {
        const int t0 = mt * 256 + wm * 64 + mi * 32;
        const float* xin0 = layer == 0 ? (t0 < NTOKP ? p.xp + (size_t)t0 * DM : p.xs + (size_t)(t0 - NTOKP) * DM) : p.out + (size_t)t0 * DM;
        float* xo0 = p.out + (size_t)t0 * DM;
        bf16_t* xb0 = p.xb + (size_t)t0 * DM;
        float ssj[4] = {0.f, 0.f, 0.f, 0.f};
#pragma unroll
        for (int ni = 0; ni < 4; ++ni) {
#pragma unroll
          for (int g4 = 0; g4 < 4; ++g4) {
            f32x4 v; v[0] = acc[mi][ni][4 * g4]; v[1] = acc[mi][ni][4 * g4 + 1]; v[2] = acc[mi][ni][4 * g4 + 2]; v[3] = acc[mi][ni][4 * g4 + 3];
            *(f32x4*)(stg + r * 128 + (((2 * g4 + h) ^ (r & 7)) << 4)) = v;
          }
#pragma unroll
          for (int j = 0; j < 4; ++j) {
            const int row = (lane >> 3) + 8 * j, ch = lane & 7;
            const f32x4 a = *(const f32x4*)(stg + row * 128 + ((ch ^ (row & 7)) << 4));
            const size_t off = (size_t)row * DM + n_w + ni * 32 + ch * 4;
            f32x4 xv = *(const f32x4*)(xin0 + off);
            xv += a;
            *(f32x4*)(xo0 + off) = xv;
            if (layer < 3) {
              u32x2 w; w.x = cvtpk(xv[0], xv[1]); w.y = cvtpk(xv[2], xv[3]);
              *(u32x2*)(xb0 + off) = w;
              ssj[j] += xv[0] * xv[0] + xv[1] * xv[1] + xv[2] * xv[2] + xv[3] * xv[3];
            }
          }
        }
        if (layer < 3) {
#pragma unroll
          for (int j = 0; j < 4; ++j) {
            float v = ssj[j];
            v += shx(v, lane, 1); v += shx(v, lane, 2); v += shx(v, lane, 4);
            if ((lane & 7) == 0) atomicAdd(p.rstd + ((layer + 1) & 1) * NTOK + t0 + (lane >> 3) + 8 * j, v);
          }
        }
      }
    }
    if (!has_next) break;
    q = qn; mt = mtn; nt = ntn; Ag = Agn; Bg = Bgn;
  }
#undef G_TILE
#undef G_LOAD
#undef G_WRITE
#undef G_COMPUTE
}

enum { AM_PLAIN = 0, AM_SWA = 1, AM_DIFF = 2 };
struct AttnJob {
  const bf16_t* q;
  const bf16_t* k[2];
  const bf16_t* v;
  int ldk, ldv;
  int tile_lo, tile_hi;
  float m_init, l_init;
  int qpos0;
  bf16_t* o;
  const bf16_t* z;
  float lam, oscale;
  const float* subg;
  int dry;
};

template <int DV, int MODE>
DI void attn_finalize(char* lds, const AttnJob& J, f32x16 (&O)[DV / 32], const float lt, const int wid, const int r, const int h) {
  constexpr int NDV = DV / 32;
  const float inv = 1.f / lt;
  if (MODE != AM_DIFF) {
    bf16_t* orow = J.o + (size_t)r * UW; const bf16_t* zrow = J.z + (size_t)r * UW;
#pragma unroll
    for (int d = 0; d < NDV; ++d)
#pragma unroll
      for (int g4 = 0; g4 < 4; ++g4) {
        const int dv = 32 * d + 8 * g4 + 4 * h;
        const u32x2 zw = *(const u32x2*)(zrow + dv);
        const float y0 = O[d][4 * g4] * inv * silu(bflo(zw.x)), y1 = O[d][4 * g4 + 1] * inv * silu(bfhi(zw.x));
        const float y2 = O[d][4 * g4 + 2] * inv * silu(bflo(zw.y)), y3 = O[d][4 * g4 + 3] * inv * silu(bfhi(zw.y));
        u32x2 w; w.x = cvtpk(y0, y1); w.y = cvtpk(y2, y3);
        *(u32x2*)(orow + dv) = w;
      }
  } else {
    float* sc = (float*)(lds + 32768) + (wid >> 1) * (DV * 32);
    if (wid & 1) {
      const float f = inv * J.lam;
#pragma unroll
      for (int d = 0; d < NDV; ++d)
#pragma unroll
        for (int i = 0; i < 16; ++i) sc[(32 * d + crow(i, h)) * 32 + r] = O[d][i] * f;
    }
    __syncthreads();
    if (!(wid & 1)) {
      float ss = 0.f;
#pragma unroll
      for (int d = 0; d < NDV; ++d)
#pragma unroll
        for (int i = 0; i < 16; ++i) { const float a = O[d][i] * inv - sc[(32 * d + crow(i, h)) * 32 + r]; O[d][i] = a; ss += a * a; }
      ss = swapsum(ss);
      const float rn = rsqrtf(ss * (1.f / DV) + EPSF) * J.oscale;
      bf16_t* orow = J.o + (size_t)r * UW; const bf16_t* zrow = J.z + (size_t)r * UW;
#pragma unroll
      for (int d = 0; d < NDV; ++d)
#pragma unroll
        for (int g4 = 0; g4 < 4; ++g4) {
          const int dv = 32 * d + 8 * g4 + 4 * h;
          const u32x2 zw = *(const u32x2*)(zrow + dv);
          const f32x4 sg = *(const f32x4*)(J.subg + dv);
          const float y0 = O[d][4 * g4] * rn * sg[0] * silu(bflo(zw.x)), y1 = O[d][4 * g4 + 1] * rn * sg[1] * silu(bfhi(zw.x));
          const float y2 = O[d][4 * g4 + 2] * rn * sg[2] * silu(bflo(zw.y)), y3 = O[d][4 * g4 + 3] * rn * sg[3] * silu(bfhi(zw.y));
          u32x2 w; w.x = cvtpk(y0, y1); w.y = cvtpk(y2, y3);
          *(u32x2*)(orow + dv) = w;
        }
    }
  }
}

template <int DV, int NK, int MODE, bool FIXM, int GRP>
DI void attn_job(char* lds_wg, const AttnJob& J) {
  constexpr int NDV = DV / 32;
  constexpr float C = 0.125f * LOG2E;
  const int tid_wg = ltid(), tid = tid_wg & (AT - 1), lane = tid & 63, wid = tid >> 6, r = lane & 31, h = lane >> 5;
  char* lds = lds_wg + GRP * 65536;
  const int kstream = (NK == 2) ? (wid & 1) : 0;
  bf16x8 qf[4];
  const bf16_t* qrow = J.q + (size_t)r * UW + 8 * h;
#pragma unroll
  for (int ds = 0; ds < 4; ++ds) qf[ds] = *(const bf16x8*)(qrow + 16 * ds);
  f32x16 O[NDV];
#pragma unroll
  for (int d = 0; d < NDV; ++d)
#pragma unroll
    for (int i = 0; i < 16; ++i) O[d][i] = 0.f;
  float m = J.m_init, l = (h == 0) ? J.l_init : 0.f;
  f32x16 Osum;
#pragma unroll
  for (int i = 0; i < 16; ++i) Osum[i] = 0.f;
  const bf16x8 ones = {0x3F80, 0x3F80, 0x3F80, 0x3F80, 0x3F80, 0x3F80, 0x3F80, 0x3F80};
  const int ksrow = tid >> 3, ksch = tid & 7;
  const int kpi = (ksrow & ~12) | ((ksrow & 4) << 1) | ((ksrow & 8) >> 1);
  const int ksoff = kpi * 128 + ((ksch ^ ((kpi >> 1) & 7)) << 4);
  constexpr int VCH = DV / 8;
  constexpr int VI = (64 * VCH) / AT;
  const int vkey0 = tid / VCH, vc8 = (tid % VCH) * 8;
  u32x4 rk0[NK][2], rv0[VI], rk1[NK][2], rv1[VI];
#define A_LOAD(t, rk, rv) do { const size_t kb_ = (size_t)(t) * 64; \
    _Pragma("unroll") for (int s = 0; s < NK; ++s) _Pragma("unroll") for (int i = 0; i < 2; ++i) rk[s][i] = *(const u32x4*)(J.k[s] + (kb_ + ksrow + 32 * i) * J.ldk + ksch * 8); \
    _Pragma("unroll") for (int i = 0; i < VI; ++i) rv[i] = *(const u32x4*)(J.v + (kb_ + vkey0 + (AT / VCH) * i) * J.ldv + vc8); } while (0)
#define A_WRITE(st, rk, rv) do { char* b_ = lds + (st) * 32768; \
    _Pragma("unroll") for (int s = 0; s < NK; ++s) _Pragma("unroll") for (int i = 0; i < 2; ++i) *(u32x4*)(b_ + s * 8192 + i * 4096 + ksoff) = rk[s][i]; \
    _Pragma("unroll") for (int i = 0; i < VI; ++i) { const int key_ = vkey0 + (AT / VCH) * i; \
      *(u32x4*)(b_ + NK * 8192 + ((key_ >> 3) * NDV + (vc8 >> 5)) * 512 + (key_ & 7) * 64 + (vc8 & 31) * 2) = rv[i]; } } while (0)
  const int nt = J.tile_hi - J.tile_lo;
  constexpr bool DEEP2 = FIXM || MODE != AM_DIFF;
  constexpr bool ONESET = FIXM;
  A_LOAD(J.tile_lo, rk0, rv0); A_WRITE(0, rk0, rv0); if (ONESET) A_LOAD(J.tile_lo + 1, rk0, rv0); else if (DEEP2) A_LOAD(J.tile_lo + 1, rk1, rv1); __syncthreads();
  const int i16 = lane & 15;
  const int vrd = h * NDV * 512 + (i16 >> 2) * 64 + (((lane >> 4) & 1) * 16 + (i16 & 3) * 4) * 2;
  auto compute = [&](const int stage, const int tile) __attribute__((always_inline)) {
    bool active = true;
    if (MODE == AM_SWA) { const int k0 = tile * 64; active = !(k0 > J.qpos0 + 31 + 128 || k0 + 63 < J.qpos0 - 128); }
    if (active) {
      const char* Kl = lds + stage * 32768 + kstream * 8192 + r * 128;
      f32x16 sA, sB;
#pragma unroll
      for (int i = 0; i < 16; ++i) { sA[i] = 0.f; sB[i] = 0.f; }
      if (NDV == 2 || FIXM) {
        bf16x8 ka[4], kb[4];
#pragma unroll
        for (int ds = 0; ds < 4; ++ds) { const int co = ((2 * ds + h) ^ ((r >> 1) & 7)) << 4; ka[ds] = *(const bf16x8*)(Kl + co); kb[ds] = *(const bf16x8*)(Kl + 4096 + co); }
#pragma unroll
        for (int ds = 0; ds < 4; ++ds) { sA = MFMA32(ka[ds], qf[ds], sA); sB = MFMA32(kb[ds], qf[ds], sB); }
        __builtin_amdgcn_sched_group_barrier(0x100, 4, 0); __builtin_amdgcn_sched_group_barrier(0x008, 2, 0);
        __builtin_amdgcn_sched_group_barrier(0x100, 2, 0); __builtin_amdgcn_sched_group_barrier(0x008, 2, 0);
        __builtin_amdgcn_sched_group_barrier(0x100, 2, 0); __builtin_amdgcn_sched_group_barrier(0x008, 4, 0);
      } else {
#pragma unroll
        for (int ds = 0; ds < 4; ++ds) {
          const int co = ((2 * ds + h) ^ ((r >> 1) & 7)) << 4;
          const bf16x8 ka = *(const bf16x8*)(Kl + co), kb = *(const bf16x8*)(Kl + 4096 + co);
          sA = MFMA32(ka, qf[ds], sA); sB = MFMA32(kb, qf[ds], sB);
        }
      }
      if (MODE == AM_SWA) {
        const int qa = J.qpos0 + r, kbase = tile * 64 + 8 * h;
#pragma unroll
        for (int i = 0; i < 16; ++i) {
          const int ka_ = kbase + 16 * (i >> 3) + (i & 7);
          int d0 = qa - ka_; d0 = d0 < 0 ? -d0 : d0; if (d0 > 128) sA[i] = -INFINITY;
          int d1 = qa - (ka_ + 32); d1 = d1 < 0 ? -d1 : d1; if (d1 > 128) sB[i] = -INFINITY;
        }
      }
      if (FIXM) {
        const float nm = -J.m_init;
#pragma unroll
        for (int i = 0; i < 16; ++i) { sA[i] = __builtin_amdgcn_exp2f(fmaf(sA[i], C, nm)); sB[i] = __builtin_amdgcn_exp2f(fmaf(sB[i], C, nm)); l += sA[i] + sB[i]; }
      } else {
      float mx = sA[0];
#pragma unroll
      for (int i = 1; i < 16; ++i) mx = fmaxf(mx, sA[i]);
#pragma unroll
      for (int i = 0; i < 16; ++i) mx = fmaxf(mx, sB[i]);
      mx = swapmax(mx);
      const float mn = fmaxf(m, mx * C);
      const float alpha = __builtin_amdgcn_exp2f(m - mn);
      m = mn;
      float ps = 0.f;
#pragma unroll
      for (int i = 0; i < 16; ++i) { sA[i] = __builtin_amdgcn_exp2f(fmaf(sA[i], C, -mn)); sB[i] = __builtin_amdgcn_exp2f(fmaf(sB[i], C, -mn)); ps += sA[i] + sB[i]; }
      l = l * alpha + ps;
#pragma unroll
      for (int d = 0; d < NDV; ++d)
#pragma unroll
        for (int i = 0; i < 16; ++i) O[d][i] *= alpha;
      }
      bf16x8 pf[4];
      { u32x4 w;
        w.x = cvtpk(sA[0], sA[1]); w.y = cvtpk(sA[2], sA[3]); w.z = cvtpk(sA[4], sA[5]); w.w = cvtpk(sA[6], sA[7]); pf[0] = __builtin_bit_cast(bf16x8, w);
        w.x = cvtpk(sA[8], sA[9]); w.y = cvtpk(sA[10], sA[11]); w.z = cvtpk(sA[12], sA[13]); w.w = cvtpk(sA[14], sA[15]); pf[1] = __builtin_bit_cast(bf16x8, w);
        w.x = cvtpk(sB[0], sB[1]); w.y = cvtpk(sB[2], sB[3]); w.z = cvtpk(sB[4], sB[5]); w.w = cvtpk(sB[6], sB[7]); pf[2] = __builtin_bit_cast(bf16x8, w);
        w.x = cvtpk(sB[8], sB[9]); w.y = cvtpk(sB[10], sB[11]); w.z = cvtpk(sB[12], sB[13]); w.w = cvtpk(sB[14], sB[15]); pf[3] = __builtin_bit_cast(bf16x8, w); }
      const char* Vl = lds + stage * 32768 + NK * 8192 + vrd;
      if (FIXM) {
        bf16x8 vf[4][NDV];
#pragma unroll
        for (int ks = 0; ks < 4; ++ks) {
#pragma unroll
          for (int d = 0; d < NDV; ++d) {
            const s16x4 lo = __builtin_amdgcn_ds_read_tr16_b64_v4i16((LAS s16x4*)(Vl + ks * 2 * NDV * 512 + d * 512));
            const s16x4 hi = __builtin_amdgcn_ds_read_tr16_b64_v4i16((LAS s16x4*)(Vl + ks * 2 * NDV * 512 + d * 512 + 256));
            vf[ks][d] = __builtin_shufflevector(lo, hi, 0, 1, 2, 3, 4, 5, 6, 7);
          }
        }
#pragma unroll
        for (int ks = 0; ks < 4; ++ks) {
#pragma unroll
          for (int d = 0; d < NDV; ++d) O[d] = MFMA32(vf[ks][d], pf[ks], O[d]);
        }
        __builtin_amdgcn_sched_group_barrier(0x100, 4 * NDV, 0); __builtin_amdgcn_sched_group_barrier(0x008, NDV, 0);
        __builtin_amdgcn_sched_group_barrier(0x100, 2 * NDV, 0); __builtin_amdgcn_sched_group_barrier(0x008, NDV, 0);
        __builtin_amdgcn_sched_group_barrier(0x100, 2 * NDV, 0); __builtin_amdgcn_sched_group_barrier(0x008, 2 * NDV, 0);
      } else {
      if (FIXM) {
#pragma unroll
        for (int ks = 0; ks < 4; ++ks) Osum = MFMA32(ones, pf[ks], Osum);
      }
#pragma unroll
      for (int ks = 0; ks < 4; ++ks)
#pragma unroll
        for (int d = 0; d < NDV; ++d) {
          const s16x4 lo = __builtin_amdgcn_ds_read_tr16_b64_v4i16((LAS s16x4*)(Vl + ks * 2 * NDV * 512 + d * 512));
          const s16x4 hi = __builtin_amdgcn_ds_read_tr16_b64_v4i16((LAS s16x4*)(Vl + ks * 2 * NDV * 512 + d * 512 + 256));
          const bf16x8 vf = __builtin_shufflevector(lo, hi, 0, 1, 2, 3, 4, 5, 6, 7);
          O[d] = MFMA32(vf, pf[ks], O[d]);
        }
      }
    }
  };
  for (int it = 0; it < nt; it += 2) {
    if (ONESET) {
      A_WRITE(1, rk0, rv0);
      if (it + 2 < nt) A_LOAD(J.tile_lo + it + 2, rk0, rv0);
      __builtin_amdgcn_sched_barrier(0);
      compute(0, J.tile_lo + it);
      __syncthreads();
      if (it + 2 < nt) A_WRITE(0, rk0, rv0);
      if (it + 3 < nt) A_LOAD(J.tile_lo + it + 3, rk0, rv0);
      __builtin_amdgcn_sched_barrier(0);
      compute(1, J.tile_lo + it + 1);
      __syncthreads();
    } else if (DEEP2) {
      if (it + 2 < nt) A_LOAD(J.tile_lo + it + 2, rk0, rv0);
      compute(0, J.tile_lo + it);
      A_WRITE(1, rk1, rv1);
      __syncthreads();
      if (it + 3 < nt) A_LOAD(J.tile_lo + it + 3, rk1, rv1);
      compute(1, J.tile_lo + it + 1);
      if (it + 2 < nt) A_WRITE(0, rk0, rv0);
      __syncthreads();
    } else {
      compute(0, J.tile_lo + it);
      __builtin_amdgcn_sched_barrier(0);
      A_LOAD(J.tile_lo + it + 1, rk0, rv0); A_WRITE(1, rk0, rv0);
      __syncthreads();
      compute(1, J.tile_lo + it + 1);
      __builtin_amdgcn_sched_barrier(0);
      if (it + 2 < nt) { A_LOAD(J.tile_lo + it + 2, rk0, rv0); A_WRITE(0, rk0, rv0); }
      __syncthreads();
    }
  }
#undef A_LOAD
#undef A_WRITE
  if (J.dry) return;
  const float lt = swapsum(l);
  attn_finalize<DV, MODE>(lds, J, O, lt, wid, r, h);
}

template <int DV, int NK, int MODE, int GRP>
DI void attn_pipe(char* lds_wg, const AttnJob& J) {
  constexpr int NDV = DV / 32;
  constexpr float C = 0.125f * LOG2E;
  constexpr int KST = NK * 8192, VST = DV * 128, VB = 2 * KST;
  const int tid_wg = ltid(), tid = tid_wg & (AT - 1), lane = tid & 63, wid = tid >> 6, r = lane & 31, h = lane >> 5;
  char* lds = lds_wg + GRP * 65536;
  const int kstream = (NK == 2) ? (wid & 1) : 0;
  bf16x8 qf[4];
  const bf16_t* qrow = J.q + (size_t)r * UW + 8 * h;
#pragma unroll
  for (int ds = 0; ds < 4; ++ds) qf[ds] = *(const bf16x8*)(qrow + 16 * ds);
  f32x16 O[NDV], Osum;
#pragma unroll
  for (int d = 0; d < NDV; ++d)
#pragma unroll
    for (int i = 0; i < 16; ++i) O[d][i] = 0.f;
#pragma unroll
  for (int i = 0; i < 16; ++i) Osum[i] = 0.f;
  const bf16x8 ones = {0x3F80, 0x3F80, 0x3F80, 0x3F80, 0x3F80, 0x3F80, 0x3F80, 0x3F80};
  const float nm = -J.m_init;
  const int ksrow = tid >> 3, ksch = tid & 7;
  const int kpi = (ksrow & ~12) | ((ksrow & 4) << 1) | ((ksrow & 8) >> 1);
  const int ksoff = kpi * 128 + ((ksch ^ ((kpi >> 1) & 7)) << 4);
  constexpr int VCH = DV / 8, VI = (64 * VCH) / AT;
  const int vkey0 = tid / VCH, vc8 = (tid % VCH) * 8;
  u32x4 rk0[NK][2], rv0[VI], rk1[NK][2], rv1[VI];
#define K_LOAD(t, rk) do { const size_t kb_ = (size_t)(t) * 64; \
    _Pragma("unroll") for (int s = 0; s < NK; ++s) _Pragma("unroll") for (int i = 0; i < 2; ++i) rk[s][i] = *(const u32x4*)(J.k[s] + (kb_ + ksrow + 32 * i) * J.ldk + ksch * 8); } while (0)
#define V_LOAD(t, rv) do { const size_t kb_ = (size_t)(t) * 64; \
    _Pragma("unroll") for (int i = 0; i < VI; ++i) rv[i] = *(const u32x4*)(J.v + (kb_ + vkey0 + (AT / VCH) * i) * J.ldv + vc8); } while (0)
#define K_WRITE(st, rk) do { char* b_ = lds + (st) * KST; \
    _Pragma("unroll") for (int s = 0; s < NK; ++s) _Pragma("unroll") for (int i = 0; i < 2; ++i) *(u32x4*)(b_ + s * 8192 + i * 4096 + ksoff) = rk[s][i]; } while (0)
#define V_WRITE(st, rv) do { char* b_ = lds + VB + (st) * VST; \
    _Pragma("unroll") for (int i = 0; i < VI; ++i) { const int key_ = vkey0 + (AT / VCH) * i; \
      *(u32x4*)(b_ + ((key_ >> 3) * NDV + (vc8 >> 5)) * 512 + (key_ & 7) * 64 + (vc8 & 31) * 2) = rv[i]; } } while (0)
  const int nt = J.tile_hi - J.tile_lo, t0 = J.tile_lo;
  const int i16 = lane & 15;
  const int vrd = h * NDV * 512 + (i16 >> 2) * 64 + (((lane >> 4) & 1) * 16 + (i16 & 3) * 4) * 2;
  auto qk = [&](const int kst, f32x16& sA, f32x16& sB) __attribute__((always_inline)) {
    const char* Kl = lds + kst * KST + kstream * 8192 + r * 128;
#pragma unroll
    for (int i = 0; i < 16; ++i) { sA[i] = 0.f; sB[i] = 0.f; }
    bf16x8 ka[4], kb[4];
#pragma unroll
    for (int ds = 0; ds < 4; ++ds) { const int co = ((2 * ds + h) ^ ((r >> 1) & 7)) << 4; ka[ds] = *(const bf16x8*)(Kl + co); kb[ds] = *(const bf16x8*)(Kl + 4096 + co); }
    __builtin_amdgcn_sched_barrier(0);
#pragma unroll
    for (int ds = 0; ds < 4; ++ds) { sA = MFMA32(ka[ds], qf[ds], sA); sB = MFMA32(kb[ds], qf[ds], sB); }
  };
  auto smpv = [&](const int vst, f32x16& sA, f32x16& sB) __attribute__((always_inline)) {
    const char* Vl = lds + VB + vst * VST + vrd;
    bf16x8 vf[4][NDV];
#pragma unroll
    for (int ks = 0; ks < 4; ++ks)
#pragma unroll
      for (int d = 0; d < NDV; ++d) {
        const s16x4 lo = __builtin_amdgcn_ds_read_tr16_b64_v4i16((LAS s16x4*)(Vl + ks * 2 * NDV * 512 + d * 512));
        const s16x4 hi = __builtin_amdgcn_ds_read_tr16_b64_v4i16((LAS s16x4*)(Vl + ks * 2 * NDV * 512 + d * 512 + 256));
        vf[ks][d] = __builtin_shufflevector(lo, hi, 0, 1, 2, 3, 4, 5, 6, 7);
      }
    __builtin_amdgcn_sched_barrier(0);
#pragma unroll
    for (int i = 0; i < 16; ++i) { sA[i] = __builtin_amdgcn_exp2f(fmaf(sA[i], C, nm)); sB[i] = __builtin_amdgcn_exp2f(fmaf(sB[i], C, nm)); }
    bf16x8 pf[4];
    { u32x4 w;
      w.x = cvtpk(sA[0], sA[1]); w.y = cvtpk(sA[2], sA[3]); w.z = cvtpk(sA[4], sA[5]); w.w = cvtpk(sA[6], sA[7]); pf[0] = __builtin_bit_cast(bf16x8, w);
      w.x = cvtpk(sA[8], sA[9]); w.y = cvtpk(sA[10], sA[11]); w.z = cvtpk(sA[12], sA[13]); w.w = cvtpk(sA[14], sA[15]); pf[1] = __builtin_bit_cast(bf16x8, w);
      w.x = cvtpk(sB[0], sB[1]); w.y = cvtpk(sB[2], sB[3]); w.z = cvtpk(sB[4], sB[5]); w.w = cvtpk(sB[6], sB[7]); pf[2] = __builtin_bit_cast(bf16x8, w);
      w.x = cvtpk(sB[8], sB[9]); w.y = cvtpk(sB[10], sB[11]); w.z = cvtpk(sB[12], sB[13]); w.w = cvtpk(sB[14], sB[15]); pf[3] = __builtin_bit_cast(bf16x8, w); }
#pragma unroll
    for (int ks = 0; ks < 4; ++ks) Osum = MFMA32(ones, pf[ks], Osum);
#pragma unroll
    for (int ks = 0; ks < 4; ++ks)
#pragma unroll
      for (int d = 0; d < NDV; ++d) O[d] = MFMA32(vf[ks][d], pf[ks], O[d]);
  };
  K_LOAD(t0, rk0); V_LOAD(t0, rv0); K_LOAD(t0 + 1, rk1);
  K_WRITE(0, rk0); V_WRITE(0, rv0); K_WRITE(1, rk1);
  if (2 < nt) K_LOAD(t0 + 2, rk0);
  V_LOAD(t0 + 1, rv0);
  __syncthreads();
  f32x16 eA, eB, oA, oB;
  qk(0, eA, eB);
  __syncthreads();
  for (int j = 0; j < nt; j += 2) {
    if (j + 3 < nt) K_LOAD(t0 + j + 3, rk1);
    if (j + 2 < nt) V_LOAD(t0 + j + 2, rv1);
    qk(1, oA, oB);
    __builtin_amdgcn_sched_barrier(0);
    smpv(0, eA, eB);
    if (j + 2 < nt) K_WRITE(0, rk0);
    V_WRITE(1, rv0);
    __syncthreads();
    if (j + 4 < nt) K_LOAD(t0 + j + 4, rk0);
    if (j + 3 < nt) V_LOAD(t0 + j + 3, rv0);
    if (j + 2 < nt) qk(0, eA, eB);
    __builtin_amdgcn_sched_barrier(0);
    smpv(1, oA, oB);
    if (j + 3 < nt) K_WRITE(1, rk1);
    if (j + 2 < nt) V_WRITE(0, rv1);
    __syncthreads();
  }
#undef K_LOAD
#undef V_LOAD
#undef K_WRITE
#undef V_WRITE
  if (J.dry) return;
  attn_finalize<DV, MODE>(lds, J, O, Osum[0], wid, r, h);
}

#define PIPE_CALL(DV, NK, MODE) do { if (grp) attn_pipe<DV, NK, MODE, 1>(lds, J); else attn_pipe<DV, NK, MODE, 0>(lds, J); } while (0)
#define ATTN_CALL(DV, NK, MODE, FIXM) do { if (grp) attn_job<DV, NK, MODE, FIXM, 1>(lds, J); else attn_job<DV, NK, MODE, FIXM, 0>(lds, J); } while (0)
DI void mem_jobs(char* lds, const Params& p, int layer, int dry) {
  const int grp = __builtin_amdgcn_readfirstlane(ltid() >> 8);
  const int wid = (ltid() >> 6) & 3, vb = blockIdx.x * 2 + grp, vg = gridDim.x * 2;
  for (int job = vb; job < 768 * 4; job += vg) {
    const int qb = job >> 2, hm = job & 3, t0 = qb * 128;
    int S, seq0, pos, sq; tok_info(t0, S, seq0, pos, sq);
    AttnJob J;
    bf16_t* qo = p.u + (size_t)(t0 + 32 * wid) * UW + 2304 + hm * 64;
    J.q = qo; J.o = qo; J.z = p.u + (size_t)(t0 + 32 * wid) * UW + 2560 + 1024 + hm * 64;
    J.k[0] = J.k[1] = p.memkv + (size_t)(sq * 256) * 2048 + layer * 512 + hm * 64; J.v = J.k[0] + 256; J.ldk = J.ldv = 2048;
    J.tile_lo = 0; J.tile_hi = 4; J.m_init = -1e30f; J.l_init = 0.f; J.qpos0 = 0; J.lam = 0.f; J.oscale = 0.f; J.subg = nullptr; J.dry = dry;
    ATTN_CALL(64, 1, AM_PLAIN, false);
  }
}

DI void phase_mix_even(char* lds, const Params& p, int layer, int dry) {
  const int grp = __builtin_amdgcn_readfirstlane(ltid() >> 8);
  const int e = layer >> 1, wid = (ltid() >> 6) & 3, vb = blockIdx.x * 2 + grp, vg = gridDim.x * 2;
  for (int job = vb; job < 768 * 8; job += vg) {
    const int qb = job >> 3, hq = job & 7, kvh = hq >> 2, t0 = qb * 128;
    int S, seq0, pos, sq; tok_info(t0, S, seq0, pos, sq);
    AttnJob J;
    bf16_t* qo = p.u + (size_t)(t0 + 32 * wid) * UW + 1536 + hq * 64;
    J.q = qo; J.o = qo; J.z = p.u + (size_t)(t0 + 32 * wid) * UW + 2560 + 512 + hq * 64;
    J.k[0] = J.k[1] = p.u + (size_t)seq0 * UW + 2048 + kvh * 64; J.v = p.u + (size_t)seq0 * UW + 2176 + kvh * 64; J.ldk = J.ldv = UW;
    const int pt = pos >> 6;
    J.tile_lo = pt - 2 < 0 ? 0 : pt - 2; J.tile_hi = pt + 4 > (S >> 6) ? (S >> 6) : pt + 4;
    J.m_init = p.swa_sink[e * 8 + hq] * LOG2E; J.l_init = 1.f; J.qpos0 = pos + 32 * wid; J.lam = 0.f; J.oscale = 0.f; J.subg = nullptr; J.dry = dry;
    ATTN_CALL(64, 1, AM_SWA, false);
  }
  mem_jobs(lds, p, layer, dry);
  const float* cw = p.conv_w + e * 3 * 512;
  for (int idx = blockIdx.x * NTHREADS + ltid(); idx < NTOK * 64; idx += gridDim.x * NTHREADS) {
    const int t = idx >> 6, c0 = (idx & 63) * 8;
    int S, seq0, pos, sq; tok_info(t, S, seq0, pos, sq);
    bf16_t* ur = p.u + (size_t)t * UW;
    float ic[8], il[8], ir[8];
    { const u32x4 a = *(const u32x4*)(ur + 512 + c0), b = *(const u32x4*)(ur + 1024 + c0);
#pragma unroll
      for (int j = 0; j < 4; ++j) { ic[2 * j] = bflo(a[j]) * bflo(b[j]); ic[2 * j + 1] = bfhi(a[j]) * bfhi(b[j]); } }
    if (pos > 0) { const u32x4 a = *(const u32x4*)(ur - UW + 512 + c0), b = *(const u32x4*)(ur - UW + 1024 + c0);
#pragma unroll
      for (int j = 0; j < 4; ++j) { il[2 * j] = bflo(a[j]) * bflo(b[j]); il[2 * j + 1] = bfhi(a[j]) * bfhi(b[j]); } }
    else {
#pragma unroll
      for (int j = 0; j < 8; ++j) il[j] = 0.f; }
    if (pos < S - 1) { const u32x4 a = *(const u32x4*)(ur + UW + 512 + c0), b = *(const u32x4*)(ur + UW + 1024 + c0);
#pragma unroll
      for (int j = 0; j < 4; ++j) { ir[2 * j] = bflo(a[j]) * bflo(b[j]); ir[2 * j + 1] = bfhi(a[j]) * bfhi(b[j]); } }
    else {
#pragma unroll
      for (int j = 0; j < 8; ++j) ir[j] = 0.f; }
    const u32x4 gbw = *(const u32x4*)(ur + c0), zw = *(const u32x4*)(ur + 2560 + c0);
    float y[8];
#pragma unroll
    for (int j = 0; j < 8; ++j) {
      const float gb = (j & 1) ? bfhi(gbw[j >> 1]) : bflo(gbw[j >> 1]);
      const float z = (j & 1) ? bfhi(zw[j >> 1]) : bflo(zw[j >> 1]);
      const float cv = il[j] * cw[c0 + j] + ic[j] * cw[512 + c0 + j] + ir[j] * cw[1024 + c0 + j];
      y[j] = gb * cv * silu(z);
    }
    u32x4 w; w.x = cvtpk(y[0], y[1]); w.y = cvtpk(y[2], y[3]); w.z = cvtpk(y[4], y[5]); w.w = cvtpk(y[6], y[7]);
    if (!dry) *(u32x4*)(ur + c0) = w;
  }
}

DI void phase_mix_odd(char* lds, const Params& p, int layer, int dry) {
  const int grp = __builtin_amdgcn_readfirstlane(ltid() >> 8);
  const int o = layer >> 1, wid = (ltid() >> 6) & 3;
  const int nx = (gridDim.x & 7) == 0 ? 8 : 1, bx = blockIdx.x % nx, bi = (blockIdx.x / nx) * 2 + grp, nbx = (gridDim.x / nx) * 2;
  const float mb_dense = p.lam[8 + o * 2], mb_diff = p.lam[8 + o * 2 + 1];
  const bool fix_dense = mb_dense < 43.f, fix_diff = mb_diff < 43.f;
#pragma unroll 1
  for (int part = 0; part < 2; ++part) {
    const int gshift = part ? 7 : 8, nv = (16 / nx) << gshift;
#pragma unroll 1
    for (int v = bi; v < nv; v += nbx) {
      const int j = ((bx + nx * (v >> gshift)) << gshift) + (v & ((1 << gshift) - 1));
      int g, qb, kvh, seq0, S;
      if (!part) { g = j & 3; qb = (j >> 2) & 63; kvh = (j >> 8) & 1; seq0 = (j >> 9) * 8192; S = 8192; }
      else { g = j & 3; qb = (j >> 2) & 31; kvh = (j >> 7) & 1; seq0 = NTOKP + (j >> 8) * 4096; S = 4096; }
      const int hq = kvh * 4 + g, t0 = seq0 + qb * 128 + 32 * wid;
      AttnJob J;
      bf16_t* qo = p.u + (size_t)t0 * UW + hq * 64;
      J.q = qo; J.o = qo; J.z = p.u + (size_t)t0 * UW + 2560 + hq * 64;
      J.k[0] = J.k[1] = p.u + (size_t)seq0 * UW + 512 + kvh * 64; J.v = p.u + (size_t)seq0 * UW + 640 + kvh * 64; J.ldk = J.ldv = UW;
      J.tile_lo = 0; J.tile_hi = S >> 6; J.l_init = 0.f; J.qpos0 = 0; J.lam = 0.f; J.oscale = 0.f; J.subg = nullptr; J.dry = dry;
      if (fix_dense) { J.m_init = mb_dense; ATTN_CALL(64, 1, AM_PLAIN, true); }
      else { J.m_init = -1e30f; ATTN_CALL(64, 1, AM_PLAIN, false); }
    }
  }
  const float lam = p.lam[o * 2], osc = p.lam[o * 2 + 1];
#pragma unroll 1
  for (int part = 0; part < 2; ++part) {
    const int gshift = part ? 6 : 7, nv = (32 / nx) << gshift;
#pragma unroll 1
    for (int v = bi; v < nv; v += nbx) {
      const int j = ((bx + nx * (v >> gshift)) << gshift) + (v & ((1 << gshift) - 1));
      int qb, hh, seq0, S;
      if (!part) { qb = j & 127; hh = (j >> 7) & 3; seq0 = (j >> 9) * 8192; S = 8192; }
      else { qb = j & 63; hh = (j >> 6) & 3; seq0 = NTOKP + (j >> 8) * 4096; S = 4096; }
      const int mp = wid & 1, sub = wid >> 1, t0 = seq0 + qb * 64 + sub * 32;
      AttnJob J;
      J.q = p.u + (size_t)t0 * UW + 768 + (2 * hh + mp) * 64;
      J.o = p.u + (size_t)t0 * UW + 768 + hh * 128; J.z = p.u + (size_t)t0 * UW + 2560 + 512 + hh * 128;
      J.k[0] = p.u + (size_t)seq0 * UW + 1280 + (2 * hh) * 64; J.k[1] = J.k[0] + 64; J.v = p.u + (size_t)seq0 * UW + 1792 + hh * 128; J.ldk = J.ldv = UW;
      J.tile_lo = 0; J.tile_hi = S >> 6; J.l_init = 0.f; J.qpos0 = 0; J.lam = lam; J.oscale = osc; J.subg = p.diff_subln_g + o * 128; J.dry = dry;
      if (fix_diff) { J.m_init = mb_diff; ATTN_CALL(128, 2, AM_DIFF, true); }
      else { J.m_init = -1e30f; ATTN_CALL(128, 2, AM_DIFF, false); }
    }
  }
  mem_jobs(lds, p, layer, dry);
}

DI void phase_norm(const Params& p) {
  const int gw = blockIdx.x * 8 + (ltid() >> 6), nw = gridDim.x * 8;
  norm_rows(p.out, p.xb, p.rstd, 0, NTOK, gw, nw);
}

__global__ void __launch_bounds__(NTHREADS, 2) fwd_kernel(Params p) {
  __shared__ __attribute__((aligned(16))) char lds[LDS_BYTES];
  int ph = p.phase_lo;
  if (ph == 0) {
    phase_prep(lds, p);
    ph = 1;
#if !MULTI_LAUNCH
    if (ph < p.phase_hi) cg::this_grid().sync();
#endif
  }
  for (; ph < p.phase_hi; ++ph) {
    {
      const int l = (ph - 1) / 3, s = (ph - 1) - 3 * l;
      if (s == 0) {
        if (l == 0) { GemmDesc g{p.memb, p.wt_mem, DM, DM, 16, 8, 0, 0}; gemm_phase<EPI_MEM>(lds, p, g, 0); }
        GemmDesc g{p.xb, p.wt_in + (size_t)l * UW * DM, DM, DM, NTOK / 256, UW / 256, 0, 0};
        const int nrep = ((p.probe >> 2) & 1) + 1;
#pragma unroll 1
        for (int rep = 0; rep < nrep; ++rep) gemm_phase<EPI_IN>(lds, p, g, l);
      } else if (s == 1) {
        const int nrep = ((l & 1) ? (p.probe & 1) : ((p.probe >> 1) & 1)) + 1;
#pragma unroll 1
        for (int rep = 0; rep < nrep; ++rep) {
          const int dry = rep + 1 < nrep;
          if (rep == 0) {
            float* z = p.rstd + ((l + 1) & 1) * NTOK;
            for (int i = blockIdx.x * NTHREADS + ltid(); i < NTOK; i += gridDim.x * NTHREADS) z[i] = 0.f;
          }
          if (ltid() >> 8) __builtin_amdgcn_s_setprio(1);
          if (l & 1) phase_mix_odd(lds, p, l, dry); else phase_mix_even(lds, p, l, dry);
          __builtin_amdgcn_s_setprio(0);
        }
      } else if (s == 2) {
        GemmDesc g{p.u, p.wt_out + (size_t)l * DM * MIXW, UW, MIXW, NTOK / 256, DM / 256, 1, (l & 1) ? 768 : 1536};
        gemm_phase<EPI_OUT>(lds, p, g, l);
      }
    }
#if !MULTI_LAUNCH
    if (ph + 1 < p.phase_hi) cg::this_grid().sync();
#endif
  }
}

extern "C" void kernel_launch(void* const* d_in, const int* in_sizes, int n_in, void* d_out, int out_size, void* d_ws, size_t ws_size,
                              hipStream_t stream) {
  static int grid_blocks = 0;
  if (!grid_blocks) {
    int dev = 0, cus = 0, per_cu = 0;
    hipGetDevice(&dev);
    hipDeviceGetAttribute(&cus, hipDeviceAttributeMultiprocessorCount, dev);
    hipOccupancyMaxActiveBlocksPerMultiprocessor(&per_cu, fwd_kernel, NTHREADS, 0);
    if (per_cu > 1) per_cu = 1;
    if (per_cu < 1) per_cu = 1;
    int cap = cus * per_cu; if (cap > 256) cap = 256;
    grid_blocks = 8; while (grid_blocks * 2 <= cap) grid_blocks *= 2;
  }
  Params p{};
  p.xp = (const float*)d_in[0]; p.xs = (const float*)d_in[1]; p.memp = (const float*)d_in[2]; p.mems = (const float*)d_in[3];
  p.norm_g = (const float*)d_in[4]; p.w_in = (const float*)d_in[5]; p.w_out = (const float*)d_in[6]; p.mem_norm_g = (const float*)d_in[7];
  p.w_mem_kv = (const float*)d_in[8]; p.mem_qk_g = (const float*)d_in[9]; p.conv_w = (const float*)d_in[10]; p.swa_qk_g = (const float*)d_in[11];
  p.swa_sink = (const float*)d_in[12]; p.ax_qk_g = (const float*)d_in[13]; p.diff_qk_g = (const float*)d_in[14]; p.diff_lambda = (const float*)d_in[15];
  p.diff_subln_g = (const float*)d_in[16];
  p.out = (float*)d_out;
  char* w = (char*)d_ws; size_t off = 0;
  auto take = [&](size_t bytes) { char* r = w + off; off += (bytes + 255) & ~(size_t)255; return r; };
  p.u = (bf16_t*)take((size_t)NTOK * UW * 2);
  p.xb = (bf16_t*)take((size_t)NTOK * DM * 2);
  p.wt_in = (bf16_t*)take((size_t)4 * UW * DM * 2);
  p.wt_out = (bf16_t*)take((size_t)4 * DM * MIXW * 2);
  p.wt_mem = (bf16_t*)take((size_t)2048 * DM * 2);
  p.memb = (bf16_t*)take((size_t)4096 * DM * 2);
  p.memkv = (bf16_t*)take((size_t)4096 * 2048 * 2);
  p.rstd = (float*)take((size_t)NTOK * 4 * 2);
  p.rstd_mem = (float*)take(4096 * 4);
  p.tab1c = (float*)take(8192 * 32 * 4); p.tab1s = (float*)take(8192 * 32 * 4);
  p.tabac = (float*)take(128 * 16 * 4); p.tabas = (float*)take(128 * 16 * 4);
  p.lam = (float*)take(256);
  if (off > ws_size) { fprintf(stderr, "workspace too small: need %zu have %zu\n", off, ws_size); return; }
#if MULTI_LAUNCH
  for (int ph = 0; ph < NPHASE; ++ph) {
    p.phase_lo = ph; p.phase_hi = ph + 1;
    hipLaunchKernelGGL(fwd_kernel, dim3(grid_blocks), dim3(NTHREADS), 0, stream, p);
  }
#else
  p.phase_lo = 0; p.phase_hi = NPHASE; p.probe = PROBE_ODD | (PROBE_EVEN << 1) | (PROBE_GIN << 2);
  void* args[] = {&p};
  hipError_t e = hipLaunchCooperativeKernel((void*)fwd_kernel, dim3(grid_blocks), dim3(NTHREADS), args, 0, stream);
  if (e != hipSuccess) fprintf(stderr, "cooperative launch failed: %s (grid %d)\n", hipGetErrorString(e), grid_blocks);
#endif
}
```

```cpp
#include <hip/hip_runtime.h>
#include <hip/hip_cooperative_groups.h>
#include <cstdint>
#include <cstdio>
namespace cg = cooperative_groups;

#ifndef MULTI_LAUNCH
#define MULTI_LAUNCH 0
#endif

#ifndef PROBE_ODD
#define PROBE_ODD 0
#endif
#ifndef PROBE_EVEN
#define PROBE_EVEN 0
#endif
#ifndef PROBE_GIN
#define PROBE_GIN 0
#endif
#define DI __device__ __forceinline__
#define LAS __attribute__((address_space(3)))
typedef unsigned short bf16_t;
typedef short bf16x8 __attribute__((ext_vector_type(8)));
typedef short s16x4 __attribute__((ext_vector_type(4)));
typedef float f32x16 __attribute__((ext_vector_type(16)));
typedef float f32x4 __attribute__((ext_vector_type(4)));
typedef unsigned u32x4 __attribute__((ext_vector_type(4)));
typedef unsigned u32x2 __attribute__((ext_vector_type(2)));

constexpr int NTOK = 98304, NTOKP = 65536, UW = 3840, DM = 1024, MIXW = 1280;
constexpr int NTHREADS = 512;
constexpr int AT = 256;
constexpr int LDS_BYTES = 131072 + 32768;
constexpr float EPSF = 1e-6f;
constexpr float LOG2E = 1.4426950408889634f;
constexpr int NPHASE = 13;

struct Params {
  const float *xp, *xs, *memp, *mems, *norm_g, *w_in, *w_out, *mem_norm_g, *w_mem_kv, *mem_qk_g, *conv_w, *swa_qk_g,
      *swa_sink, *ax_qk_g, *diff_qk_g, *diff_lambda, *diff_subln_g;
  float* out;
  bf16_t *u, *xb, *wt_in, *wt_out, *wt_mem, *memb, *memkv;
  float *rstd, *rstd_mem, *tab1c, *tab1s, *tabac, *tabas, *lam;
  int phase_lo, phase_hi, probe, pad_;
};

typedef __bf16 bf16x2_t __attribute__((ext_vector_type(2)));
typedef float f32x2 __attribute__((ext_vector_type(2)));
DI unsigned cvtpk(float lo, float hi) { f32x2 v = {lo, hi}; bf16x2_t b = __builtin_convertvector(v, bf16x2_t); return __builtin_bit_cast(unsigned, b); }
DI float bf2f(unsigned short b) { return __uint_as_float(((unsigned)b) << 16); }
DI float bflo(unsigned w) { return __uint_as_float(w << 16); }
DI float bfhi(unsigned w) { return __uint_as_float(w & 0xffff0000u); }
DI int ltid() { int t; asm volatile("v_mov_b32 %0, %1" : "=v"(t) : "v"(threadIdx.x)); return t; }
DI int crow(int i, int h) { return (i & 3) + 8 * (i >> 2) + 4 * h; }
DI float swapmax(float v) { auto rr = __builtin_amdgcn_permlane32_swap(__float_as_uint(v), __float_as_uint(v), false, false); return fmaxf(__uint_as_float(rr[0]), __uint_as_float(rr[1])); }
DI float swapsum(float v) { auto rr = __builtin_amdgcn_permlane32_swap(__float_as_uint(v), __float_as_uint(v), false, false); return __uint_as_float(rr[0]) + __uint_as_float(rr[1]); }
DI float shx(float v, int lane, int o) { return __int_as_float(__builtin_amdgcn_ds_bpermute(((lane ^ o) & 63) << 2, __float_as_int(v))); }
DI float silu(float z) { return z / (1.f + __expf(-z)); }
#define MFMA32(a, b, c) __builtin_amdgcn_mfma_f32_32x32x16_bf16((a), (b), (c), 0, 0, 0)

DI void tok_info(int t, int& S, int& seq0, int& pos, int& sq) {
  if (t < NTOKP) { S = 8192; seq0 = t & ~8191; pos = t & 8191; sq = t >> 13; }
  else { int tt = t - NTOKP; S = 4096; seq0 = NTOKP + (tt & ~4095); pos = tt & 4095; sq = 8 + (tt >> 12); }
}

DI void transpose_tile(char* lds, const float* src, const float* g, bf16_t* dst, int K, int N, int k0, int n0) {
  float* tile = (float*)lds;
  const int tid = ltid(), a = tid >> 6, b = tid & 63;
#pragma unroll 4
  for (int i = 0; i < 8; ++i) { int kk = i * 8 + a; float v = src[(size_t)(k0 + kk) * N + n0 + b]; if (g) v *= g[k0 + kk]; tile[kk * 65 + b] = v; }
  __syncthreads();
#pragma unroll 4
  for (int i = 0; i < 8; ++i) { int nn = i * 8 + a; float v = tile[b * 65 + nn]; dst[(size_t)(n0 + nn) * K + k0 + b] = (bf16_t)(cvtpk(v, v) & 0xffffu); }
  __syncthreads();
}

DI void norm_rows(const float* src, bf16_t* dst, float* ssq, int row_begin, int row_end, int gw, int nw) {
  const int lane = ltid() & 63;
  for (int row = row_begin + gw; row < row_end; row += nw) {
    const float* s = src + (size_t)(row - row_begin) * DM; bf16_t* d = dst + (size_t)row * DM;
    f32x4 v[4]; float ss = 0.f;
#pragma unroll
    for (int j = 0; j < 4; ++j) { v[j] = *(const f32x4*)(s + (lane + 64 * j) * 4); ss += v[j][0] * v[j][0] + v[j][1] * v[j][1] + v[j][2] * v[j][2] + v[j][3] * v[j][3]; }
#pragma unroll
    for (int o = 32; o > 0; o >>= 1) ss += shx(ss, lane, o);
    const float rs = ssq ? 1.f : rsqrtf(ss * (1.f / DM) + EPSF);
#pragma unroll
    for (int j = 0; j < 4; ++j) { u32x2 w; w.x = cvtpk(v[j][0] * rs, v[j][1] * rs); w.y = cvtpk(v[j][2] * rs, v[j][3] * rs); *(u32x2*)(d + (lane + 64 * j) * 4) = w; }
    if (ssq && lane == 0) ssq[row] = ss;
  }
}

DI void phase_prep(char* lds, const Params& p) {
  const int T_IN = 4 * 16 * 60, T_OUT = 4 * 20 * 16, T_MEM = 4 * 16 * 8;
  for (int t = blockIdx.x; t < T_IN + T_OUT + T_MEM; t += gridDim.x) {
    if (t < T_IN) { int l = t / 960, r = t % 960, kt = r / 60, nt = r % 60;
      transpose_tile(lds, p.w_in + (size_t)l * DM * UW, p.norm_g + l * DM, p.wt_in + (size_t)l * UW * DM, DM, UW, kt * 64, nt * 64); }
    else if (t < T_IN + T_OUT) { int tt = t - T_IN; int l = tt / 320, r = tt % 320, kt = r / 16, nt = r % 16;
      transpose_tile(lds, p.w_out + (size_t)l * MIXW * DM, nullptr, p.wt_out + (size_t)l * DM * MIXW, MIXW, DM, kt * 64, nt * 64); }
    else { int tt = t - T_IN - T_OUT; int l = tt / 128, r = tt % 128, kt = r / 8, nt = r % 8;
      transpose_tile(lds, p.w_mem_kv + (size_t)l * DM * 512, p.mem_norm_g + l * DM, p.wt_mem + (size_t)l * 512 * DM, DM, 512, kt * 64, nt * 64); }
  }
  const int gw = blockIdx.x * 8 + (ltid() >> 6), nw = gridDim.x * 8;
  norm_rows(p.memp, p.memb, nullptr, 0, 2048, gw, nw);
  norm_rows(p.mems, p.memb, nullptr, 2048, 4096, gw, nw);
  norm_rows(p.xp, p.xb, p.rstd, 0, NTOKP, gw, nw);
  norm_rows(p.xs, p.xb, p.rstd, NTOKP, NTOK, gw, nw);
  const int gt = blockIdx.x * NTHREADS + ltid(), nt_ = gridDim.x * NTHREADS;
  for (int i = gt; i < 8192 * 32; i += nt_) { int pos = i >> 5, f = i & 31; float inv = powf(10000.f, -(float)(2 * f) / 64.f); float ang = (float)pos * inv; p.tab1c[i] = cosf(ang); p.tab1s[i] = sinf(ang); }
  for (int i = gt; i < 128 * 16; i += nt_) { int pos = i >> 4, f = i & 15; float inv = powf(10000.f, -(float)(2 * f) / 32.f); float ang = (float)pos * inv; p.tabac[i] = cosf(ang); p.tabas[i] = sinf(ang); }
  if (blockIdx.x == 0 && ltid() < 64) {
    const int lane = ltid();
    for (int o = 0; o < 2; ++o) {
      const float* lv = p.diff_lambda + o * 256;
      float a = lv[lane] * lv[64 + lane], b = lv[128 + lane] * lv[192 + lane];
#pragma unroll
      for (int s = 32; s > 0; s >>= 1) { a += shx(a, lane, s); b += shx(b, lane, s); }
      float li = 0.8f - 0.6f * expf(-0.3f * (float)(2 * o + 1));
      if (lane == 0) { p.lam[o * 2] = expf(a) - expf(b) + li; p.lam[o * 2 + 1] = 1.f - li; }
      float g0 = fabsf(p.ax_qk_g[o * 128 + lane]), g1 = fabsf(p.ax_qk_g[o * 128 + 64 + lane]);
      float g2 = fabsf(p.diff_qk_g[o * 128 + lane]), g3 = fabsf(p.diff_qk_g[o * 128 + 64 + lane]);
#pragma unroll
      for (int s = 32; s > 0; s >>= 1) { g0 = fmaxf(g0, shx(g0, lane, s)); g1 = fmaxf(g1, shx(g1, lane, s)); g2 = fmaxf(g2, shx(g2, lane, s)); g3 = fmaxf(g3, shx(g3, lane, s)); }
      if (lane == 0) { p.lam[8 + o * 2] = 8.f * g0 * g1 * 1.02f * LOG2E; p.lam[8 + o * 2 + 1] = 8.f * g2 * g3 * 1.02f * LOG2E; }
    }
  }
}

struct GemmDesc { const bf16_t* A; const bf16_t* Bt; int lda, K, mtiles, ntiles, remap, seg2; };
enum { EPI_IN = 0, EPI_MEM = 1, EPI_OUT = 2 };

DI void head_store(f32x16 v0, f32x16 v1, float rs, int mode, const float* gain, const Params& p, int pos, bf16_t* obase, int ldo, char* stg_wg) {
  const int tid_ = ltid(), lane = tid_ & 63, r = lane & 31, h = lane >> 5;
  char* stg = stg_wg + (tid_ >> 6) * 4096;
  v0 *= rs; v1 *= rs;
  if (mode) {
    float ss = 0.f;
#pragma unroll
    for (int i = 0; i < 16; ++i) ss += v0[i] * v0[i] + v1[i] * v1[i];
    ss = swapsum(ss);
    const float inv = rsqrtf(ss * (1.f / 64.f) + EPSF);
#pragma unroll
    for (int g4 = 0; g4 < 4; ++g4) {
      const f32x4 ga = *(const f32x4*)(gain + 8 * g4 + 4 * h), gb = *(const f32x4*)(gain + 32 + 8 * g4 + 4 * h);
#pragma unroll
      for (int j = 0; j < 4; ++j) { v0[4 * g4 + j] *= inv * ga[j]; v1[4 * g4 + j] *= inv * gb[j]; }
    }
    if (mode == 2) {
#pragma unroll
      for (int g4 = 0; g4 < 4; ++g4) {
        const f32x4 c = *(const f32x4*)(p.tab1c + pos * 32 + 8 * g4 + 4 * h), s = *(const f32x4*)(p.tab1s + pos * 32 + 8 * g4 + 4 * h);
#pragma unroll
        for (int j = 0; j < 4; ++j) { const int i = 4 * g4 + j; const float x1 = v0[i], x2 = v1[i]; v0[i] = x1 * c[j] - x2 * s[j]; v1[i] = x2 * c[j] + x1 * s[j]; }
      }
    } else if (mode == 3) {
      const int row = pos >> 6, col = pos & 63;
#pragma unroll
      for (int g4 = 0; g4 < 2; ++g4) {
        const f32x4 c0 = *(const f32x4*)(p.tabac + row * 16 + 8 * g4 + 4 * h), s0 = *(const f32x4*)(p.tabas + row * 16 + 8 * g4 + 4 * h);
        const f32x4 c1 = *(const f32x4*)(p.tabac + col * 16 + 8 * g4 + 4 * h), s1 = *(const f32x4*)(p.tabas + col * 16 + 8 * g4 + 4 * h);
#pragma unroll
        for (int j = 0; j < 4; ++j) { const int i = 4 * g4 + j;
          float x1 = v0[i], x2 = v0[i + 8]; v0[i] = x1 * c0[j] - x2 * s0[j]; v0[i + 8] = x2 * c0[j] + x1 * s0[j];
          x1 = v1[i]; x2 = v1[i + 8]; v1[i] = x1 * c1[j] - x2 * s1[j]; v1[i + 8] = x2 * c1[j] + x1 * s1[j]; }
      }
    }
  }
#pragma unroll
  for (int g4 = 0; g4 < 4; ++g4) {
    u32x2 w0, w1; w0.x = cvtpk(v0[4 * g4], v0[4 * g4 + 1]); w0.y = cvtpk(v0[4 * g4 + 2], v0[4 * g4 + 3]);
    w1.x = cvtpk(v1[4 * g4], v1[4 * g4 + 1]); w1.y = cvtpk(v1[4 * g4 + 2], v1[4 * g4 + 3]);
    *(u32x2*)(stg + r * 128 + ((g4 ^ (r & 7)) << 4) + h * 8) = w0;
    *(u32x2*)(stg + r * 128 + (((4 + g4) ^ (r & 7)) << 4) + h * 8) = w1;
  }
#pragma unroll
  for (int j = 0; j < 4; ++j) {
    const int row = (lane >> 3) + 8 * j, ch = lane & 7;
    const u32x4 w = *(const u32x4*)(stg + row * 128 + ((ch ^ (row & 7)) << 4));
    *(u32x4*)(obase + (size_t)row * ldo + ch * 8) = w;
  }
}

DI int in_mode(const Params& p, int layer, int n_h, const float*& gain) {
  int mode = 0; gain = p.mem_qk_g;
  if ((layer & 1) == 0) { const int e = layer >> 1;
    if (n_h >= 1536 && n_h < 2048) { mode = 2; gain = p.swa_qk_g + (e * 2) * 64; }
    else if (n_h >= 2048 && n_h < 2176) { mode = 2; gain = p.swa_qk_g + (e * 2 + 1) * 64; }
    else if (n_h >= 2304 && n_h < 2560) { mode = 1; gain = p.mem_qk_g + (layer * 2) * 64; }
  } else { const int o = layer >> 1;
    if (n_h < 512) { mode = 3; gain = p.ax_qk_g + (o * 2) * 64; }
    else if (n_h < 640) { mode = 3; gain = p.ax_qk_g + (o * 2 + 1) * 64; }
    else if (n_h >= 768 && n_h < 1280) { mode = 2; gain = p.diff_qk_g + (o * 2) * 64; }
    else if (n_h >= 1280 && n_h < 1792) { mode = 2; gain = p.diff_qk_g + (o * 2 + 1) * 64; }
    else if (n_h >= 2304 && n_h < 2560) { mode = 1; gain = p.mem_qk_g + (layer * 2) * 64; }
  }
  return mode;
}

template <int EPI>
DI void gemm_phase(char* lds, const Params& p, const GemmDesc g, int layer) {
  const int tid = ltid(), lane = tid & 63, wid = tid >> 6, wm = wid >> 1, wn = wid & 1, r = lane & 31, h = lane >> 5;
  const int srow = tid >> 3, sch = tid & 7;
  const int soff = srow * 128 + ((sch ^ ((srow >> 1) & 7)) << 4);
  const int nk = g.K >> 6;
  const int ntile = g.mtiles * g.ntiles;
  const bool banded = ((gridDim.x & 7) == 0) && ((g.mtiles & 63) == 0);
  const int nx = banded ? 8 : 1, bx = blockIdx.x % nx, bi = blockIdx.x / nx, nbx = gridDim.x / nx;
  const int per_band = 8 * g.ntiles;
  const int qtot = ntile / nx;
  int q = bi;
  if (q >= qtot) return;
  int mt, nt;
#define G_TILE(qq, MT, NT) do { if (banded) { const int bl_ = (qq) / per_band, rem_ = (qq) - bl_ * per_band; NT = rem_ >> 3; MT = (bl_ * 8 + bx) * 8 + (rem_ & 7); } \
    else { MT = (qq) / g.ntiles; NT = (qq) - MT * g.ntiles; } } while (0)
#define G_LOAD(AG, BG, kt, RA, RB) do { const int k0_ = (kt) * 64; int ac_ = k0_; if (g.remap) ac_ = k0_ < 512 ? k0_ : (k0_ < 1024 ? g.seg2 + k0_ - 512 : 2304 + k0_ - 1024); \
    _Pragma("unroll") for (int i = 0; i < 4; ++i) { RA[i] = *(const u32x4*)(AG + (size_t)(64 * i) * g.lda + ac_); RB[i] = *(const u32x4*)(BG + (size_t)(64 * i) * g.K + k0_); } } while (0)
#define G_WRITE(buf, RA, RB) do { _Pragma("unroll") for (int i = 0; i < 4; ++i) { *(u32x4*)(lds + (buf) * 65536 + i * 8192 + soff) = RA[i]; *(u32x4*)(lds + (buf) * 65536 + 32768 + i * 8192 + soff) = RB[i]; } } while (0)
#define G_COMPUTE(buf) do { _Pragma("unroll") for (int ks = 0; ks < 4; ++ks) { const int co_ = ((2 * ks + h) ^ ((r >> 1) & 7)) << 4; \
      const char* la_ = lds + (buf) * 65536 + (wm * 64 + r) * 128 + co_; const char* lb_ = lds + (buf) * 65536 + 32768 + (wn * 128 + r) * 128 + co_; \
      bf16x8 fa_[2], fb_[4]; fa_[0] = *(const bf16x8*)(la_); fa_[1] = *(const bf16x8*)(la_ + 4096); \
      _Pragma("unroll") for (int ni = 0; ni < 4; ++ni) fb_[ni] = *(const bf16x8*)(lb_ + ni * 4096); \
      _Pragma("unroll") for (int ni = 0; ni < 4; ++ni) { acc[0][ni] = MFMA32(fb_[ni], fa_[0], acc[0][ni]); acc[1][ni] = MFMA32(fb_[ni], fa_[1], acc[1][ni]); } } } while (0)
  G_TILE(q, mt, nt);
  const bf16_t* Ag = g.A + (size_t)(mt * 256 + srow) * g.lda + sch * 8;
  const bf16_t* Bg = g.Bt + (size_t)(nt * 256 + srow) * g.K + sch * 8;
  u32x4 ra0[4], rb0[4];
  G_LOAD(Ag, Bg, 0, ra0, rb0); G_WRITE(0, ra0, rb0); G_LOAD(Ag, Bg, 1, ra0, rb0); __syncthreads();
  for (;;) {
    const int qn = q + nbx; const bool has_next = qn < qtot;
    int mtn = mt, ntn = nt; if (has_next) G_TILE(qn, mtn, ntn);
    const bf16_t* Agn = g.A + (size_t)(mtn * 256 + srow) * g.lda + sch * 8;
    const bf16_t* Bgn = g.Bt + (size_t)(ntn * 256 + srow) * g.K + sch * 8;
    f32x16 acc[2][4];
#pragma unroll
    for (int a = 0; a < 2; ++a)
#pragma unroll
      for (int b = 0; b < 4; ++b)
#pragma unroll
        for (int i = 0; i < 16; ++i) acc[a][b][i] = 0.f;
    for (int kt = 0; kt < nk; kt += 2) {
      const bool last = kt + 2 >= nk;
      G_WRITE(1, ra0, rb0);
      if (!last) G_LOAD(Ag, Bg, kt + 2, ra0, rb0); else if (has_next) G_LOAD(Agn, Bgn, 0, ra0, rb0);
      G_COMPUTE(0);
      __syncthreads();
      if (!last || has_next) G_WRITE(0, ra0, rb0);
      if (!last) G_LOAD(Ag, Bg, kt + 3, ra0, rb0); else if (has_next) G_LOAD(Agn, Bgn, 1, ra0, rb0);
      G_COMPUTE(1);
      __syncthreads();
    }
    const int n_w = nt * 256 + wn * 128;
    if (EPI == EPI_IN) {
#pragma unroll
      for (int hu = 0; hu < 2; ++hu) {
        const int n_h = n_w + 64 * hu; const float* gain; const int mode = in_mode(p, layer, n_h, gain);
#pragma unroll
        for (int mi = 0; mi < 2; ++mi) {
          const int t = mt * 256 + wm * 64 + mi * 32 + r;
          int S, seq0, pos, sq; tok_info(t, S, seq0, pos, sq);
          const float rs = rsqrtf(p.rstd[(layer & 1) * NTOK + t] * (1.f / DM) + EPSF);
          head_store(acc[mi][2 * hu], acc[mi][2 * hu + 1], rs, mode, gain, p, pos, p.u + (size_t)(t - r) * UW + n_h, UW, lds + 131072);
        }
      }
    } else if (EPI == EPI_MEM) {
#pragma unroll
      for (int hu = 0; hu < 2; ++hu) {
        const int n_h = n_w + 64 * hu, l = n_h >> 9, c = n_h & 511;
        const int mode = c < 256 ? 1 : 0; const float* gain = p.mem_qk_g + (l * 2 + 1) * 64;
#pragma unroll
        for (int mi = 0; mi < 2; ++mi) {
          const int row = mt * 256 + wm * 64 + mi * 32 + r;
          head_store(acc[mi][2 * hu], acc[mi][2 * hu + 1], 1.f, mode, gain, p, 0, p.memkv + (size_t)(row - r) * 2048 + n_h, 2048, lds + 131072);
        }
      }
    } else {
      const int tid_ = ltid(), lane = tid_ & 63, r = lane & 31, h = lane >> 5;
      char* stg = lds + 131072 + (tid_ >> 6) * 4096;
#pragma unroll
      for (int mi = 0; mi < 2; ++mi) {
        const int t0 = mt * 256 + wm * 64 + mi * 32;
        const float* xin0 = layer == 0 ? (t0 < NTOKP ? p.xp + (size_t)t0 * DM : p.xs + (size_t)(t0 - NTOKP) * DM) : p.out + (size_t)t0 * DM;
        float* xo0 = p.out + (size_t)t0 * DM;
        bf16_t* xb0 = p.xb + (size_t)t0 * DM;
        float ssj[4] = {0.f, 0.f, 0.f, 0.f};
#pragma unroll
        for (int ni = 0; ni < 4; ++ni) {
#pragma unroll
          for (int g4 = 0; g4 < 4; ++g4) {
            f32x4 v; v[0] = acc[mi][ni][4 * g4]; v[1] = acc[mi][ni][4 * g4 + 1]; v[2] = acc[mi][ni][4 * g4 + 2]; v[3] = acc[mi][ni][4 * g4 + 3];
            *(f32x4*)(stg + r * 128 + (((2 * g4 + h) ^ (r & 7)) << 4)) = v;
          }
#pragma unroll
          for (int j = 0; j < 4; ++j) {
            const int row = (lane >> 3) + 8 * j, ch = lane & 7;
            const f32x4 a = *(const f32x4*)(stg + row * 128 + ((ch ^ (row & 7)) << 4));
            const size_t off = (size_t)row * DM + n_w + ni * 32 + ch * 4;
            f32x4 xv = *(const f32x4*)(xin0 + off);
            xv += a;
            *(f32x4*)(xo0 + off) = xv;
            if (layer < 3) {
              u32x2 w; w.x = cvtpk(xv[0], xv[1]); w.y = cvtpk(xv[2], xv[3]);
              *(u32x2*)(xb0 + off) = w;
              ssj[j] += xv[0] * xv[0] + xv[1] * xv[1] + xv[2] * xv[2] + xv[3] * xv[3];
            }
          }
        }
        if (layer < 3) {
#pragma unroll
          for (int j = 0; j < 4; ++j) {
            float v = ssj[j];
            v += shx(v, lane, 1); v += shx(v, lane, 2); v += shx(v, lane, 4);
            if ((lane & 7) == 0) atomicAdd(p.rstd + ((layer + 1) & 1) * NTOK + t0 + (lane >> 3) + 8 * j, v);
          }
        }
      }
    }
    if (!has_next) break;
    q = qn; mt = mtn; nt = ntn; Ag = Agn; Bg = Bgn;
  }
#undef G_TILE
#undef G_LOAD
#undef G_WRITE
#undef G_COMPUTE
}

enum { AM_PLAIN = 0, AM_SWA = 1, AM_DIFF = 2 };
struct AttnJob {
  const bf16_t* q;
  const bf16_t* k[2];
  const bf16_t* v;
  int ldk, ldv;
  int tile_lo, tile_hi;
  float m_init, l_init;
  int qpos0;
  bf16_t* o;
  const bf16_t* z;
  float lam, oscale;
  const float* subg;
  int dry;
};

template <int DV, int MODE>
DI void attn_finalize(char* lds, const AttnJob& J, f32x16 (&O)[DV / 32], const float lt, const int wid, const int r, const int h) {
  constexpr int NDV = DV / 32;
  const float inv = 1.f / lt;
  if (MODE != AM_DIFF) {
    bf16_t* orow = J.o + (size_t)r * UW; const bf16_t* zrow = J.z + (size_t)r * UW;
#pragma unroll
    for (int d = 0; d < NDV; ++d)
#pragma unroll
      for (int g4 = 0; g4 < 4; ++g4) {
        const int dv = 32 * d + 8 * g4 + 4 * h;
        const u32x2 zw = *(const u32x2*)(zrow + dv);
        const float y0 = O[d][4 * g4] * inv * silu(bflo(zw.x)), y1 = O[d][4 * g4 + 1] * inv * silu(bfhi(zw.x));
        const float y2 = O[d][4 * g4 + 2] * inv * silu(bflo(zw.y)), y3 = O[d][4 * g4 + 3] * inv * silu(bfhi(zw.y));
        u32x2 w; w.x = cvtpk(y0, y1); w.y = cvtpk(y2, y3);
        *(u32x2*)(orow + dv) = w;
      }
  } else {
    float* sc = (float*)(lds + 32768) + (wid >> 1) * (DV * 32);
    if (wid & 1) {
      const float f = inv * J.lam;
#pragma unroll
      for (int d = 0; d < NDV; ++d)
#pragma unroll
        for (int i = 0; i < 16; ++i) sc[(32 * d + crow(i, h)) * 32 + r] = O[d][i] * f;
    }
    __syncthreads();
    if (!(wid & 1)) {
      float ss = 0.f;
#pragma unroll
      for (int d = 0; d < NDV; ++d)
#pragma unroll
        for (int i = 0; i < 16; ++i) { const float a = O[d][i] * inv - sc[(32 * d + crow(i, h)) * 32 + r]; O[d][i] = a; ss += a * a; }
      ss = swapsum(ss);
      const float rn = rsqrtf(ss * (1.f / DV) + EPSF) * J.oscale;
      bf16_t* orow = J.o + (size_t)r * UW; const bf16_t* zrow = J.z + (size_t)r * UW;
#pragma unroll
      for (int d = 0; d < NDV; ++d)
#pragma unroll
        for (int g4 = 0; g4 < 4; ++g4) {
          const int dv = 32 * d + 8 * g4 + 4 * h;
          const u32x2 zw = *(const u32x2*)(zrow + dv);
          const f32x4 sg = *(const f32x4*)(J.subg + dv);
          const float y0 = O[d][4 * g4] * rn * sg[0] * silu(bflo(zw.x)), y1 = O[d][4 * g4 + 1] * rn * sg[1] * silu(bfhi(zw.x));
          const float y2 = O[d][4 * g4 + 2] * rn * sg[2] * silu(bflo(zw.y)), y3 = O[d][4 * g4 + 3] * rn * sg[3] * silu(bfhi(zw.y));
          u32x2 w; w.x = cvtpk(y0, y1); w.y = cvtpk(y2, y3);
          *(u32x2*)(orow + dv) = w;
        }
    }
  }
}

template <int DV, int NK, int MODE, bool FIXM, int GRP>
DI void attn_job(char* lds_wg, const AttnJob& J) {
  constexpr int NDV = DV / 32;
  constexpr float C = 0.125f * LOG2E;
  const int tid_wg = ltid(), tid = tid_wg & (AT - 1), lane = tid & 63, wid = tid >> 6, r = lane & 31, h = lane >> 5;
  char* lds = lds_wg + GRP * 65536;
  const int kstream = (NK == 2) ? (wid & 1) : 0;
  bf16x8 qf[4];
  const bf16_t* qrow = J.q + (size_t)r * UW + 8 * h;
#pragma unroll
  for (int ds = 0; ds < 4; ++ds) qf[ds] = *(const bf16x8*)(qrow + 16 * ds);
  f32x16 O[NDV];
#pragma unroll
  for (int d = 0; d < NDV; ++d)
#pragma unroll
    for (int i = 0; i < 16; ++i) O[d][i] = 0.f;
  float m = J.m_init, l = (h == 0) ? J.l_init : 0.f;
  f32x16 Osum;
#pragma unroll
  for (int i = 0; i < 16; ++i) Osum[i] = 0.f;
  const bf16x8 ones = {0x3F80, 0x3F80, 0x3F80, 0x3F80, 0x3F80, 0x3F80, 0x3F80, 0x3F80};
  const int ksrow = tid >> 3, ksch = tid & 7;
  const int kpi = (ksrow & ~12) | ((ksrow & 4) << 1) | ((ksrow & 8) >> 1);
  const int ksoff = kpi * 128 + ((ksch ^ ((kpi >> 1) & 7)) << 4);
  constexpr int VCH = DV / 8;
  constexpr int VI = (64 * VCH) / AT;
  const int vkey0 = tid / VCH, vc8 = (tid % VCH) * 8;
  u32x4 rk0[NK][2], rv0[VI], rk1[NK][2], rv1[VI];
#define A_LOAD(t, rk, rv) do { const size_t kb_ = (size_t)(t) * 64; \
    _Pragma("unroll") for (int s = 0; s < NK; ++s) _Pragma("unroll") for (int i = 0; i < 2; ++i) rk[s][i] = *(const u32x4*)(J.k[s] + (kb_ + ksrow + 32 * i) * J.ldk + ksch * 8); \
    _Pragma("unroll") for (int i = 0; i < VI; ++i) rv[i] = *(const u32x4*)(J.v + (kb_ + vkey0 + (AT / VCH) * i) * J.ldv + vc8); } while (0)
#define A_WRITE(st, rk, rv) do { char* b_ = lds + (st) * 32768; \
    _Pragma("unroll") for (int s = 0; s < NK; ++s) _Pragma("unroll") for (int i = 0; i < 2; ++i) *(u32x4*)(b_ + s * 8192 + i * 4096 + ksoff) = rk[s][i]; \
    _Pragma("unroll") for (int i = 0; i < VI; ++i) { const int key_ = vkey0 + (AT / VCH) * i; \
      *(u32x4*)(b_ + NK * 8192 + ((key_ >> 3) * NDV + (vc8 >> 5)) * 512 + (key_ & 7) * 64 + (vc8 & 31) * 2) = rv[i]; } } while (0)
  const int nt = J.tile_hi - J.tile_lo;
  constexpr bool DEEP2 = FIXM || MODE != AM_DIFF;
  constexpr bool ONESET = FIXM;
  A_LOAD(J.tile_lo, rk0, rv0); A_WRITE(0, rk0, rv0); if (ONESET) A_LOAD(J.tile_lo + 1, rk0, rv0); else if (DEEP2) A_LOAD(J.tile_lo + 1, rk1, rv1); __syncthreads();
  const int i16 = lane & 15;
  const int vrd = h * NDV * 512 + (i16 >> 2) * 64 + (((lane >> 4) & 1) * 16 + (i16 & 3) * 4) * 2;
  auto compute = [&](const int stage, const int tile) __attribute__((always_inline)) {
    bool active = true;
    if (MODE == AM_SWA) { const int k0 = tile * 64; active = !(k0 > J.qpos0 + 31 + 128 || k0 + 63 < J.qpos0 - 128); }
    if (active) {
      const char* Kl = lds + stage * 32768 + kstream * 8192 + r * 128;
      f32x16 sA, sB;
#pragma unroll
      for (int i = 0; i < 16; ++i) { sA[i] = 0.f; sB[i] = 0.f; }
      if (NDV == 2 || FIXM) {
        bf16x8 ka[4], kb[4];
#pragma unroll
        for (int ds = 0; ds < 4; ++ds) { const int co = ((2 * ds + h) ^ ((r >> 1) & 7)) << 4; ka[ds] = *(const bf16x8*)(Kl + co); kb[ds] = *(const bf16x8*)(Kl + 4096 + co); }
#pragma unroll
        for (int ds = 0; ds < 4; ++ds) { sA = MFMA32(ka[ds], qf[ds], sA); sB = MFMA32(kb[ds], qf[ds], sB); }
        __builtin_amdgcn_sched_group_barrier(0x100, 4, 0); __builtin_amdgcn_sched_group_barrier(0x008, 2, 0);
        __builtin_amdgcn_sched_group_barrier(0x100, 2, 0); __builtin_amdgcn_sched_group_barrier(0x008, 2, 0);
        __builtin_amdgcn_sched_group_barrier(0x100, 2, 0); __builtin_amdgcn_sched_group_barrier(0x008, 4, 0);
      } else {
#pragma unroll
        for (int ds = 0; ds < 4; ++ds) {
          const int co = ((2 * ds + h) ^ ((r >> 1) & 7)) << 4;
          const bf16x8 ka = *(const bf16x8*)(Kl + co), kb = *(const bf16x8*)(Kl + 4096 + co);
          sA = MFMA32(ka, qf[ds], sA); sB = MFMA32(kb, qf[ds], sB);
        }
      }
      if (MODE == AM_SWA) {
        const int qa = J.qpos0 + r, kbase = tile * 64 + 8 * h;
#pragma unroll
        for (int i = 0; i < 16; ++i) {
          const int ka_ = kbase + 16 * (i >> 3) + (i & 7);
          int d0 = qa - ka_; d0 = d0 < 0 ? -d0 : d0; if (d0 > 128) sA[i] = -INFINITY;
          int d1 = qa - (ka_ + 32); d1 = d1 < 0 ? -d1 : d1; if (d1 > 128) sB[i] = -INFINITY;
        }
      }
      if (FIXM) {
        const float nm = -J.m_init;
#pragma unroll
        for (int i = 0; i < 16; ++i) { sA[i] = __builtin_amdgcn_exp2f(fmaf(sA[i], C, nm)); sB[i] = __builtin_amdgcn_exp2f(fmaf(sB[i], C, nm)); l += sA[i] + sB[i]; }
      } else {
      float mx = sA[0];
#pragma unroll
      for (int i = 1; i < 16; ++i) mx = fmaxf(mx, sA[i]);
#pragma unroll
      for (int i = 0; i < 16; ++i) mx = fmaxf(mx, sB[i]);
      mx = swapmax(mx);
      const float mn = fmaxf(m, mx * C);
      const float alpha = __builtin_amdgcn_exp2f(m - mn);
      m = mn;
      float ps = 0.f;
#pragma unroll
      for (int i = 0; i < 16; ++i) { sA[i] = __builtin_amdgcn_exp2f(fmaf(sA[i], C, -mn)); sB[i] = __builtin_amdgcn_exp2f(fmaf(sB[i], C, -mn)); ps += sA[i] + sB[i]; }
      l = l * alpha + ps;
#pragma unroll
      for (int d = 0; d < NDV; ++d)
#pragma unroll
        for (int i = 0; i < 16; ++i) O[d][i] *= alpha;
      }
      bf16x8 pf[4];
      { u32x4 w;
        w.x = cvtpk(sA[0], sA[1]); w.y = cvtpk(sA[2], sA[3]); w.z = cvtpk(sA[4], sA[5]); w.w = cvtpk(sA[6], sA[7]); pf[0] = __builtin_bit_cast(bf16x8, w);
        w.x = cvtpk(sA[8], sA[9]); w.y = cvtpk(sA[10], sA[11]); w.z = cvtpk(sA[12], sA[13]); w.w = cvtpk(sA[14], sA[15]); pf[1] = __builtin_bit_cast(bf16x8, w);
        w.x = cvtpk(sB[0], sB[1]); w.y = cvtpk(sB[2], sB[3]); w.z = cvtpk(sB[4], sB[5]); w.w = cvtpk(sB[6], sB[7]); pf[2] = __builtin_bit_cast(bf16x8, w);
        w.x = cvtpk(sB[8], sB[9]); w.y = cvtpk(sB[10], sB[11]); w.z = cvtpk(sB[12], sB[13]); w.w = cvtpk(sB[14], sB[15]); pf[3] = __builtin_bit_cast(bf16x8, w); }
      const char* Vl = lds + stage * 32768 + NK * 8192 + vrd;
      if (FIXM) {
        bf16x8 vf[4][NDV];
#pragma unroll
        for (int ks = 0; ks < 4; ++ks) {
#pragma unroll
          for (int d = 0; d < NDV; ++d) {
            const s16x4 lo = __builtin_amdgcn_ds_read_tr16_b64_v4i16((LAS s16x4*)(Vl + ks * 2 * NDV * 512 + d * 512));
            const s16x4 hi = __builtin_amdgcn_ds_read_tr16_b64_v4i16((LAS s16x4*)(Vl + ks * 2 * NDV * 512 + d * 512 + 256));
            vf[ks][d] = __builtin_shufflevector(lo, hi, 0, 1, 2, 3, 4, 5, 6, 7);
          }
        }
#pragma unroll
        for (int ks = 0; ks < 4; ++ks) {
#pragma unroll
          for (int d = 0; d < NDV; ++d) O[d] = MFMA32(vf[ks][d], pf[ks], O[d]);
        }
        __builtin_amdgcn_sched_group_barrier(0x100, 4 * NDV, 0); __builtin_amdgcn_sched_group_barrier(0x008, NDV, 0);
        __builtin_amdgcn_sched_group_barrier(0x100, 2 * NDV, 0); __builtin_amdgcn_sched_group_barrier(0x008, NDV, 0);
        __builtin_amdgcn_sched_group_barrier(0x100, 2 * NDV, 0); __builtin_amdgcn_sched_group_barrier(0x008, 2 * NDV, 0);
      } else {
      if (FIXM) {
#pragma unroll
        for (int ks = 0; ks < 4; ++ks) Osum = MFMA32(ones, pf[ks], Osum);
      }
#pragma unroll
      for (int ks = 0; ks < 4; ++ks)
#pragma unroll
        for (int d = 0; d < NDV; ++d) {
          const s16x4 lo = __builtin_amdgcn_ds_read_tr16_b64_v4i16((LAS s16x4*)(Vl + ks * 2 * NDV * 512 + d * 512));
          const s16x4 hi = __builtin_amdgcn_ds_read_tr16_b64_v4i16((LAS s16x4*)(Vl + ks * 2 * NDV * 512 + d * 512 + 256));
          const bf16x8 vf = __builtin_shufflevector(lo, hi, 0, 1, 2, 3, 4, 5, 6, 7);
          O[d] = MFMA32(vf, pf[ks], O[d]);
        }
      }
    }
  };
  for (int it = 0; it < nt; it += 2) {
    if (ONESET) {
      A_WRITE(1, rk0, rv0);
      if (it + 2 < nt) A_LOAD(J.tile_lo + it + 2, rk0, rv0);
      compute(0, J.tile_lo + it);
      __syncthreads();
      if (it + 2 < nt) A_WRITE(0, rk0, rv0);
      if (it + 3 < nt) A_LOAD(J.tile_lo + it + 3, rk0, rv0);
      compute(1, J.tile_lo + it + 1);
      __syncthreads();
    } else if (DEEP2) {
      if (it + 2 < nt) A_LOAD(J.tile_lo + it + 2, rk0, rv0);
      compute(0, J.tile_lo + it);
      A_WRITE(1, rk1, rv1);
      __syncthreads();
      if (it + 3 < nt) A_LOAD(J.tile_lo + it + 3, rk1, rv1);
      compute(1, J.tile_lo + it + 1);
      if (it + 2 < nt) A_WRITE(0, rk0, rv0);
      __syncthreads();
    } else {
      compute(0, J.tile_lo + it);
      __builtin_amdgcn_sched_barrier(0);
      A_LOAD(J.tile_lo + it + 1, rk0, rv0); A_WRITE(1, rk0, rv0);
      __syncthreads();
      compute(1, J.tile_lo + it + 1);
      __builtin_amdgcn_sched_barrier(0);
      if (it + 2 < nt) { A_LOAD(J.tile_lo + it + 2, rk0, rv0); A_WRITE(0, rk0, rv0); }
      __syncthreads();
    }
  }
#undef A_LOAD
#undef A_WRITE
  if (J.dry) return;
  const float lt = swapsum(l);
  attn_finalize<DV, MODE>(lds, J, O, lt, wid, r, h);
}

template <int DV, int NK, int MODE, int GRP>
DI void attn_pipe(char* lds_wg, const AttnJob& J) {
  constexpr int NDV = DV / 32;
  constexpr float C = 0.125f * LOG2E;
  constexpr int KST = NK * 8192, VST = DV * 128, VB = 2 * KST;
  const int tid_wg = ltid(), tid = tid_wg & (AT - 1), lane = tid & 63, wid = tid >> 6, r = lane & 31, h = lane >> 5;
  char* lds = lds_wg + GRP * 65536;
  const int kstream = (NK == 2) ? (wid & 1) : 0;
  bf16x8 qf[4];
  const bf16_t* qrow = J.q + (size_t)r * UW + 8 * h;
#pragma unroll
  for (int ds = 0; ds < 4; ++ds) qf[ds] = *(const bf16x8*)(qrow + 16 * ds);
  f32x16 O[NDV], Osum;
#pragma unroll
  for (int d = 0; d < NDV; ++d)
#pragma unroll
    for (int i = 0; i < 16; ++i) O[d][i] = 0.f;
#pragma unroll
  for (int i = 0; i < 16; ++i) Osum[i] = 0.f;
  const bf16x8 ones = {0x3F80, 0x3F80, 0x3F80, 0x3F80, 0x3F80, 0x3F80, 0x3F80, 0x3F80};
  const float nm = -J.m_init;
  const int ksrow = tid >> 3, ksch = tid & 7;
  const int kpi = (ksrow & ~12) | ((ksrow & 4) << 1) | ((ksrow & 8) >> 1);
  const int ksoff = kpi * 128 + ((ksch ^ ((kpi >> 1) & 7)) << 4);
  constexpr int VCH = DV / 8, VI = (64 * VCH) / AT;
  const int vkey0 = tid / VCH, vc8 = (tid % VCH) * 8;
  u32x4 rk0[NK][2], rv0[VI], rk1[NK][2], rv1[VI];
#define K_LOAD(t, rk) do { const size_t kb_ = (size_t)(t) * 64; \
    _Pragma("unroll") for (int s = 0; s < NK; ++s) _Pragma("unroll") for (int i = 0; i < 2; ++i) rk[s][i] = *(const u32x4*)(J.k[s] + (kb_ + ksrow + 32 * i) * J.ldk + ksch * 8); } while (0)
#define V_LOAD(t, rv) do { const size_t kb_ = (size_t)(t) * 64; \
    _Pragma("unroll") for (int i = 0; i < VI; ++i) rv[i] = *(const u32x4*)(J.v + (kb_ + vkey0 + (AT / VCH) * i) * J.ldv + vc8); } while (0)
#define K_WRITE(st, rk) do { char* b_ = lds + (st) * KST; \
    _Pragma("unroll") for (int s = 0; s < NK; ++s) _Pragma("unroll") for (int i = 0; i < 2; ++i) *(u32x4*)(b_ + s * 8192 + i * 4096 + ksoff) = rk[s][i]; } while (0)
#define V_WRITE(st, rv) do { char* b_ = lds + VB + (st) * VST; \
    _Pragma("unroll") for (int i = 0; i < VI; ++i) { const int key_ = vkey0 + (AT / VCH) * i; \
      *(u32x4*)(b_ + ((key_ >> 3) * NDV + (vc8 >> 5)) * 512 + (key_ & 7) * 64 + (vc8 & 31) * 2) = rv[i]; } } while (0)
  const int nt = J.tile_hi - J.tile_lo, t0 = J.tile_lo;
  const int i16 = lane & 15;
  const int vrd = h * NDV * 512 + (i16 >> 2) * 64 + (((lane >> 4) & 1) * 16 + (i16 & 3) * 4) * 2;
  auto qk = [&](const int kst, f32x16& sA, f32x16& sB) __attribute__((always_inline)) {
    const char* Kl = lds + kst * KST + kstream * 8192 + r * 128;
#pragma unroll
    for (int i = 0; i < 16; ++i) { sA[i] = 0.f; sB[i] = 0.f; }
    bf16x8 ka[4], kb[4];
#pragma unroll
    for (int ds = 0; ds < 4; ++ds) { const int co = ((2 * ds + h) ^ ((r >> 1) & 7)) << 4; ka[ds] = *(const bf16x8*)(Kl + co); kb[ds] = *(const bf16x8*)(Kl + 4096 + co); }
    __builtin_amdgcn_sched_barrier(0);
#pragma unroll
    for (int ds = 0; ds < 4; ++ds) { sA = MFMA32(ka[ds], qf[ds], sA); sB = MFMA32(kb[ds], qf[ds], sB); }
  };
  auto smpv = [&](const int vst, f32x16& sA, f32x16& sB) __attribute__((always_inline)) {
    const char* Vl = lds + VB + vst * VST + vrd;
    bf16x8 vf[4][NDV];
#pragma unroll
    for (int ks = 0; ks < 4; ++ks)
#pragma unroll
      for (int d = 0; d < NDV; ++d) {
        const s16x4 lo = __builtin_amdgcn_ds_read_tr16_b64_v4i16((LAS s16x4*)(Vl + ks * 2 * NDV * 512 + d * 512));
        const s16x4 hi = __builtin_amdgcn_ds_read_tr16_b64_v4i16((LAS s16x4*)(Vl + ks * 2 * NDV * 512 + d * 512 + 256));
        vf[ks][d] = __builtin_shufflevector(lo, hi, 0, 1, 2, 3, 4, 5, 6, 7);
      }
    __builtin_amdgcn_sched_barrier(0);
#pragma unroll
    for (int i = 0; i < 16; ++i) { sA[i] = __builtin_amdgcn_exp2f(fmaf(sA[i], C, nm)); sB[i] = __builtin_amdgcn_exp2f(fmaf(sB[i], C, nm)); }
    bf16x8 pf[4];
    { u32x4 w;
      w.x = cvtpk(sA[0], sA[1]); w.y = cvtpk(sA[2], sA[3]); w.z = cvtpk(sA[4], sA[5]); w.w = cvtpk(sA[6], sA[7]); pf[0] = __builtin_bit_cast(bf16x8, w);
      w.x = cvtpk(sA[8], sA[9]); w.y = cvtpk(sA[10], sA[11]); w.z = cvtpk(sA[12], sA[13]); w.w = cvtpk(sA[14], sA[15]); pf[1] = __builtin_bit_cast(bf16x8, w);
      w.x = cvtpk(sB[0], sB[1]); w.y = cvtpk(sB[2], sB[3]); w.z = cvtpk(sB[4], sB[5]); w.w = cvtpk(sB[6], sB[7]); pf[2] = __builtin_bit_cast(bf16x8, w);
      w.x = cvtpk(sB[8], sB[9]); w.y = cvtpk(sB[10], sB[11]); w.z = cvtpk(sB[12], sB[13]); w.w = cvtpk(sB[14], sB[15]); pf[3] = __builtin_bit_cast(bf16x8, w); }
#pragma unroll
    for (int ks = 0; ks < 4; ++ks) Osum = MFMA32(ones, pf[ks], Osum);
#pragma unroll
    for (int ks = 0; ks < 4; ++ks)
#pragma unroll
      for (int d = 0; d < NDV; ++d) O[d] = MFMA32(vf[ks][d], pf[ks], O[d]);
  };
  K_LOAD(t0, rk0); V_LOAD(t0, rv0); K_LOAD(t0 + 1, rk1);
  K_WRITE(0, rk0); V_WRITE(0, rv0); K_WRITE(1, rk1);
  if (2 < nt) K_LOAD(t0 + 2, rk0);
  V_LOAD(t0 + 1, rv0);
  __syncthreads();
  f32x16 eA, eB, oA, oB;
  qk(0, eA, eB);
  __syncthreads();
  for (int j = 0; j < nt; j += 2) {
    if (j + 3 < nt) K_LOAD(t0 + j + 3, rk1);
    if (j + 2 < nt) V_LOAD(t0 + j + 2, rv1);
    qk(1, oA, oB);
    __builtin_amdgcn_sched_barrier(0);
    smpv(0, eA, eB);
    if (j + 2 < nt) K_WRITE(0, rk0);
    V_WRITE(1, rv0);
    __syncthreads();
    if (j + 4 < nt) K_LOAD(t0 + j + 4, rk0);
    if (j + 3 < nt) V_LOAD(t0 + j + 3, rv0);
    if (j + 2 < nt) qk(0, eA, eB);
    __builtin_amdgcn_sched_barrier(0);
    smpv(1, oA, oB);
    if (j + 3 < nt) K_WRITE(1, rk1);
    if (j + 2 < nt) V_WRITE(0, rv1);
    __syncthreads();
  }
#undef K_LOAD
#undef V_LOAD
#undef K_WRITE
#undef V_WRITE
  if (J.dry) return;
  attn_finalize<DV, MODE>(lds, J, O, Osum[0], wid, r, h);
}

#define PIPE_CALL(DV, NK, MODE) do { if (grp) attn_pipe<DV, NK, MODE, 1>(lds, J); else attn_pipe<DV, NK, MODE, 0>(lds, J); } while (0)
#define ATTN_CALL(DV, NK, MODE, FIXM) do { if (grp) attn_job<DV, NK, MODE, FIXM, 1>(lds, J); else attn_job<DV, NK, MODE, FIXM, 0>(lds, J); } while (0)
DI void mem_jobs(char* lds, const Params& p, int layer, int dry) {
  const int grp = __builtin_amdgcn_readfirstlane(ltid() >> 8);
  const int wid = (ltid() >> 6) & 3, vb = blockIdx.x * 2 + grp, vg = gridDim.x * 2;
  for (int job = vb; job < 768 * 4; job += vg) {
    const int qb = job >> 2, hm = job & 3, t0 = qb * 128;
    int S, seq0, pos, sq; tok_info(t0, S, seq0, pos, sq);
    AttnJob J;
    bf16_t* qo = p.u + (size_t)(t0 + 32 * wid) * UW + 2304 + hm * 64;
    J.q = qo; J.o = qo; J.z = p.u + (size_t)(t0 + 32 * wid) * UW + 2560 + 1024 + hm * 64;
    J.k[0] = J.k[1] = p.memkv + (size_t)(sq * 256) * 2048 + layer * 512 + hm * 64; J.v = J.k[0] + 256; J.ldk = J.ldv = 2048;
    J.tile_lo = 0; J.tile_hi = 4; J.m_init = -1e30f; J.l_init = 0.f; J.qpos0 = 0; J.lam = 0.f; J.oscale = 0.f; J.subg = nullptr; J.dry = dry;
    ATTN_CALL(64, 1, AM_PLAIN, false);
  }
}

DI void phase_mix_even(char* lds, const Params& p, int layer, int dry) {
  const int grp = __builtin_amdgcn_readfirstlane(ltid() >> 8);
  const int e = layer >> 1, wid = (ltid() >> 6) & 3, vb = blockIdx.x * 2 + grp, vg = gridDim.x * 2;
  for (int job = vb; job < 768 * 8; job += vg) {
    const int qb = job >> 3, hq = job & 7, kvh = hq >> 2, t0 = qb * 128;
    int S, seq0, pos, sq; tok_info(t0, S, seq0, pos, sq);
    AttnJob J;
    bf16_t* qo = p.u + (size_t)(t0 + 32 * wid) * UW + 1536 + hq * 64;
    J.q = qo; J.o = qo; J.z = p.u + (size_t)(t0 + 32 * wid) * UW + 2560 + 512 + hq * 64;
    J.k[0] = J.k[1] = p.u + (size_t)seq0 * UW + 2048 + kvh * 64; J.v = p.u + (size_t)seq0 * UW + 2176 + kvh * 64; J.ldk = J.ldv = UW;
    const int pt = pos >> 6;
    J.tile_lo = pt - 2 < 0 ? 0 : pt - 2; J.tile_hi = pt + 4 > (S >> 6) ? (S >> 6) : pt + 4;
    J.m_init = p.swa_sink[e * 8 + hq] * LOG2E; J.l_init = 1.f; J.qpos0 = pos + 32 * wid; J.lam = 0.f; J.oscale = 0.f; J.subg = nullptr; J.dry = dry;
    ATTN_CALL(64, 1, AM_SWA, false);
  }
  mem_jobs(lds, p, layer, dry);
  const float* cw = p.conv_w + e * 3 * 512;
  for (int idx = blockIdx.x * NTHREADS + ltid(); idx < NTOK * 64; idx += gridDim.x * NTHREADS) {
    const int t = idx >> 6, c0 = (idx & 63) * 8;
    int S, seq0, pos, sq; tok_info(t, S, seq0, pos, sq);
    bf16_t* ur = p.u + (size_t)t * UW;
    float ic[8], il[8], ir[8];
    { const u32x4 a = *(const u32x4*)(ur + 512 + c0), b = *(const u32x4*)(ur + 1024 + c0);
#pragma unroll
      for (int j = 0; j < 4; ++j) { ic[2 * j] = bflo(a[j]) * bflo(b[j]); ic[2 * j + 1] = bfhi(a[j]) * bfhi(b[j]); } }
    if (pos > 0) { const u32x4 a = *(const u32x4*)(ur - UW + 512 + c0), b = *(const u32x4*)(ur - UW + 1024 + c0);
#pragma unroll
      for (int j = 0; j < 4; ++j) { il[2 * j] = bflo(a[j]) * bflo(b[j]); il[2 * j + 1] = bfhi(a[j]) * bfhi(b[j]); } }
    else {
#pragma unroll
      for (int j = 0; j < 8; ++j) il[j] = 0.f; }
    if (pos < S - 1) { const u32x4 a = *(const u32x4*)(ur + UW + 512 + c0), b = *(const u32x4*)(ur + UW + 1024 + c0);
#pragma unroll
      for (int j = 0; j < 4; ++j) { ir[2 * j] = bflo(a[j]) * bflo(b[j]); ir[2 * j + 1] = bfhi(a[j]) * bfhi(b[j]); } }
    else {
#pragma unroll
      for (int j = 0; j < 8; ++j) ir[j] = 0.f; }
    const u32x4 gbw = *(const u32x4*)(ur + c0), zw = *(const u32x4*)(ur + 2560 + c0);
    float y[8];
#pragma unroll
    for (int j = 0; j < 8; ++j) {
      const float gb = (j & 1) ? bfhi(gbw[j >> 1]) : bflo(gbw[j >> 1]);
      const float z = (j & 1) ? bfhi(zw[j >> 1]) : bflo(zw[j >> 1]);
      const float cv = il[j] * cw[c0 + j] + ic[j] * cw[512 + c0 + j] + ir[j] * cw[1024 + c0 + j];
      y[j] = gb * cv * silu(z);
    }
    u32x4 w; w.x = cvtpk(y[0], y[1]); w.y = cvtpk(y[2], y[3]); w.z = cvtpk(y[4], y[5]); w.w = cvtpk(y[6], y[7]);
    if (!dry) *(u32x4*)(ur + c0) = w;
  }
}

DI void phase_mix_odd(char* lds, const Params& p, int layer, int dry) {
  const int grp = __builtin_amdgcn_readfirstlane(ltid() >> 8);
  const int o = layer >> 1, wid = (ltid() >> 6) & 3;
  const int nx = (gridDim.x & 7) == 0 ? 8 : 1, bx = blockIdx.x % nx, bi = (blockIdx.x / nx) * 2 + grp, nbx = (gridDim.x / nx) * 2;
  const float mb_dense = p.lam[8 + o * 2], mb_diff = p.lam[8 + o * 2 + 1];
  const bool fix_dense = mb_dense < 43.f, fix_diff = mb_diff < 43.f;
#pragma unroll 1
  for (int part = 0; part < 2; ++part) {
    const int gshift = part ? 7 : 8, nv = (16 / nx) << gshift;
#pragma unroll 1
    for (int v = bi; v < nv; v += nbx) {
      const int j = ((bx + nx * (v >> gshift)) << gshift) + (v & ((1 << gshift) - 1));
      int g, qb, kvh, seq0, S;
      if (!part) { g = j & 3; qb = (j >> 2) & 63; kvh = (j >> 8) & 1; seq0 = (j >> 9) * 8192; S = 8192; }
      else { g = j & 3; qb = (j >> 2) & 31; kvh = (j >> 7) & 1; seq0 = NTOKP + (j >> 8) * 4096; S = 4096; }
      const int hq = kvh * 4 + g, t0 = seq0 + qb * 128 + 32 * wid;
      AttnJob J;
      bf16_t* qo = p.u + (size_t)t0 * UW + hq * 64;
      J.q = qo; J.o = qo; J.z = p.u + (size_t)t0 * UW + 2560 + hq * 64;
      J.k[0] = J.k[1] = p.u + (size_t)seq0 * UW + 512 + kvh * 64; J.v = p.u + (size_t)seq0 * UW + 640 + kvh * 64; J.ldk = J.ldv = UW;
      J.tile_lo = 0; J.tile_hi = S >> 6; J.l_init = 0.f; J.qpos0 = 0; J.lam = 0.f; J.oscale = 0.f; J.subg = nullptr; J.dry = dry;
      if (fix_dense) { J.m_init = mb_dense; ATTN_CALL(64, 1, AM_PLAIN, true); }
      else { J.m_init = -1e30f; ATTN_CALL(64, 1, AM_PLAIN, false); }
    }
  }
  const float lam = p.lam[o * 2], osc = p.lam[o * 2 + 1];
#pragma unroll 1
  for (int part = 0; part < 2; ++part) {
    const int gshift = part ? 6 : 7, nv = (32 / nx) << gshift;
#pragma unroll 1
    for (int v = bi; v < nv; v += nbx) {
      const int j = ((bx + nx * (v >> gshift)) << gshift) + (v & ((1 << gshift) - 1));
      int qb, hh, seq0, S;
      if (!part) { qb = j & 127; hh = (j >> 7) & 3; seq0 = (j >> 9) * 8192; S = 8192; }
      else { qb = j & 63; hh = (j >> 6) & 3; seq0 = NTOKP + (j >> 8) * 4096; S = 4096; }
      const int mp = wid & 1, sub = wid >> 1, t0 = seq0 + qb * 64 + sub * 32;
      AttnJob J;
      J.q = p.u + (size_t)t0 * UW + 768 + (2 * hh + mp) * 64;
      J.o = p.u + (size_t)t0 * UW + 768 + hh * 128; J.z = p.u + (size_t)t0 * UW + 2560 + 512 + hh * 128;
      J.k[0] = p.u + (size_t)seq0 * UW + 1280 + (2 * hh) * 64; J.k[1] = J.k[0] + 64; J.v = p.u + (size_t)seq0 * UW + 1792 + hh * 128; J.ldk = J.ldv = UW;
      J.tile_lo = 0; J.tile_hi = S >> 6; J.l_init = 0.f; J.qpos0 = 0; J.lam = lam; J.oscale = osc; J.subg = p.diff_subln_g + o * 128; J.dry = dry;
      if (fix_diff) { J.m_init = mb_diff; ATTN_CALL(128, 2, AM_DIFF, true); }
      else { J.m_init = -1e30f; ATTN_CALL(128, 2, AM_DIFF, false); }
    }
  }
  mem_jobs(lds, p, layer, dry);
}

DI void phase_norm(const Params& p) {
  const int gw = blockIdx.x * 8 + (ltid() >> 6), nw = gridDim.x * 8;
  norm_rows(p.out, p.xb, p.rstd, 0, NTOK, gw, nw);
}

__global__ void __launch_bounds__(NTHREADS, 2) fwd_kernel(Params p) {
  __shared__ __attribute__((aligned(16))) char lds[LDS_BYTES];
  int ph = p.phase_lo;
  if (ph == 0) {
    phase_prep(lds, p);
    ph = 1;
#if !MULTI_LAUNCH
    if (ph < p.phase_hi) cg::this_grid().sync();
#endif
  }
  for (; ph < p.phase_hi; ++ph) {
    {
      const int l = (ph - 1) / 3, s = (ph - 1) - 3 * l;
      if (s == 0) {
        if (l == 0) { GemmDesc g{p.memb, p.wt_mem, DM, DM, 16, 8, 0, 0}; gemm_phase<EPI_MEM>(lds, p, g, 0); }
        GemmDesc g{p.xb, p.wt_in + (size_t)l * UW * DM, DM, DM, NTOK / 256, UW / 256, 0, 0};
        const int nrep = ((p.probe >> 2) & 1) + 1;
#pragma unroll 1
        for (int rep = 0; rep < nrep; ++rep) gemm_phase<EPI_IN>(lds, p, g, l);
      } else if (s == 1) {
        const int nrep = ((l & 1) ? (p.probe & 1) : ((p.probe >> 1) & 1)) + 1;
#pragma unroll 1
        for (int rep = 0; rep < nrep; ++rep) {
          const int dry = rep + 1 < nrep;
          if (rep == 0) {
            float* z = p.rstd + ((l + 1) & 1) * NTOK;
            for (int i = blockIdx.x * NTHREADS + ltid(); i < NTOK; i += gridDim.x * NTHREADS) z[i] = 0.f;
          }
          if (ltid() >> 8) __builtin_amdgcn_s_setprio(1);
          if (l & 1) phase_mix_odd(lds, p, l, dry); else phase_mix_even(lds, p, l, dry);
          __builtin_amdgcn_s_setprio(0);
        }
      } else if (s == 2) {
        GemmDesc g{p.u, p.wt_out + (size_t)l * DM * MIXW, UW, MIXW, NTOK / 256, DM / 256, 1, (l & 1) ? 768 : 1536};
        gemm_phase<EPI_OUT>(lds, p, g, l);
      }
    }
#if !MULTI_LAUNCH
    if (ph + 1 < p.phase_hi) cg::this_grid().sync();
#endif
  }
}

extern "C" void kernel_launch(void* const* d_in, const int* in_sizes, int n_in, void* d_out, int out_size, void* d_ws, size_t ws_size,
                              hipStream_t stream) {
  static int grid_blocks = 0;
  if (!grid_blocks) {
    int dev = 0, cus = 0, per_cu = 0;
    hipGetDevice(&dev);
    hipDeviceGetAttribute(&cus, hipDeviceAttributeMultiprocessorCount, dev);
    hipOccupancyMaxActiveBlocksPerMultiprocessor(&per_cu, fwd_kernel, NTHREADS, 0);
    if (per_cu > 1) per_cu = 1;
    if (per_cu < 1) per_cu = 1;
    int cap = cus * per_cu; if (cap > 256) cap = 256;
    grid_blocks = 8; while (grid_blocks * 2 <= cap) grid_blocks *= 2;
  }
  Params p{};
  p.xp = (const float*)d_in[0]; p.xs = (const float*)d_in[1]; p.memp = (const float*)d_in[2]; p.mems = (const float*)d_in[3];
  p.norm_g = (const float*)d_in[4]; p.w_in = (const float*)d_in[5]; p.w_out = (const float*)d_in[6]; p.mem_norm_g = (const float*)d_in[7];
  p.w_mem_kv = (const float*)d_in[8]; p.mem_qk_g = (const float*)d_in[9]; p.conv_w = (const float*)d_in[10]; p.swa_qk_g = (const float*)d_in[11];
  p.swa_sink = (const float*)d_in[12]; p.ax_qk_g = (const float*)d_in[13]; p.diff_qk_g = (const float*)d_in[14]; p.diff_lambda = (const float*)d_in[15];
  p.diff_subln_g = (const float*)d_in[16];
  p.out = (float*)d_out;
  char* w = (char*)d_ws; size_t off = 0;
  auto take = [&](size_t bytes) { char* r = w + off; off += (bytes + 255) & ~(size_t)255; return r; };
  p.u = (bf16_t*)take((size_t)NTOK * UW * 2);
  p.xb = (bf16_t*)take((size_t)NTOK * DM * 2);
  p.wt_in = (bf16_t*)take((size_t)4 * UW * DM * 2);
  p.wt_out = (bf16_t*)take((size_t)4 * DM * MIXW * 2);
  p.wt_mem = (bf16_t*)take((size_t)2048 * DM * 2);
  p.memb = (bf16_t*)take((size_t)4096 * DM * 2);
  p.memkv = (bf16_t*)take((size_t)4096 * 2048 * 2);
  p.rstd = (float*)take((size_t)NTOK * 4 * 2);
  p.rstd_mem = (float*)take(4096 * 4);
  p.tab1c = (float*)take(8192 * 32 * 4); p.tab1s = (float*)take(8192 * 32 * 4);
  p.tabac = (float*)take(128 * 16 * 4); p.tabas = (float*)take(128 * 16 * 4);
  p.lam = (float*)take(256);
  if (off > ws_size) { fprintf(stderr, "workspace too small: need %zu have %zu\n", off, ws_size); return; }
#if MULTI_LAUNCH
  for (int ph = 0; ph < NPHASE; ++ph) {
    p.phase_lo = ph; p.phase_hi = ph + 1;
    hipLaunchKernelGGL(fwd_kernel, dim3(grid_blocks), dim3(NTHREADS), 0, stream, p);
  }
#else
  p.phase_lo = 0; p.phase_hi = NPHASE; p.probe = PROBE_ODD | (PROBE_EVEN << 1) | (PROBE_GIN << 2);
  void* args[] = {&p};
  hipError_t e = hipLaunchCooperativeKernel((void*)fwd_kernel, dim3(grid_blocks), dim3(NTHREADS), args, 0, stream);
  if (e != hipSuccess) fprintf(stderr, "cooperative launch failed: %s (grid %d)\n", hipGetErrorString(e), grid_blocks);
#endif
}
```

```cpp
#include <hip/hip_runtime.h>
#include <hip/hip_cooperative_groups.h>
#include <cstdint>
#include <cstdio>
namespace cg = cooperative_groups;

#ifndef MULTI_LAUNCH
#define MULTI_LAUNCH 0
#endif

#ifndef PROBE_ODD
#define PROBE_ODD 0
#endif
#ifndef PROBE_EVEN
#define PROBE_EVEN 0
#endif
#ifndef PROBE_GIN
#define PROBE_GIN 0
#endif
#define DI __device__ __forceinline__
#define LAS __attribute__((address_space(3)))
typedef unsigned short bf16_t;
typedef short bf16x8 __attribute__((ext_vector_type(8)));
typedef short s16x4 __attribute__((ext_vector_type(4)));
typedef float f32x16 __attribute__((ext_vector_type(16)));
typedef float f32x4 __attribute__((ext_vector_type(4)));
typedef unsigned u32x4 __attribute__((ext_vector_type(4)));
typedef unsigned u32x2 __attribute__((ext_vector_type(2)));

constexpr int NTOK = 98304, NTOKP = 65536, UW = 3840, DM = 1024, MIXW = 1280;
constexpr int NTHREADS = 512;
constexpr int AT = 256;
constexpr int LDS_BYTES = 131072 + 32768;
constexpr float EPSF = 1e-6f;
constexpr float LOG2E = 1.4426950408889634f;
constexpr int NPHASE = 13;

struct Params {
  const float *xp, *xs, *memp, *mems, *norm_g, *w_in, *w_out, *mem_norm_g, *w_mem_kv, *mem_qk_g, *conv_w, *swa_qk_g,
      *swa_sink, *ax_qk_g, *diff_qk_g, *diff_lambda, *diff_subln_g;
  float* out;
  bf16_t *u, *xb, *wt_in, *wt_out, *wt_mem, *memb, *memkv;
  float *rstd, *rstd_mem, *tab1c, *tab1s, *tabac, *tabas, *lam;
  int phase_lo, phase_hi, probe, pad_;
};

typedef __bf16 bf16x2_t __attribute__((ext_vector_type(2)));
typedef float f32x2 __attribute__((ext_vector_type(2)));
DI unsigned cvtpk(float lo, float hi) { f32x2 v = {lo, hi}; bf16x2_t b = __builtin_convertvector(v, bf16x2_t); return __builtin_bit_cast(unsigned, b); }
DI float bf2f(unsigned short b) { return __uint_as_float(((unsigned)b) << 16); }
DI float bflo(unsigned w) { return __uint_as_float(w << 16); }
DI float bfhi(unsigned w) { return __uint_as_float(w & 0xffff0000u); }
DI int ltid() { int t; asm volatile("v_mov_b32 %0, %1" : "=v"(t) : "v"(threadIdx.x)); return t; }
DI int crow(int i, int h) { return (i & 3) + 8 * (i >> 2) + 4 * h; }
DI float swapmax(float v) { auto rr = __builtin_amdgcn_permlane32_swap(__float_as_uint(v), __float_as_uint(v), false, false); return fmaxf(__uint_as_float(rr[0]), __uint_as_float(rr[1])); }
DI float swapsum(float v) { auto rr = __builtin_amdgcn_permlane32_swap(__float_as_uint(v), __float_as_uint(v), false, false); return __uint_as_float(rr[0]) + __uint_as_float(rr[1]); }
DI float shx(float v, int lane, int o) { return __int_as_float(__builtin_amdgcn_ds_bpermute(((lane ^ o) & 63) << 2, __float_as_int(v))); }
DI float silu(float z) { return z / (1.f + __expf(-z)); }
#define MFMA32(a, b, c) __builtin_amdgcn_mfma_f32_32x32x16_bf16((a), (b), (c), 0, 0, 0)

DI void tok_info(int t, int& S, int& seq0, int& pos, int& sq) {
  if (t < NTOKP) { S = 8192; seq0 = t & ~8191; pos = t & 8191; sq = t >> 13; }
  else { int tt = t - NTOKP; S = 4096; seq0 = NTOKP + (tt & ~4095); pos = tt & 4095; sq = 8 + (tt >> 12); }
}

DI void transpose_tile(char* lds, const float* src, const float* g, bf16_t* dst, int K, int N, int k0, int n0) {
  float* tile = (float*)lds;
  const int tid = ltid(), a = tid >> 6, b = tid & 63;
#pragma unroll 4
  for (int i = 0; i < 8; ++i) { int kk = i * 8 + a; float v = src[(size_t)(k0 + kk) * N + n0 + b]; if (g) v *= g[k0 + kk]; tile[kk * 65 + b] = v; }
  __syncthreads();
#pragma unroll 4
  for (int i = 0; i < 8; ++i) { int nn = i * 8 + a; float v = tile[b * 65 + nn]; dst[(size_t)(n0 + nn) * K + k0 + b] = (bf16_t)(cvtpk(v, v) & 0xffffu); }
  __syncthreads();
}

DI void norm_rows(const float* src, bf16_t* dst, float* ssq, int row_begin, int row_end, int gw, int nw) {
  const int lane = ltid() & 63;
  for (int row = row_begin + gw; row < row_end; row += nw) {
    const float* s = src + (size_t)(row - row_begin) * DM; bf16_t* d = dst + (size_t)row * DM;
    f32x4 v[4]; float ss = 0.f;
#pragma unroll
    for (int j = 0; j < 4; ++j) { v[j] = *(const f32x4*)(s + (lane + 64 * j) * 4); ss += v[j][0] * v[j][0] + v[j][1] * v[j][1] + v[j][2] * v[j][2] + v[j][3] * v[j][3]; }
#pragma unroll
    for (int o = 32; o > 0; o >>= 1) ss += shx(ss, lane, o);
    const float rs = ssq ? 1.f : rsqrtf(ss * (1.f / DM) + EPSF);
#pragma unroll
    for (int j = 0; j < 4; ++j) { u32x2 w; w.x = cvtpk(v[j][0] * rs, v[j][1] * rs); w.y = cvtpk(v[j][2] * rs, v[j][3] * rs); *(u32x2*)(d + (lane + 64 * j) * 4) = w; }
    if (ssq && lane == 0) ssq[row] = ss;
  }
}

DI void phase_prep(char* lds, const Params& p) {
  const int T_IN = 4 * 16 * 60, T_OUT = 4 * 20 * 16, T_MEM = 4 * 16 * 8;
  for (int t = blockIdx.x; t < T_IN + T_OUT + T_MEM; t += gridDim.x) {
    if (t < T_IN) { int l = t / 960, r = t % 960, kt = r / 60, nt = r % 60;
      transpose_tile(lds, p.w_in + (size_t)l * DM * UW, p.norm_g + l * DM, p.wt_in + (size_t)l * UW * DM, DM, UW, kt * 64, nt * 64); }
    else if (t < T_IN + T_OUT) { int tt = t - T_IN; int l = tt / 320, r = tt % 320, kt = r / 16, nt = r % 16;
      transpose_tile(lds, p.w_out + (size_t)l * MIXW * DM, nullptr, p.wt_out + (size_t)l * DM * MIXW, MIXW, DM, kt * 64, nt * 64); }
    else { int tt = t - T_IN - T_OUT; int l = tt / 128, r = tt % 128, kt = r / 8, nt = r % 8;
      transpose_tile(lds, p.w_mem_kv + (size_t)l * DM * 512, p.mem_norm_g + l * DM, p.wt_mem + (size_t)l * 512 * DM, DM, 512, kt * 64, nt * 64); }
  }
  const int gw = blockIdx.x * 8 + (ltid() >> 6), nw = gridDim.x * 8;
  norm_rows(p.memp, p.memb, nullptr, 0, 2048, gw, nw);
  norm_rows(p.mems, p.memb, nullptr, 2048, 4096, gw, nw);
  norm_rows(p.xp, p.xb, p.rstd, 0, NTOKP, gw, nw);
  norm_rows(p.xs, p.xb, p.rstd, NTOKP, NTOK, gw, nw);
  const int gt = blockIdx.x * NTHREADS + ltid(), nt_ = gridDim.x * NTHREADS;
  for (int i = gt; i < 8192 * 32; i += nt_) { int pos = i >> 5, f = i & 31; float inv = powf(10000.f, -(float)(2 * f) / 64.f); float ang = (float)pos * inv; p.tab1c[i] = cosf(ang); p.tab1s[i] = sinf(ang); }
  for (int i = gt; i < 128 * 16; i += nt_) { int pos = i >> 4, f = i & 15; float inv = powf(10000.f, -(float)(2 * f) / 32.f); float ang = (float)pos * inv; p.tabac[i] = cosf(ang); p.tabas[i] = sinf(ang); }
  if (blockIdx.x == 0 && ltid() < 64) {
    const int lane = ltid();
    for (int o = 0; o < 2; ++o) {
      const float* lv = p.diff_lambda + o * 256;
      float a = lv[lane] * lv[64 + lane], b = lv[128 + lane] * lv[192 + lane];
#pragma unroll
      for (int s = 32; s > 0; s >>= 1) { a += shx(a, lane, s); b += shx(b, lane, s); }
      float li = 0.8f - 0.6f * expf(-0.3f * (float)(2 * o + 1));
      if (lane == 0) { p.lam[o * 2] = expf(a) - expf(b) + li; p.lam[o * 2 + 1] = 1.f - li; }
      float g0 = fabsf(p.ax_qk_g[o * 128 + lane]), g1 = fabsf(p.ax_qk_g[o * 128 + 64 + lane]);
      float g2 = fabsf(p.diff_qk_g[o * 128 + lane]), g3 = fabsf(p.diff_qk_g[o * 128 + 64 + lane]);
#pragma unroll
      for (int s = 32; s > 0; s >>= 1) { g0 = fmaxf(g0, shx(g0, lane, s)); g1 = fmaxf(g1, shx(g1, lane, s)); g2 = fmaxf(g2, shx(g2, lane, s)); g3 = fmaxf(g3, shx(g3, lane, s)); }
      if (lane == 0) { p.lam[8 + o * 2] = 8.f * g0 * g1 * 1.02f * LOG2E; p.lam[8 + o * 2 + 1] = 8.f * g2 * g3 * 1.02f * LOG2E; }
    }
  }
}

struct GemmDesc { const bf16_t* A; const bf16_t* Bt; int lda, K, mtiles, ntiles, remap, seg2; };
enum { EPI_IN = 0, EPI_MEM = 1, EPI_OUT = 2 };

DI void head_store(f32x16 v0, f32x16 v1, float rs, int mode, const float* gain, const Params& p, int pos, bf16_t* obase, int ldo, char* stg_wg) {
  const int tid_ = ltid(), lane = tid_ & 63, r = lane & 31, h = lane >> 5;
  char* stg = stg_wg + (tid_ >> 6) * 4096;
  v0 *= rs; v1 *= rs;
  if (mode) {
    float ss = 0.f;
#pragma unroll
    for (int i = 0; i < 16; ++i) ss += v0[i] * v0[i] + v1[i] * v1[i];
    ss = swapsum(ss);
    const float inv = rsqrtf(ss * (1.f / 64.f) + EPSF);
#pragma unroll
    for (int g4 = 0; g4 < 4; ++g4) {
      const f32x4 ga = *(const f32x4*)(gain + 8 * g4 + 4 * h), gb = *(const f32x4*)(gain + 32 + 8 * g4 + 4 * h);
#pragma unroll
      for (int j = 0; j < 4; ++j) { v0[4 * g4 + j] *= inv * ga[j]; v1[4 * g4 + j] *= inv * gb[j]; }
    }
    if (mode == 2) {
#pragma unroll
      for (int g4 = 0; g4 < 4; ++g4) {
        const f32x4 c = *(const f32x4*)(p.tab1c + pos * 32 + 8 * g4 + 4 * h), s = *(const f32x4*)(p.tab1s + pos * 32 + 8 * g4 + 4 * h);
#pragma unroll
        for (int j = 0; j < 4; ++j) { const int i = 4 * g4 + j; const float x1 = v0[i], x2 = v1[i]; v0[i] = x1 * c[j] - x2 * s[j]; v1[i] = x2 * c[j] + x1 * s[j]; }
      }
    } else if (mode == 3) {
      const int row = pos >> 6, col = pos & 63;
#pragma unroll
      for (int g4 = 0; g4 < 2; ++g4) {
        const f32x4 c0 = *(const f32x4*)(p.tabac + row * 16 + 8 * g4 + 4 * h), s0 = *(const f32x4*)(p.tabas + row * 16 + 8 * g4 + 4 * h);
        const f32x4 c1 = *(const f32x4*)(p.tabac + col * 16 + 8 * g4 + 4 * h), s1 = *(const f32x4*)(p.tabas + col * 16 + 8 * g4 + 4 * h);
#pragma unroll
        for (int j = 0; j < 4; ++j) { const int i = 4 * g4 + j;
          float x1 = v0[i], x2 = v0[i + 8]; v0[i] = x1 * c0[j] - x2 * s0[j]; v0[i + 8] = x2 * c0[j] + x1 * s0[j];
          x1 = v1[i]; x2 = v1[i + 8]; v1[i] = x1 * c1[j] - x2 * s1[j]; v1[i + 8] = x2 * c1[j] + x1 * s1[j]; }
      }
    }
  }
#pragma unroll
  for (int g4 = 0; g4 < 4; ++g4) {
    u32x2 w0, w1; w0.x = cvtpk(v0[4 * g4], v0[4 * g4 + 1]); w0.y = cvtpk(v0[4 * g4 + 2], v0[4 * g4 + 3]);
    w1.x = cvtpk(v1[4 * g4], v1[4 * g4 + 1]); w1.y = cvtpk(v1[4 * g4 + 2], v1[4 * g4 + 3]);
    *(u32x2*)(stg + r * 128 + ((g4 ^ (r & 7)) << 4) + h * 8) = w0;
    *(u32x2*)(stg + r * 128 + (((4 + g4) ^ (r & 7)) << 4) + h * 8) = w1;
  }
#pragma unroll
  for (int j = 0; j < 4; ++j) {
    const int row = (lane >> 3) + 8 * j, ch = lane & 7;
    const u32x4 w = *(const u32x4*)(stg + row * 128 + ((ch ^ (row & 7)) << 4));
    *(u32x4*)(obase + (size_t)row * ldo + ch * 8) = w;
  }
}

DI int in_mode(const Params& p, int layer, int n_h, const float*& gain) {
  int mode = 0; gain = p.mem_qk_g;
  if ((layer & 1) == 0) { const int e = layer >> 1;
    if (n_h >= 1536 && n_h < 2048) { mode = 2; gain = p.swa_qk_g + (e * 2) * 64; }
    else if (n_h >= 2048 && n_h < 2176) { mode = 2; gain = p.swa_qk_g + (e * 2 + 1) * 64; }
    else if (n_h >= 2304 && n_h < 2560) { mode = 1; gain = p.mem_qk_g + (layer * 2) * 64; }
  } else { const int o = layer >> 1;
    if (n_h < 512) { mode = 3; gain = p.ax_qk_g + (o * 2) * 64; }
    else if (n_h < 640) { mode = 3; gain = p.ax_qk_g + (o * 2 + 1) * 64; }
    else if (n_h >= 768 && n_h < 1280) { mode = 2; gain = p.diff_qk_g + (o * 2) * 64; }
    else if (n_h >= 1280 && n_h < 1792) { mode = 2; gain = p.diff_qk_g + (o * 2 + 1) * 64; }
    else if (n_h >= 2304 && n_h < 2560) { mode = 1; gain = p.mem_qk_g + (layer * 2) * 64; }
  }
  return mode;
}

template <int EPI>
DI void gemm_phase(char* lds, const Params& p, const GemmDesc g, int layer) {
  const int tid = ltid(), lane = tid & 63, wid = tid >> 6, wm = wid >> 1, wn = wid & 1, r = lane & 31, h = lane >> 5;
  const int srow = tid >> 3, sch = tid & 7;
  const int soff = srow * 128 + ((sch ^ ((srow >> 1) & 7)) << 4);
  const int nk = g.K >> 6;
  const int ntile = g.mtiles * g.ntiles;
  const bool banded = ((gridDim.x & 7) == 0) && ((g.mtiles & 63) == 0);
  const int nx = banded ? 8 : 1, bx = blockIdx.x % nx, bi = blockIdx.x / nx, nbx = gridDim.x / nx;
  const int per_band = 8 * g.ntiles;
  const int qtot = ntile / nx;
  int q = bi;
  if (q >= qtot) return;
  int mt, nt;
#define G_TILE(qq, MT, NT) do { if (banded) { const int bl_ = (qq) / per_band, rem_ = (qq) - bl_ * per_band; NT = rem_ >> 3; MT = (bl_ * 8 + bx) * 8 + (rem_ & 7); } \
    else { MT = (qq) / g.ntiles; NT = (qq) - MT * g.ntiles; } } while (0)
#define G_LOAD(AG, BG, kt, RA, RB) do { const int k0_ = (kt) * 64; int ac_ = k0_; if (g.remap) ac_ = k0_ < 512 ? k0_ : (k0_ < 1024 ? g.seg2 + k0_ - 512 : 2304 + k0_ - 1024); \
    _Pragma("unroll") for (int i = 0; i < 4; ++i) { RA[i] = *(const u32x4*)(AG + (size_t)(64 * i) * g.lda + ac_); RB[i] = *(const u32x4*)(BG + (size_t)(64 * i) * g.K + k0_); } } while (0)
#define G_WRITE(buf, RA, RB) do { _Pragma("unroll") for (int i = 0; i < 4; ++i) { *(u32x4*)(lds + (buf) * 65536 + i * 8192 + soff) = RA[i]; *(u32x4*)(lds + (buf) * 65536 + 32768 + i * 8192 + soff) = RB[i]; } } while (0)
#define G_COMPUTE(buf) do { _Pragma("unroll") for (int ks = 0; ks < 4; ++ks) { const int co_ = ((2 * ks + h) ^ ((r >> 1) & 7)) << 4; \
      const char* la_ = lds + (buf) * 65536 + (wm * 64 + r) * 128 + co_; const char* lb_ = lds + (buf) * 65536 + 32768 + (wn * 128 + r) * 128 + co_; \
      bf16x8 fa_[2], fb_[4]; fa_[0] = *(const bf16x8*)(la_); fa_[1] = *(const bf16x8*)(la_ + 4096); \
      _Pragma("unroll") for (int ni = 0; ni < 4; ++ni) fb_[ni] = *(const bf16x8*)(lb_ + ni * 4096); \
      _Pragma("unroll") for (int ni = 0; ni < 4; ++ni) { acc[0][ni] = MFMA32(fb_[ni], fa_[0], acc[0][ni]); acc[1][ni] = MFMA32(fb_[ni], fa_[1], acc[1][ni]); } } } while (0)
  G_TILE(q, mt, nt);
  const bf16_t* Ag = g.A + (size_t)(mt * 256 + srow) * g.lda + sch * 8;
  const bf16_t* Bg = g.Bt + (size_t)(nt * 256 + srow) * g.K + sch * 8;
  u32x4 ra0[4], rb0[4];
  G_LOAD(Ag, Bg, 0, ra0, rb0); G_WRITE(0, ra0, rb0); G_LOAD(Ag, Bg, 1, ra0, rb0); __syncthreads();
  for (;;) {
    const int qn = q + nbx; const bool has_next = qn < qtot;
    int mtn = mt, ntn = nt; if (has_next) G_TILE(qn, mtn, ntn);
    const bf16_t* Agn = g.A + (size_t)(mtn * 256 + srow) * g.lda + sch * 8;
    const bf16_t* Bgn = g.Bt + (size_t)(ntn * 256 + srow) * g.K + sch * 8;
    f32x16 acc[2][4];
#pragma unroll
    for (int a = 0; a < 2; ++a)
#pragma unroll
      for (int b = 0; b < 4; ++b)
#pragma unroll
        for (int i = 0; i < 16; ++i) acc[a][b][i] = 0.f;
    for (int kt = 0; kt < nk; kt += 2) {
      const bool last = kt + 2 >= nk;
      G_WRITE(1, ra0, rb0);
      if (!last) G_LOAD(Ag, Bg, kt + 2, ra0, rb0); else if (has_next) G_LOAD(Agn, Bgn, 0, ra0, rb0);
      G_COMPUTE(0);
      __syncthreads();
      if (!last || has_next) G_WRITE(0, ra0, rb0);
      if (!last) G_LOAD(Ag, Bg, kt + 3, ra0, rb0); else if (has_next) G_LOAD(Agn, Bgn, 1, ra0, rb0);
      G_COMPUTE(1);
      __syncthreads();
    }
    const int n_w = nt * 256 + wn * 128;
    if (EPI == EPI_IN) {
#pragma unroll
      for (int hu = 0; hu < 2; ++hu) {
        const int n_h = n_w + 64 * hu; const float* gain; const int mode = in_mode(p, layer, n_h, gain);
#pragma unroll
        for (int mi = 0; mi < 2; ++mi) {
          const int t = mt * 256 + wm * 64 + mi * 32 + r;
          int S, seq0, pos, sq; tok_info(t, S, seq0, pos, sq);
          const float rs = rsqrtf(p.rstd[(layer & 1) * NTOK + t] * (1.f / DM) + EPSF);
          head_store(acc[mi][2 * hu], acc[mi][2 * hu + 1], rs, mode, gain, p, pos, p.u + (size_t)(t - r) * UW + n_h, UW, lds + 131072);
        }
      }
    } else if (EPI == EPI_MEM) {
#pragma unroll
      for (int hu = 0; hu < 2; ++hu) {
        const int n_h = n_w + 64 * hu, l = n_h >> 9, c = n_h & 511;
        const int mode = c < 256 ? 1 : 0; const float* gain = p.mem_qk_g + (l * 2 + 1) * 64;
#pragma unroll
        for (int mi = 0; mi < 2; ++mi) {
          const int row = mt * 256 + wm * 64 + mi * 32 + r;
          head_store(acc[mi][2 * hu], acc[mi][2 * hu + 1], 1.f, mode, gain, p, 0, p.memkv + (size_t)(row - r) * 2048 + n_h, 2048, lds + 131072);
        }
      }
    } else {
      const int tid_ = ltid(), lane = tid_ & 63, r = lane & 31, h = lane >> 5;
      char* stg = lds + 131072 + (tid_ >> 6) * 4096;
#pragma unroll
      for (int mi = 0; mi < 2; ++mi) {
        const int t0 = mt * 256 + wm * 64 + mi * 32;
        const float* xin0 = layer == 0 ? (t0 < NTOKP ? p.xp + (size_t)t0 * DM : p.xs + (size_t)(t0 - NTOKP) * DM) : p.out + (size_t)t0 * DM;
        float* xo0 = p.out + (size_t)t0 * DM;
        bf16_t* xb0 = p.xb + (size_t)t0 * DM;
        float ssj[4] = {0.f, 0.f, 0.f, 0.f};
#pragma unroll
        for (int ni = 0; ni < 4; ++ni) {
#pragma unroll
          for (int g4 = 0; g4 < 4; ++g4) {
            f32x4 v; v[0] = acc[mi][ni][4 * g4]; v[1] = acc[mi][ni][4 * g4 + 1]; v[2] = acc[mi][ni][4 * g4 + 2]; v[3] = acc[mi][ni][4 * g4 + 3];
            *(f32x4*)(stg + r * 128 + (((2 * g4 + h) ^ (r & 7)) << 4)) = v;
          }
#pragma unroll
          for (int j = 0; j < 4; ++j) {
            const int row = (lane >> 3) + 8 * j, ch = lane & 7;
            const f32x4 a = *(const f32x4*)(stg + row * 128 + ((ch ^ (row & 7)) << 4));
            const size_t off = (size_t)row * DM + n_w + ni * 32 + ch * 4;
            f32x4 xv = *(const f32x4*)(xin0 + off);
            xv += a;
            *(f32x4*)(xo0 + off) = xv;
            if (layer < 3) {
              u32x2 w; w.x = cvtpk(xv[0], xv[1]); w.y = cvtpk(xv[2], xv[3]);
              *(u32x2*)(xb0 + off) = w;
              ssj[j] += xv[0] * xv[0] + xv[1] * xv[1] + xv[2] * xv[2] + xv[3] * xv[3];
            }
          }
        }
        if (layer < 3) {
#pragma unroll
          for (int j = 0; j < 4; ++j) {
            float v = ssj[j];
            v += shx(v, lane, 1); v += shx(v, lane, 2); v += shx(v, lane, 4);
            if ((lane & 7) == 0) atomicAdd(p.rstd + ((layer + 1) & 1) * NTOK + t0 + (lane >> 3) + 8 * j, v);
          }
        }
      }
    }
    if (!has_next) break;
    q = qn; mt = mtn; nt = ntn; Ag = Agn; Bg = Bgn;
  }
#undef G_TILE
#undef G_LOAD
#undef G_WRITE
#undef G_COMPUTE
}

enum { AM_PLAIN = 0, AM_SWA = 1, AM_DIFF = 2 };
struct AttnJob {
  const bf16_t* q;
  const bf16_t* k[2];
  const bf16_t* v;
  int ldk, ldv;
  int tile_lo, tile_hi;
  float m_init, l_init;
  int qpos0;
  bf16_t* o;
  const bf16_t* z;
  float lam, oscale;
  const float* subg;
  int dry;
};

template <int DV, int MODE>
DI void attn_finalize(char* lds, const AttnJob& J, f32x16 (&O)[DV / 32], const float lt, const int wid, const int r, const int h) {
  constexpr int NDV = DV / 32;
  const float inv = 1.f / lt;
  if (MODE != AM_DIFF) {
    bf16_t* orow = J.o + (size_t)r * UW; const bf16_t* zrow = J.z + (size_t)r * UW;
#pragma unroll
    for (int d = 0; d < NDV; ++d)
#pragma unroll
      for (int g4 = 0; g4 < 4; ++g4) {
        const int dv = 32 * d + 8 * g4 + 4 * h;
        const u32x2 zw = *(const u32x2*)(zrow + dv);
        const float y0 = O[d][4 * g4] * inv * silu(bflo(zw.x)), y1 = O[d][4 * g4 + 1] * inv * silu(bfhi(zw.x));
        const float y2 = O[d][4 * g4 + 2] * inv * silu(bflo(zw.y)), y3 = O[d][4 * g4 + 3] * inv * silu(bfhi(zw.y));
        u32x2 w; w.x = cvtpk(y0, y1); w.y = cvtpk(y2, y3);
        *(u32x2*)(orow + dv) = w;
      }
  } else {
    float* sc = (float*)(lds + 32768) + (wid >> 1) * (DV * 32);
    if (wid & 1) {
      const float f = inv * J.lam;
#pragma unroll
      for (int d = 0; d < NDV; ++d)
#pragma unroll
        for (int i = 0; i < 16; ++i) sc[(32 * d + crow(i, h)) * 32 + r] = O[d][i] * f;
    }
    __syncthreads();
    if (!(wid & 1)) {
      float ss = 0.f;
#pragma unroll
      for (int d = 0; d < NDV; ++d)
#pragma unroll
        for (int i = 0; i < 16; ++i) { const float a = O[d][i] * inv - sc[(32 * d + crow(i, h)) * 32 + r]; O[d][i] = a; ss += a * a; }
      ss = swapsum(ss);
      const float rn = rsqrtf(ss * (1.f / DV) + EPSF) * J.oscale;
      bf16_t* orow = J.o + (size_t)r * UW; const bf16_t* zrow = J.z + (size_t)r * UW;
#pragma unroll
      for (int d = 0; d < NDV; ++d)
#pragma unroll
        for (int g4 = 0; g4 < 4; ++g4) {
          const int dv = 32 * d + 8 * g4 + 4 * h;
          const u32x2 zw = *(const u32x2*)(zrow + dv);
          const f32x4 sg = *(const f32x4*)(J.subg + dv);
          const float y0 = O[d][4 * g4] * rn * sg[0] * silu(bflo(zw.x)), y1 = O[d][4 * g4 + 1] * rn * sg[1] * silu(bfhi(zw.x));
          const float y2 = O[d][4 * g4 + 2] * rn * sg[2] * silu(bflo(zw.y)), y3 = O[d][4 * g4 + 3] * rn * sg[3] * silu(bfhi(zw.y));
          u32x2 w; w.x = cvtpk(y0, y1); w.y = cvtpk(y2, y3);
          *(u32x2*)(orow + dv) = w;
        }
    }
  }
}

template <int DV, int NK, int MODE, bool FIXM, int GRP>
DI void attn_job(char* lds_wg, const AttnJob& J) {
  constexpr int NDV = DV / 32;
  constexpr float C = 0.125f * LOG2E;
  const int tid_wg = ltid(), tid = tid_wg & (AT - 1), lane = tid & 63, wid = tid >> 6, r = lane & 31, h = lane >> 5;
  char* lds = lds_wg + GRP * 65536;
  const int kstream = (NK == 2) ? (wid & 1) : 0;
  bf16x8 qf[4];
  const bf16_t* qrow = J.q + (size_t)r * UW + 8 * h;
#pragma unroll
  for (int ds = 0; ds < 4; ++ds) qf[ds] = *(const bf16x8*)(qrow + 16 * ds);
  f32x16 O[NDV];
#pragma unroll
  for (int d = 0; d < NDV; ++d)
#pragma unroll
    for (int i = 0; i < 16; ++i) O[d][i] = 0.f;
  float m = J.m_init, l = (h == 0) ? J.l_init : 0.f;
  f32x16 Osum;
#pragma unroll
  for (int i = 0; i < 16; ++i) Osum[i] = 0.f;
  const bf16x8 ones = {0x3F80, 0x3F80, 0x3F80, 0x3F80, 0x3F80, 0x3F80, 0x3F80, 0x3F80};
  const int ksrow = tid >> 3, ksch = tid & 7;
  const int kpi = (ksrow & ~12) | ((ksrow & 4) << 1) | ((ksrow & 8) >> 1);
  const int ksoff = kpi * 128 + ((ksch ^ ((kpi >> 1) & 7)) << 4);
  constexpr int VCH = DV / 8;
  constexpr int VI = (64 * VCH) / AT;
  const int vkey0 = tid / VCH, vc8 = (tid % VCH) * 8;
  u32x4 rk0[NK][2], rv0[VI], rk1[NK][2], rv1[VI];
#define A_LOAD(t, rk, rv) do { const size_t kb_ = (size_t)(t) * 64; \
    _Pragma("unroll") for (int s = 0; s < NK; ++s) _Pragma("unroll") for (int i = 0; i < 2; ++i) rk[s][i] = *(const u32x4*)(J.k[s] + (kb_ + ksrow + 32 * i) * J.ldk + ksch * 8); \
    _Pragma("unroll") for (int i = 0; i < VI; ++i) rv[i] = *(const u32x4*)(J.v + (kb_ + vkey0 + (AT / VCH) * i) * J.ldv + vc8); } while (0)
#define A_WRITE(st, rk, rv) do { char* b_ = lds + (st) * 32768; \
    _Pragma("unroll") for (int s = 0; s < NK; ++s) _Pragma("unroll") for (int i = 0; i < 2; ++i) *(u32x4*)(b_ + s * 8192 + i * 4096 + ksoff) = rk[s][i]; \
    _Pragma("unroll") for (int i = 0; i < VI; ++i) { const int key_ = vkey0 + (AT / VCH) * i; \
      *(u32x4*)(b_ + NK * 8192 + ((key_ >> 3) * NDV + (vc8 >> 5)) * 512 + (key_ & 7) * 64 + (vc8 & 31) * 2) = rv[i]; } } while (0)
  const int nt = J.tile_hi - J.tile_lo;
  constexpr bool DEEP2 = FIXM || MODE != AM_DIFF;
  constexpr bool ONESET = FIXM;
  A_LOAD(J.tile_lo, rk0, rv0); A_WRITE(0, rk0, rv0); if (ONESET) A_LOAD(J.tile_lo + 1, rk0, rv0); else if (DEEP2) A_LOAD(J.tile_lo + 1, rk1, rv1); __syncthreads();
  const int i16 = lane & 15;
  const int vrd = h * NDV * 512 + (i16 >> 2) * 64 + (((lane >> 4) & 1) * 16 + (i16 & 3) * 4) * 2;
  auto compute = [&](const int stage, const int tile) __attribute__((always_inline)) {
    bool active = true;
    if (MODE == AM_SWA) { const int k0 = tile * 64; active = !(k0 > J.qpos0 + 31 + 128 || k0 + 63 < J.qpos0 - 128); }
    if (active) {
      const char* Kl = lds + stage * 32768 + kstream * 8192 + r * 128;
      f32x16 sA, sB;
#pragma unroll
      for (int i = 0; i < 16; ++i) { sA[i] = 0.f; sB[i] = 0.f; }
      if (NDV == 2 || FIXM) {
        bf16x8 ka[4], kb[4];
#pragma unroll
        for (int ds = 0; ds < 4; ++ds) { const int co = ((2 * ds + h) ^ ((r >> 1) & 7)) << 4; ka[ds] = *(const bf16x8*)(Kl + co); kb[ds] = *(const bf16x8*)(Kl + 4096 + co); }
#pragma unroll
        for (int ds = 0; ds < 4; ++ds) { sA = MFMA32(ka[ds], qf[ds], sA); sB = MFMA32(kb[ds], qf[ds], sB); }
        __builtin_amdgcn_sched_group_barrier(0x100, 4, 0); __builtin_amdgcn_sched_group_barrier(0x008, 2, 0);
        __builtin_amdgcn_sched_group_barrier(0x100, 2, 0); __builtin_amdgcn_sched_group_barrier(0x008, 2, 0);
        __builtin_amdgcn_sched_group_barrier(0x100, 2, 0); __builtin_amdgcn_sched_group_barrier(0x008, 4, 0);
      } else {
#pragma unroll
        for (int ds = 0; ds < 4; ++ds) {
          const int co = ((2 * ds + h) ^ ((r >> 1) & 7)) << 4;
          const bf16x8 ka = *(const bf16x8*)(Kl + co), kb = *(const bf16x8*)(Kl + 4096 + co);
          sA = MFMA32(ka, qf[ds], sA); sB = MFMA32(kb, qf[ds], sB);
        }
      }
      if (MODE == AM_SWA) {
        const int qa = J.qpos0 + r, kbase = tile * 64 + 8 * h;
#pragma unroll
        for (int i = 0; i < 16; ++i) {
          const int ka_ = kbase + 16 * (i >> 3) + (i & 7);
          int d0 = qa - ka_; d0 = d0 < 0 ? -d0 : d0; if (d0 > 128) sA[i] = -INFINITY;
          int d1 = qa - (ka_ + 32); d1 = d1 < 0 ? -d1 : d1; if (d1 > 128) sB[i] = -INFINITY;
        }
      }
      if (FIXM) {
        const float nm = -J.m_init;
#pragma unroll
        for (int i = 0; i < 16; ++i) { sA[i] = __builtin_amdgcn_exp2f(fmaf(sA[i], C, nm)); sB[i] = __builtin_amdgcn_exp2f(fmaf(sB[i], C, nm)); l += sA[i] + sB[i]; }
      } else {
      float mx = sA[0];
#pragma unroll
      for (int i = 1; i < 16; ++i) mx = fmaxf(mx, sA[i]);
#pragma unroll
      for (int i = 0; i < 16; ++i) mx = fmaxf(mx, sB[i]);
      mx = swapmax(mx);
      const float mn = fmaxf(m, mx * C);
      const float alpha = __builtin_amdgcn_exp2f(m - mn);
      m = mn;
      float ps = 0.f;
#pragma unroll
      for (int i = 0; i < 16; ++i) { sA[i] = __builtin_amdgcn_exp2f(fmaf(sA[i], C, -mn)); sB[i] = __builtin_amdgcn_exp2f(fmaf(sB[i], C, -mn)); ps += sA[i] + sB[i]; }
      l = l * alpha + ps;
#pragma unroll
      for (int d = 0; d < NDV; ++d)
#pragma unroll
        for (int i = 0; i < 16; ++i) O[d][i] *= alpha;
      }
      bf16x8 pf[4];
      { u32x4 w;
        w.x = cvtpk(sA[0], sA[1]); w.y = cvtpk(sA[2], sA[3]); w.z = cvtpk(sA[4], sA[5]); w.w = cvtpk(sA[6], sA[7]); pf[0] = __builtin_bit_cast(bf16x8, w);
        w.x = cvtpk(sA[8], sA[9]); w.y = cvtpk(sA[10], sA[11]); w.z = cvtpk(sA[12], sA[13]); w.w = cvtpk(sA[14], sA[15]); pf[1] = __builtin_bit_cast(bf16x8, w);
        w.x = cvtpk(sB[0], sB[1]); w.y = cvtpk(sB[2], sB[3]); w.z = cvtpk(sB[4], sB[5]); w.w = cvtpk(sB[6], sB[7]); pf[2] = __builtin_bit_cast(bf16x8, w);
        w.x = cvtpk(sB[8], sB[9]); w.y = cvtpk(sB[10], sB[11]); w.z = cvtpk(sB[12], sB[13]); w.w = cvtpk(sB[14], sB[15]); pf[3] = __builtin_bit_cast(bf16x8, w); }
      const char* Vl = lds + stage * 32768 + NK * 8192 + vrd;
      if (FIXM) {
        bf16x8 vf[4][NDV];
#pragma unroll
        for (int ks = 0; ks < 4; ++ks) {
#pragma unroll
          for (int d = 0; d < NDV; ++d) {
            const s16x4 lo = __builtin_amdgcn_ds_read_tr16_b64_v4i16((LAS s16x4*)(Vl + ks * 2 * NDV * 512 + d * 512));
            const s16x4 hi = __builtin_amdgcn_ds_read_tr16_b64_v4i16((LAS s16x4*)(Vl + ks * 2 * NDV * 512 + d * 512 + 256));
            vf[ks][d] = __builtin_shufflevector(lo, hi, 0, 1, 2, 3, 4, 5, 6, 7);
          }
        }
#pragma unroll
        for (int ks = 0; ks < 4; ++ks) {
#pragma unroll
          for (int d = 0; d < NDV; ++d) O[d] = MFMA32(vf[ks][d], pf[ks], O[d]);
        }
        __builtin_amdgcn_sched_group_barrier(0x100, 4 * NDV, 0); __builtin_amdgcn_sched_group_barrier(0x008, NDV, 0);
        __builtin_amdgcn_sched_group_barrier(0x100, 2 * NDV, 0); __builtin_amdgcn_sched_group_barrier(0x008, NDV, 0);
        __builtin_amdgcn_sched_group_barrier(0x100, 2 * NDV, 0); __builtin_amdgcn_sched_group_barrier(0x008, 2 * NDV, 0);
      } else {
      if (FIXM) {
#pragma unroll
        for (int ks = 0; ks < 4; ++ks) Osum = MFMA32(ones, pf[ks], Osum);
      }
#pragma unroll
      for (int ks = 0; ks < 4; ++ks)
#pragma unroll
        for (int d = 0; d < NDV; ++d) {
          const s16x4 lo = __builtin_amdgcn_ds_read_tr16_b64_v4i16((LAS s16x4*)(Vl + ks * 2 * NDV * 512 + d * 512));
          const s16x4 hi = __builtin_amdgcn_ds_read_tr16_b64_v4i16((LAS s16x4*)(Vl + ks * 2 * NDV * 512 + d * 512 + 256));
          const bf16x8 vf = __builtin_shufflevector(lo, hi, 0, 1, 2, 3, 4, 5, 6, 7);
          O[d] = MFMA32(vf, pf[ks], O[d]);
        }
      }
    }
  };
  for (int it = 0; it < nt; it += 2) {
    if (ONESET) {
      A_WRITE(1, rk0, rv0);
      if (it + 2 < nt) A_LOAD(J.tile_lo + it + 2, rk0, rv0);
      compute(0, J.tile_lo + it);
      __syncthreads();
      if (it + 2 < nt) A_WRITE(0, rk0, rv0);
      if (it + 3 < nt) A_LOAD(J.tile_lo + it + 3, rk0, rv0);
      compute(1, J.tile_lo + it + 1);
      __syncthreads();
    } else if (DEEP2) {
      if (it + 2 < nt) A_LOAD(J.tile_lo + it + 2, rk0, rv0);
      compute(0, J.tile_lo + it);
      A_WRITE(1, rk1, rv1);
      __syncthreads();
      if (it + 3 < nt) A_LOAD(J.tile_lo + it + 3, rk1, rv1);
      compute(1, J.tile_lo + it + 1);
      if (it + 2 < nt) A_WRITE(0, rk0, rv0);
      __syncthreads();
    } else {
      compute(0, J.tile_lo + it);
      __builtin_amdgcn_sched_barrier(0);
      A_LOAD(J.tile_lo + it + 1, rk0, rv0); A_WRITE(1, rk0, rv0);
      __syncthreads();
      compute(1, J.tile_lo + it + 1);
      __builtin_amdgcn_sched_barrier(0);
      if (it + 2 < nt) { A_LOAD(J.tile_lo + it + 2, rk0, rv0); A_WRITE(0, rk0, rv0); }
      __syncthreads();
    }
  }
#undef A_LOAD
#undef A_WRITE
  if (J.dry) return;
  const float lt = swapsum(l);
  attn_finalize<DV, MODE>(lds, J, O, lt, wid, r, h);
}

template <int DV, int NK, int MODE, int GRP>
DI void attn_pipe(char* lds_wg, const AttnJob& J) {
  constexpr int NDV = DV / 32;
  constexpr float C = 0.125f * LOG2E;
  constexpr int KST = NK * 8192, VST = DV * 128, VB = 2 * KST;
  const int tid_wg = ltid(), tid = tid_wg & (AT - 1), lane = tid & 63, wid = tid >> 6, r = lane & 31, h = lane >> 5;
  char* lds = lds_wg + GRP * 65536;
  const int kstream = (NK == 2) ? (wid & 1) : 0;
  bf16x8 qf[4];
  const bf16_t* qrow = J.q + (size_t)r * UW + 8 * h;
#pragma unroll
  for (int ds = 0; ds < 4; ++ds) qf[ds] = *(const bf16x8*)(qrow + 16 * ds);
  f32x16 O[NDV], Osum;
#pragma unroll
  for (int d = 0; d < NDV; ++d)
#pragma unroll
    for (int i = 0; i < 16; ++i) O[d][i] = 0.f;
#pragma unroll
  for (int i = 0; i < 16; ++i) Osum[i] = 0.f;
  const bf16x8 ones = {0x3F80, 0x3F80, 0x3F80, 0x3F80, 0x3F80, 0x3F80, 0x3F80, 0x3F80};
  const float nm = -J.m_init;
  const int ksrow = tid >> 3, ksch = tid & 7;
  const int kpi = (ksrow & ~12) | ((ksrow & 4) << 1) | ((ksrow & 8) >> 1);
  const int ksoff = kpi * 128 + ((ksch ^ ((kpi >> 1) & 7)) << 4);
  constexpr int VCH = DV / 8, VI = (64 * VCH) / AT;
  const int vkey0 = tid / VCH, vc8 = (tid % VCH) * 8;
  u32x4 rk0[NK][2], rv0[VI], rk1[NK][2], rv1[VI];
#define K_LOAD(t, rk) do { const size_t kb_ = (size_t)(t) * 64; \
    _Pragma("unroll") for (int s = 0; s < NK; ++s) _Pragma("unroll") for (int i = 0; i < 2; ++i) rk[s][i] = *(const u32x4*)(J.k[s] + (kb_ + ksrow + 32 * i) * J.ldk + ksch * 8); } while (0)
#define V_LOAD(t, rv) do { const size_t kb_ = (size_t)(t) * 64; \
    _Pragma("unroll") for (int i = 0; i < VI; ++i) rv[i] = *(const u32x4*)(J.v + (kb_ + vkey0 + (AT / VCH) * i) * J.ldv + vc8); } while (0)
#define K_WRITE(st, rk) do { char* b_ = lds + (st) * KST; \
    _Pragma("unroll") for (int s = 0; s < NK; ++s) _Pragma("unroll") for (int i = 0; i < 2; ++i) *(u32x4*)(b_ + s * 8192 + i * 4096 + ksoff) = rk[s][i]; } while (0)
#define V_WRITE(st, rv) do { char* b_ = lds + VB + (st) * VST; \
    _Pragma("unroll") for (int i = 0; i < VI; ++i) { const int key_ = vkey0 + (AT / VCH) * i; \
      *(u32x4*)(b_ + ((key_ >> 3) * NDV + (vc8 >> 5)) * 512 + (key_ & 7) * 64 + (vc8 & 31) * 2) = rv[i]; } } while (0)
  const int nt = J.tile_hi - J.tile_lo, t0 = J.tile_lo;
  const int i16 = lane & 15;
  const int vrd = h * NDV * 512 + (i16 >> 2) * 64 + (((lane >> 4) & 1) * 16 + (i16 & 3) * 4) * 2;
  auto qk = [&](const int kst, f32x16& sA, f32x16& sB) __attribute__((always_inline)) {
    const char* Kl = lds + kst * KST + kstream * 8192 + r * 128;
#pragma unroll
    for (int i = 0; i < 16; ++i) { sA[i] = 0.f; sB[i] = 0.f; }
    bf16x8 ka[4], kb[4];
#pragma unroll
    for (int ds = 0; ds < 4; ++ds) { const int co = ((2 * ds + h) ^ ((r >> 1) & 7)) << 4; ka[ds] = *(const bf16x8*)(Kl + co); kb[ds] = *(const bf16x8*)(Kl + 4096 + co); }
    __builtin_amdgcn_sched_barrier(0);
#pragma unroll
    for (int ds = 0; ds < 4; ++ds) { sA = MFMA32(ka[ds], qf[ds], sA); sB = MFMA32(kb[ds], qf[ds], sB); }
  };
  auto smpv = [&](const int vst, f32x16& sA, f32x16& sB) __attribute__((always_inline)) {
    const char* Vl = lds + VB + vst * VST + vrd;
    bf16x8 vf[4][NDV];
#pragma unroll
    for (int ks = 0; ks < 4; ++ks)
#pragma unroll
      for (int d = 0; d < NDV; ++d) {
        const s16x4 lo = __builtin_amdgcn_ds_read_tr16_b64_v4i16((LAS s16x4*)(Vl + ks * 2 * NDV * 512 + d * 512));
        const s16x4 hi = __builtin_amdgcn_ds_read_tr16_b64_v4i16((LAS s16x4*)(Vl + ks * 2 * NDV * 512 + d * 512 + 256));
        vf[ks][d] = __builtin_shufflevector(lo, hi, 0, 1, 2, 3, 4, 5, 6, 7);
      }
    __builtin_amdgcn_sched_barrier(0);
#pragma unroll
    for (int i = 0; i < 16; ++i) { sA[i] = __builtin_amdgcn_exp2f(fmaf(sA[i], C, nm)); sB[i] = __builtin_amdgcn_exp2f(fmaf(sB[i], C, nm)); }
    bf16x8 pf[4];
    { u32x4 w;
      w.x = cvtpk(sA[0], sA[1]); w.y = cvtpk(sA[2], sA[3]); w.z = cvtpk(sA[4], sA[5]); w.w = cvtpk(sA[6], sA[7]); pf[0] = __builtin_bit_cast(bf16x8, w);
      w.x = cvtpk(sA[8], sA[9]); w.y = cvtpk(sA[10], sA[11]); w.z = cvtpk(sA[12], sA[13]); w.w = cvtpk(sA[14], sA[15]); pf[1] = __builtin_bit_cast(bf16x8, w);
      w.x = cvtpk(sB[0], sB[1]); w.y = cvtpk(sB[2], sB[3]); w.z = cvtpk(sB[4], sB[5]); w.w = cvtpk(sB[6], sB[7]); pf[2] = __builtin_bit_cast(bf16x8, w);
      w.x = cvtpk(sB[8], sB[9]); w.y = cvtpk(sB[10], sB[11]); w.z = cvtpk(sB[12], sB[13]); w.w = cvtpk(sB[14], sB[15]); pf[3] = __builtin_bit_cast(bf16x8, w); }
#pragma unroll
    for (int ks = 0; ks < 4; ++ks) Osum = MFMA32(ones, pf[ks], Osum);
#pragma unroll
    for (int ks = 0; ks < 4; ++ks)
#pragma unroll
      for (int d = 0; d < NDV; ++d) O[d] = MFMA32(vf[ks][d], pf[ks], O[d]);
  };
  K_LOAD(t0, rk0); V_LOAD(t0, rv0); K_LOAD(t0 + 1, rk1);
  K_WRITE(0, rk0); V_WRITE(0, rv0); K_WRITE(1, rk1);
  if (2 < nt) K_LOAD(t0 + 2, rk0);
  V_LOAD(t0 + 1, rv0);
  __syncthreads();
  f32x16 eA, eB, oA, oB;
  qk(0, eA, eB);
  __syncthreads();
  for (int j = 0; j < nt; j += 2) {
    if (j + 3 < nt) K_LOAD(t0 + j + 3, rk1);
    if (j + 2 < nt) V_LOAD(t0 + j + 2, rv1);
    qk(1, oA, oB);
    __builtin_amdgcn_sched_barrier(0);
    smpv(0, eA, eB);
    if (j + 2 < nt) K_WRITE(0, rk0);
    V_WRITE(1, rv0);
    __syncthreads();
    if (j + 4 < nt) K_LOAD(t0 + j + 4, rk0);
    if (j + 3 < nt) V_LOAD(t0 + j + 3, rv0);
    if (j + 2 < nt) qk(0, eA, eB);
    __builtin_amdgcn_sched_barrier(0);
    smpv(1, oA, oB);
    if (j + 3 < nt) K_WRITE(1, rk1);
    if (j + 2 < nt) V_WRITE(0, rv1);
    __syncthreads();
  }
#undef K_LOAD
#undef V_LOAD
#undef K_WRITE
#undef V_WRITE
  if (J.dry) return;
  attn_finalize<DV, MODE>(lds, J, O, Osum[0], wid, r, h);
}

#define PIPE_CALL(DV, NK, MODE) do { if (grp) attn_pipe<DV, NK, MODE, 1>(lds, J); else attn_pipe<DV, NK, MODE, 0>(lds, J); } while (0)
#define ATTN_CALL(DV, NK, MODE, FIXM) do { if (grp) attn_job<DV, NK, MODE, FIXM, 1>(lds, J); else attn_job<DV, NK, MODE, FIXM, 0>(lds, J); } while (0)
DI void mem_jobs(char* lds, const Params& p, int layer, int dry) {
  const int grp = __builtin_amdgcn_readfirstlane(ltid() >> 8);
  const int wid = (ltid() >> 6) & 3, vb = blockIdx.x * 2 + grp, vg = gridDim.x * 2;
  for (int job = vb; job < 768 * 4; job += vg) {
    const int qb = job >> 2, hm = job & 3, t0 = qb * 128;
    int S, seq0, pos, sq; tok_info(t0, S, seq0, pos, sq);
    AttnJob J;
    bf16_t* qo = p.u + (size_t)(t0 + 32 * wid) * UW + 2304 + hm * 64;
    J.q = qo; J.o = qo; J.z = p.u + (size_t)(t0 + 32 * wid) * UW + 2560 + 1024 + hm * 64;
    J.k[0] = J.k[1] = p.memkv + (size_t)(sq * 256) * 2048 + layer * 512 + hm * 64; J.v = J.k[0] + 256; J.ldk = J.ldv = 2048;
    J.tile_lo = 0; J.tile_hi = 4; J.m_init = -1e30f; J.l_init = 0.f; J.qpos0 = 0; J.lam = 0.f; J.oscale = 0.f; J.subg = nullptr; J.dry = dry;
    ATTN_CALL(64, 1, AM_PLAIN, false);
  }
}

DI void phase_mix_even(char* lds, const Params& p, int layer, int dry) {
  const int grp = __builtin_amdgcn_readfirstlane(ltid() >> 8);
  const int e = layer >> 1, wid = (ltid() >> 6) & 3, vb = blockIdx.x * 2 + grp, vg = gridDim.x * 2;
  for (int job = vb; job < 768 * 8; job += vg) {
    const int qb = job >> 3, hq = job & 7, kvh = hq >> 2, t0 = qb * 128;
    int S, seq0, pos, sq; tok_info(t0, S, seq0, pos, sq);
    AttnJob J;
    bf16_t* qo = p.u + (size_t)(t0 + 32 * wid) * UW + 1536 + hq * 64;
    J.q = qo; J.o = qo; J.z = p.u + (size_t)(t0 + 32 * wid) * UW + 2560 + 512 + hq * 64;
    J.k[0] = J.k[1] = p.u + (size_t)seq0 * UW + 2048 + kvh * 64; J.v = p.u + (size_t)seq0 * UW + 2176 + kvh * 64; J.ldk = J.ldv = UW;
    const int pt = pos >> 6;
    J.tile_lo = pt - 2 < 0 ? 0 : pt - 2; J.tile_hi = pt + 4 > (S >> 6) ? (S >> 6) : pt + 4;
    J.m_init = p.swa_sink[e * 8 + hq] * LOG2E; J.l_init = 1.f; J.qpos0 = pos + 32 * wid; J.lam = 0.f; J.oscale = 0.f; J.subg = nullptr; J.dry = dry;
    ATTN_CALL(64, 1, AM_SWA, false);
  }
  mem_jobs(lds, p, layer, dry);
  const float* cw = p.conv_w + e * 3 * 512;
  for (int idx = blockIdx.x * NTHREADS + ltid(); idx < NTOK * 64; idx += gridDim.x * NTHREADS) {
    const int t = idx >> 6, c0 = (idx & 63) * 8;
    int S, seq0, pos, sq; tok_info(t, S, seq0, pos, sq);
    bf16_t* ur = p.u + (size_t)t * UW;
    float ic[8], il[8], ir[8];
    { const u32x4 a = *(const u32x4*)(ur + 512 + c0), b = *(const u32x4*)(ur + 1024 + c0);
#pragma unroll
      for (int j = 0; j < 4; ++j) { ic[2 * j] = bflo(a[j]) * bflo(b[j]); ic[2 * j + 1] = bfhi(a[j]) * bfhi(b[j]); } }
    if (pos > 0) { const u32x4 a = *(const u32x4*)(ur - UW + 512 + c0), b = *(const u32x4*)(ur - UW + 1024 + c0);
#pragma unroll
      for (int j = 0; j < 4; ++j) { il[2 * j] = bflo(a[j]) * bflo(b[j]); il[2 * j + 1] = bfhi(a[j]) * bfhi(b[j]); } }
    else {
#pragma unroll
      for (int j = 0; j < 8; ++j) il[j] = 0.f; }
    if (pos < S - 1) { const u32x4 a = *(const u32x4*)(ur + UW + 512 + c0), b = *(const u32x4*)(ur + UW + 1024 + c0);
#pragma unroll
      for (int j = 0; j < 4; ++j) { ir[2 * j] = bflo(a[j]) * bflo(b[j]); ir[2 * j + 1] = bfhi(a[j]) * bfhi(b[j]); } }
    else {
#pragma unroll
      for (int j = 0; j < 8; ++j) ir[j] = 0.f; }
    const u32x4 gbw = *(const u32x4*)(ur + c0), zw = *(const u32x4*)(ur + 2560 + c0);
    float y[8];
#pragma unroll
    for (int j = 0; j < 8; ++j) {
      const float gb = (j & 1) ? bfhi(gbw[j >> 1]) : bflo(gbw[j >> 1]);
      const float z = (j & 1) ? bfhi(zw[j >> 1]) : bflo(zw[j >> 1]);
      const float cv = il[j] * cw[c0 + j] + ic[j] * cw[512 + c0 + j] + ir[j] * cw[1024 + c0 + j];
      y[j] = gb * cv * silu(z);
    }
    u32x4 w; w.x = cvtpk(y[0], y[1]); w.y = cvtpk(y[2], y[3]); w.z = cvtpk(y[4], y[5]); w.w = cvtpk(y[6], y[7]);
    if (!dry) *(u32x4*)(ur + c0) = w;
  }
}

DI void phase_mix_odd(char* lds, const Params& p, int layer, int dry) {
  const int grp = __builtin_amdgcn_readfirstlane(ltid() >> 8);
  const int o = layer >> 1, wid = (ltid() >> 6) & 3;
  const int nx = (gridDim.x & 7) == 0 ? 8 : 1, bx = blockIdx.x % nx, bi = (blockIdx.x / nx) * 2 + grp, nbx = (gridDim.x / nx) * 2;
  const float mb_dense = p.lam[8 + o * 2], mb_diff = p.lam[8 + o * 2 + 1];
  const bool fix_dense = mb_dense < 43.f, fix_diff = mb_diff < 43.f;
#pragma unroll 1
  for (int part = 0; part < 2; ++part) {
    const int gshift = part ? 7 : 8, nv = (16 / nx) << gshift;
#pragma unroll 1
    for (int v = bi; v < nv; v += nbx) {
      const int j = ((bx + nx * (v >> gshift)) << gshift) + (v & ((1 << gshift) - 1));
      int g, qb, kvh, seq0, S;
      if (!part) { g = j & 3; qb = (j >> 2) & 63; kvh = (j >> 8) & 1; seq0 = (j >> 9) * 8192; S = 8192; }
      else { g = j & 3; qb = (j >> 2) & 31; kvh = (j >> 7) & 1; seq0 = NTOKP + (j >> 8) * 4096; S = 4096; }
      const int hq = kvh * 4 + g, t0 = seq0 + qb * 128 + 32 * wid;
      AttnJob J;
      bf16_t* qo = p.u + (size_t)t0 * UW + hq * 64;
      J.q = qo; J.o = qo; J.z = p.u + (size_t)t0 * UW + 2560 + hq * 64;
      J.k[0] = J.k[1] = p.u + (size_t)seq0 * UW + 512 + kvh * 64; J.v = p.u + (size_t)seq0 * UW + 640 + kvh * 64; J.ldk = J.ldv = UW;
      J.tile_lo = 0; J.tile_hi = S >> 6; J.l_init = 0.f; J.qpos0 = 0; J.lam = 0.f; J.oscale = 0.f; J.subg = nullptr; J.dry = dry;
      if (fix_dense) { J.m_init = mb_dense; ATTN_CALL(64, 1, AM_PLAIN, true); }
      else { J.m_init = -1e30f; ATTN_CALL(64, 1, AM_PLAIN, false); }
    }
  }
  const float lam = p.lam[o * 2], osc = p.lam[o * 2 + 1];
#pragma unroll 1
  for (int part = 0; part < 2; ++part) {
    const int gshift = part ? 6 : 7, nv = (32 / nx) << gshift;
#pragma unroll 1
    for (int v = bi; v < nv; v += nbx) {
      const int j = ((bx + nx * (v >> gshift)) << gshift) + (v & ((1 << gshift) - 1));
      int qb, hh, seq0, S;
      if (!part) { qb = j & 127; hh = (j >> 7) & 3; seq0 = (j >> 9) * 8192; S = 8192; }
      else { qb = j & 63; hh = (j >> 6) & 3; seq0 = NTOKP + (j >> 8) * 4096; S = 4096; }
      const int mp = wid & 1, sub = wid >> 1, t0 = seq0 + qb * 64 + sub * 32;
      AttnJob J;
      J.q = p.u + (size_t)t0 * UW + 768 + (2 * hh + mp) * 64;
      J.o = p.u + (size_t)t0 * UW + 768 + hh * 128; J.z = p.u + (size_t)t0 * UW + 2560 + 512 + hh * 128;
      J.k[0] = p.u + (size_t)seq0 * UW + 1280 + (2 * hh) * 64; J.k[1] = J.k[0] + 64; J.v = p.u + (size_t)seq0 * UW + 1792 + hh * 128; J.ldk = J.ldv = UW;
      J.tile_lo = 0; J.tile_hi = S >> 6; J.l_init = 0.f; J.qpos0 = 0; J.lam = lam; J.oscale = osc; J.subg = p.diff_subln_g + o * 128; J.dry = dry;
      if (fix_diff) { J.m_init = mb_diff; ATTN_CALL(128, 2, AM_DIFF, true); }
      else { J.m_init = -1e30f; ATTN_CALL(128, 2, AM_DIFF, false); }
    }
  }
  mem_jobs(lds, p, layer, dry);
}

DI void phase_norm(const Params& p) {
  const int gw = blockIdx.x * 8 + (ltid() >> 6), nw = gridDim.x * 8;
  norm_rows(p.out, p.xb, p.rstd, 0, NTOK, gw, nw);
}

__global__ void __launch_bounds__(NTHREADS, 2) fwd_kernel(Params p) {
  __shared__ __attribute__((aligned(16))) char lds[LDS_BYTES];
  int ph = p.phase_lo;
  if (ph == 0) {
    phase_prep(lds, p);
    ph = 1;
#if !MULTI_LAUNCH
    if (ph < p.phase_hi) cg::this_grid().sync();
#endif
  }
  for (; ph < p.phase_hi; ++ph) {
    {
      const int l = (ph - 1) / 3, s = (ph - 1) - 3 * l;
      if (s == 0) {
        if (l == 0) { GemmDesc g{p.memb, p.wt_mem, DM, DM, 16, 8, 0, 0}; gemm_phase<EPI_MEM>(lds, p, g, 0); }
        GemmDesc g{p.xb, p.wt_in + (size_t)l * UW * DM, DM, DM, NTOK / 256, UW / 256, 0, 0};
        const int nrep = ((p.probe >> 2) & 1) + 1;
#pragma unroll 1
        for (int rep = 0; rep < nrep; ++rep) gemm_phase<EPI_IN>(lds, p, g, l);
      } else if (s == 1) {
        const int nrep = ((l & 1) ? (p.probe & 1) : ((p.probe >> 1) & 1)) + 1;
#pragma unroll 1
        for (int rep = 0; rep < nrep; ++rep) {
          const int dry = rep + 1 < nrep;
          if (rep == 0) {
            float* z = p.rstd + ((l + 1) & 1) * NTOK;
            for (int i = blockIdx.x * NTHREADS + ltid(); i < NTOK; i += gridDim.x * NTHREADS) z[i] = 0.f;
          }
          if (__builtin_amdgcn_readfirstlane(ltid()) >= 256) __builtin_amdgcn_s_setprio(1);
          if (l & 1) phase_mix_odd(lds, p, l, dry); else phase_mix_even(lds, p, l, dry);
          __builtin_amdgcn_s_setprio(0);
        }
      } else if (s == 2) {
        GemmDesc g{p.u, p.wt_out + (size_t)l * DM * MIXW, UW, MIXW, NTOK / 256, DM / 256, 1, (l & 1) ? 768 : 1536};
        gemm_phase<EPI_OUT>(lds, p, g, l);
      }
    }
#if !MULTI_LAUNCH
    if (ph + 1 < p.phase_hi) cg::this_grid().sync();
#endif
  }
}

extern "C" void kernel_launch(void* const* d_in, const int* in_sizes, int n_in, void* d_out, int out_size, void* d_ws, size_t ws_size,
                              hipStream_t stream) {
  static int grid_blocks = 0;
  if (!grid_blocks) {
    int dev = 0, cus = 0, per_cu = 0;
    hipGetDevice(&dev);
    hipDeviceGetAttribute(&cus, hipDeviceAttributeMultiprocessorCount, dev);
    hipOccupancyMaxActiveBlocksPerMultiprocessor(&per_cu, fwd_kernel, NTHREADS, 0);
    if (per_cu > 1) per_cu = 1;
    if (per_cu < 1) per_cu = 1;
    int cap = cus * per_cu; if (cap > 256) cap = 256;
    grid_blocks = 8; while (grid_blocks * 2 <= cap) grid_blocks *= 2;
  }
  Params p{};
  p.xp = (const float*)d_in[0]; p.xs = (const float*)d_in[1]; p.memp = (const float*)d_in[2]; p.mems = (const float*)d_in[3];
  p.norm_g = (const float*)d_in[4]; p.w_in = (const float*)d_in[5]; p.w_out = (const float*)d_in[6]; p.mem_norm_g = (const float*)d_in[7];
  p.w_mem_kv = (const float*)d_in[8]; p.mem_qk_g = (const float*)d_in[9]; p.conv_w = (const float*)d_in[10]; p.swa_qk_g = (const float*)d_in[11];
  p.swa_sink = (const float*)d_in[12]; p.ax_qk_g = (const float*)d_in[13]; p.diff_qk_g = (const float*)d_in[14]; p.diff_lambda = (const float*)d_in[15];
  p.diff_subln_g = (const float*)d_in[16];
  p.out = (float*)d_out;
  char* w = (char*)d_ws; size_t off = 0;
  auto take = [&](size_t bytes) { char* r = w + off; off += (bytes + 255) & ~(size_t)255; return r; };
  p.u = (bf16_t*)take((size_t)NTOK * UW * 2);
  p.xb = (bf16_t*)take((size_t)NTOK * DM * 2);
  p.wt_in = (bf16_t*)take((size_t)4 * UW * DM * 2);
  p.wt_out = (bf16_t*)take((size_t)4 * DM * MIXW * 2);
  p.wt_mem = (bf16_t*)take((size_t)2048 * DM * 2);
  p.memb = (bf16_t*)take((size_t)4096 * DM * 2);
  p.memkv = (bf16_t*)take((size_t)4096 * 2048 * 2);
  p.rstd = (float*)take((size_t)NTOK * 4 * 2);
  p.rstd_mem = (float*)take(4096 * 4);
  p.tab1c = (float*)take(8192 * 32 * 4); p.tab1s = (float*)take(8192 * 32 * 4);
  p.tabac = (float*)take(128 * 16 * 4); p.tabas = (float*)take(128 * 16 * 4);
  p.lam = (float*)take(256);
  if (off > ws_size) { fprintf(stderr, "workspace too small: need %zu have %zu\n", off, ws_size); return; }
#if MULTI_LAUNCH
  for (int ph = 0; ph < NPHASE; ++ph) {
    p.phase_lo = ph; p.phase_hi = ph + 1;
    hipLaunchKernelGGL(fwd_kernel, dim3(grid_blocks), dim3(NTHREADS), 0, stream, p);
  }
#else
  p.phase_lo = 0; p.phase_hi = NPHASE; p.probe = PROBE_ODD | (PROBE_EVEN << 1) | (PROBE_GIN << 2);
  void* args[] = {&p};
  hipError_t e = hipLaunchCooperativeKernel((void*)fwd_kernel, dim3(grid_blocks), dim3(NTHREADS), args, 0, stream);
  if (e != hipSuccess) fprintf(stderr, "cooperative launch failed: %s (grid %d)\n", hipGetErrorString(e), grid_blocks);
#endif
}
```

```cpp
#include <hip/hip_runtime.h>
#include <hip/hip_cooperative_groups.h>
#include <cstdint>
#include <cstdio>
namespace cg = cooperative_groups;

#ifndef MULTI_LAUNCH
#define MULTI_LAUNCH 0
#endif

#ifndef PROBE_ODD
#define PROBE_ODD 0
#endif
#ifndef PROBE_EVEN
#define PROBE_EVEN 0
#endif
#ifndef PROBE_GIN
#define PROBE_GIN 0
#endif
#define DI __device__ __forceinline__
#define LAS __attribute__((address_space(3)))
typedef unsigned short bf16_t;
typedef short bf16x8 __attribute__((ext_vector_type(8)));
typedef short s16x4 __attribute__((ext_vector_type(4)));
typedef float f32x16 __attribute__((ext_vector_type(16)));
typedef float f32x4 __attribute__((ext_vector_type(4)));
typedef unsigned u32x4 __attribute__((ext_vector_type(4)));
typedef unsigned u32x2 __attribute__((ext_vector_type(2)));

constexpr int NTOK = 98304, NTOKP = 65536, UW = 3840, DM = 1024, MIXW = 1280;
constexpr int NTHREADS = 512;
constexpr int AT = 256;
constexpr int LDS_BYTES = 131072 + 32768;
constexpr float EPSF = 1e-6f;
constexpr float LOG2E = 1.4426950408889634f;
constexpr int NPHASE = 13;

struct Params {
  const float *xp, *xs, *memp, *mems, *norm_g, *w_in, *w_out, *mem_norm_g, *w_mem_kv, *mem_qk_g, *conv_w, *swa_qk_g,
      *swa_sink, *ax_qk_g, *diff_qk_g, *diff_lambda, *diff_subln_g;
  float* out;
  bf16_t *u, *xb, *wt_in, *wt_out, *wt_mem, *memb, *memkv;
  float *rstd, *rstd_mem, *tab1c, *tab1s, *tabac, *tabas, *lam;
  unsigned* bar;
  int phase_lo, phase_hi, probe, pad_;
};

typedef __bf16 bf16x2_t __attribute__((ext_vector_type(2)));
typedef float f32x2 __attribute__((ext_vector_type(2)));
DI unsigned cvtpk(float lo, float hi) { f32x2 v = {lo, hi}; bf16x2_t b = __builtin_convertvector(v, bf16x2_t); return __builtin_bit_cast(unsigned, b); }
DI float bf2f(unsigned short b) { return __uint_as_float(((unsigned)b) << 16); }
DI float bflo(unsigned w) { return __uint_as_float(w << 16); }
DI float bfhi(unsigned w) { return __uint_as_float(w & 0xffff0000u); }
DI int ltid() { int t; asm volatile("v_mov_b32 %0, %1" : "=v"(t) : "v"(threadIdx.x)); return t; }
DI int crow(int i, int h) { return (i & 3) + 8 * (i >> 2) + 4 * h; }
DI float swapmax(float v) { auto rr = __builtin_amdgcn_permlane32_swap(__float_as_uint(v), __float_as_uint(v), false, false); return fmaxf(__uint_as_float(rr[0]), __uint_as_float(rr[1])); }
DI float swapsum(float v) { auto rr = __builtin_amdgcn_permlane32_swap(__float_as_uint(v), __float_as_uint(v), false, false); return __uint_as_float(rr[0]) + __uint_as_float(rr[1]); }
DI float shx(float v, int lane, int o) { return __int_as_float(__builtin_amdgcn_ds_bpermute(((lane ^ o) & 63) << 2, __float_as_int(v))); }
DI float silu(float z) { return z / (1.f + __expf(-z)); }
#define MFMA32(a, b, c) __builtin_amdgcn_mfma_f32_32x32x16_bf16((a), (b), (c), 0, 0, 0)

DI void tok_info(int t, int& S, int& seq0, int& pos, int& sq) {
  if (t < NTOKP) { S = 8192; seq0 = t & ~8191; pos = t & 8191; sq = t >> 13; }
  else { int tt = t - NTOKP; S = 4096; seq0 = NTOKP + (tt & ~4095); pos = tt & 4095; sq = 8 + (tt >> 12); }
}

DI void transpose_tile(char* lds, const float* src, const float* g, bf16_t* dst, int K, int N, int k0, int n0) {
  float* tile = (float*)lds;
  const int tid = ltid(), a = tid >> 6, b = tid & 63;
#pragma unroll 4
  for (int i = 0; i < 8; ++i) { int kk = i * 8 + a; float v = src[(size_t)(k0 + kk) * N + n0 + b]; if (g) v *= g[k0 + kk]; tile[kk * 65 + b] = v; }
  __syncthreads();
#pragma unroll 4
  for (int i = 0; i < 8; ++i) { int nn = i * 8 + a; float v = tile[b * 65 + nn]; dst[(size_t)(n0 + nn) * K + k0 + b] = (bf16_t)(cvtpk(v, v) & 0xffffu); }
  __syncthreads();
}

DI void norm_rows(const float* src, bf16_t* dst, float* ssq, int row_begin, int row_end, int gw, int nw) {
  const int lane = ltid() & 63;
  for (int row = row_begin + gw; row < row_end; row += nw) {
    const float* s = src + (size_t)(row - row_begin) * DM; bf16_t* d = dst + (size_t)row * DM;
    f32x4 v[4]; float ss = 0.f;
#pragma unroll
    for (int j = 0; j < 4; ++j) { v[j] = *(const f32x4*)(s + (lane + 64 * j) * 4); ss += v[j][0] * v[j][0] + v[j][1] * v[j][1] + v[j][2] * v[j][2] + v[j][3] * v[j][3]; }
#pragma unroll
    for (int o = 32; o > 0; o >>= 1) ss += shx(ss, lane, o);
    const float rs = ssq ? 1.f : rsqrtf(ss * (1.f / DM) + EPSF);
#pragma unroll
    for (int j = 0; j < 4; ++j) { u32x2 w; w.x = cvtpk(v[j][0] * rs, v[j][1] * rs); w.y = cvtpk(v[j][2] * rs, v[j][3] * rs); *(u32x2*)(d + (lane + 64 * j) * 4) = w; }
    if (ssq && lane == 0) ssq[row] = ss;
  }
}

DI void phase_prep(char* lds, const Params& p) {
  const int T_IN = 4 * 16 * 60, T_OUT = 4 * 20 * 16, T_MEM = 4 * 16 * 8;
  for (int t = blockIdx.x; t < T_IN + T_OUT + T_MEM; t += gridDim.x) {
    if (t < T_IN) { int l = t / 960, r = t % 960, kt = r / 60, nt = r % 60;
      transpose_tile(lds, p.w_in + (size_t)l * DM * UW, p.norm_g + l * DM, p.wt_in + (size_t)l * UW * DM, DM, UW, kt * 64, nt * 64); }
    else if (t < T_IN + T_OUT) { int tt = t - T_IN; int l = tt / 320, r = tt % 320, kt = r / 16, nt = r % 16;
      transpose_tile(lds, p.w_out + (size_t)l * MIXW * DM, nullptr, p.wt_out + (size_t)l * DM * MIXW, MIXW, DM, kt * 64, nt * 64); }
    else { int tt = t - T_IN - T_OUT; int l = tt / 128, r = tt % 128, kt = r / 8, nt = r % 8;
      transpose_tile(lds, p.w_mem_kv + (size_t)l * DM * 512, p.mem_norm_g + l * DM, p.wt_mem + (size_t)l * 512 * DM, DM, 512, kt * 64, nt * 64); }
  }
  const int gw = blockIdx.x * 8 + (ltid() >> 6), nw = gridDim.x * 8;
  norm_rows(p.memp, p.memb, nullptr, 0, 2048, gw, nw);
  norm_rows(p.mems, p.memb, nullptr, 2048, 4096, gw, nw);
  norm_rows(p.xp, p.xb, p.rstd, 0, NTOKP, gw, nw);
  norm_rows(p.xs, p.xb, p.rstd, NTOKP, NTOK, gw, nw);
  const int gt = blockIdx.x * NTHREADS + ltid(), nt_ = gridDim.x * NTHREADS;
  for (int i = gt; i < 8192 * 32; i += nt_) { int pos = i >> 5, f = i & 31; float inv = powf(10000.f, -(float)(2 * f) / 64.f); float ang = (float)pos * inv; p.tab1c[i] = cosf(ang); p.tab1s[i] = sinf(ang); }
  for (int i = gt; i < 128 * 16; i += nt_) { int pos = i >> 4, f = i & 15; float inv = powf(10000.f, -(float)(2 * f) / 32.f); float ang = (float)pos * inv; p.tabac[i] = cosf(ang); p.tabas[i] = sinf(ang); }
  if (blockIdx.x == 0 && ltid() < 64) {
    const int lane = ltid();
    for (int o = 0; o < 2; ++o) {
      const float* lv = p.diff_lambda + o * 256;
      float a = lv[lane] * lv[64 + lane], b = lv[128 + lane] * lv[192 + lane];
#pragma unroll
      for (int s = 32; s > 0; s >>= 1) { a += shx(a, lane, s); b += shx(b, lane, s); }
      float li = 0.8f - 0.6f * expf(-0.3f * (float)(2 * o + 1));
      if (lane == 0) { p.lam[o * 2] = expf(a) - expf(b) + li; p.lam[o * 2 + 1] = 1.f - li; }
      float g0 = fabsf(p.ax_qk_g[o * 128 + lane]), g1 = fabsf(p.ax_qk_g[o * 128 + 64 + lane]);
      float g2 = fabsf(p.diff_qk_g[o * 128 + lane]), g3 = fabsf(p.diff_qk_g[o * 128 + 64 + lane]);
#pragma unroll
      for (int s = 32; s > 0; s >>= 1) { g0 = fmaxf(g0, shx(g0, lane, s)); g1 = fmaxf(g1, shx(g1, lane, s)); g2 = fmaxf(g2, shx(g2, lane, s)); g3 = fmaxf(g3, shx(g3, lane, s)); }
      if (lane == 0) { p.lam[8 + o * 2] = 8.f * g0 * g1 * 1.02f * LOG2E; p.lam[8 + o * 2 + 1] = 8.f * g2 * g3 * 1.02f * LOG2E; }
    }
  }
}

struct GemmDesc { const bf16_t* A; const bf16_t* Bt; int lda, K, mtiles, ntiles, remap, seg2; };
enum { EPI_IN = 0, EPI_MEM = 1, EPI_OUT = 2 };

DI void head_store(f32x16 v0, f32x16 v1, float rs, int mode, const float* gain, const Params& p, int pos, bf16_t* obase, int ldo, char* stg_wg) {
  const int tid_ = ltid(), lane = tid_ & 63, r = lane & 31, h = lane >> 5;
  char* stg = stg_wg + (tid_ >> 6) * 4096;
  v0 *= rs; v1 *= rs;
  if (mode) {
    float ss = 0.f;
#pragma unroll
    for (int i = 0; i < 16; ++i) ss += v0[i] * v0[i] + v1[i] * v1[i];
    ss = swapsum(ss);
    const float inv = rsqrtf(ss * (1.f / 64.f) + EPSF);
#pragma unroll
    for (int g4 = 0; g4 < 4; ++g4) {
      const f32x4 ga = *(const f32x4*)(gain + 8 * g4 + 4 * h), gb = *(const f32x4*)(gain + 32 + 8 * g4 + 4 * h);
#pragma unroll
      for (int j = 0; j < 4; ++j) { v0[4 * g4 + j] *= inv * ga[j]; v1[4 * g4 + j] *= inv * gb[j]; }
    }
    if (mode == 2) {
#pragma unroll
      for (int g4 = 0; g4 < 4; ++g4) {
        const f32x4 c = *(const f32x4*)(p.tab1c + pos * 32 + 8 * g4 + 4 * h), s = *(const f32x4*)(p.tab1s + pos * 32 + 8 * g4 + 4 * h);
#pragma unroll
        for (int j = 0; j < 4; ++j) { const int i = 4 * g4 + j; const float x1 = v0[i], x2 = v1[i]; v0[i] = x1 * c[j] - x2 * s[j]; v1[i] = x2 * c[j] + x1 * s[j]; }
      }
    } else if (mode == 3) {
      const int row = pos >> 6, col = pos & 63;
#pragma unroll
      for (int g4 = 0; g4 < 2; ++g4) {
        const f32x4 c0 = *(const f32x4*)(p.tabac + row * 16 + 8 * g4 + 4 * h), s0 = *(const f32x4*)(p.tabas + row * 16 + 8 * g4 + 4 * h);
        const f32x4 c1 = *(const f32x4*)(p.tabac + col * 16 + 8 * g4 + 4 * h), s1 = *(const f32x4*)(p.tabas + col * 16 + 8 * g4 + 4 * h);
#pragma unroll
        for (int j = 0; j < 4; ++j) { const int i = 4 * g4 + j;
          float x1 = v0[i], x2 = v0[i + 8]; v0[i] = x1 * c0[j] - x2 * s0[j]; v0[i + 8] = x2 * c0[j] + x1 * s0[j];
          x1 = v1[i]; x2 = v1[i + 8]; v1[i] = x1 * c1[j] - x2 * s1[j]; v1[i + 8] = x2 * c1[j] + x1 * s1[j]; }
      }
    }
  }
#pragma unroll
  for (int g4 = 0; g4 < 4; ++g4) {
    u32x2 w0, w1; w0.x = cvtpk(v0[4 * g4], v0[4 * g4 + 1]); w0.y = cvtpk(v0[4 * g4 + 2], v0[4 * g4 + 3]);
    w1.x = cvtpk(v1[4 * g4], v1[4 * g4 + 1]); w1.y = cvtpk(v1[4 * g4 + 2], v1[4 * g4 + 3]);
    *(u32x2*)(stg + r * 128 + ((g4 ^ (r & 7)) << 4) + h * 8) = w0;
    *(u32x2*)(stg + r * 128 + (((4 + g4) ^ (r & 7)) << 4) + h * 8) = w1;
  }
#pragma unroll
  for (int j = 0; j < 4; ++j) {
    const int row = (lane >> 3) + 8 * j, ch = lane & 7;
    const u32x4 w = *(const u32x4*)(stg + row * 128 + ((ch ^ (row & 7)) << 4));
    *(u32x4*)(obase + (size_t)row * ldo + ch * 8) = w;
  }
}

DI int in_mode(const Params& p, int layer, int n_h, const float*& gain) {
  int mode = 0; gain = p.mem_qk_g;
  if ((layer & 1) == 0) { const int e = layer >> 1;
    if (n_h >= 1536 && n_h < 2048) { mode = 2; gain = p.swa_qk_g + (e * 2) * 64; }
    else if (n_h >= 2048 && n_h < 2176) { mode = 2; gain = p.swa_qk_g + (e * 2 + 1) * 64; }
    else if (n_h >= 2304 && n_h < 2560) { mode = 1; gain = p.mem_qk_g + (layer * 2) * 64; }
  } else { const int o = layer >> 1;
    if (n_h < 512) { mode = 3; gain = p.ax_qk_g + (o * 2) * 64; }
    else if (n_h < 640) { mode = 3; gain = p.ax_qk_g + (o * 2 + 1) * 64; }
    else if (n_h >= 768 && n_h < 1280) { mode = 2; gain = p.diff_qk_g + (o * 2) * 64; }
    else if (n_h >= 1280 && n_h < 1792) { mode = 2; gain = p.diff_qk_g + (o * 2 + 1) * 64; }
    else if (n_h >= 2304 && n_h < 2560) { mode = 1; gain = p.mem_qk_g + (layer * 2) * 64; }
  }
  return mode;
}

template <int EPI>
DI void gemm_phase(char* lds, const Params& p, const GemmDesc g, int layer) {
  const int tid = ltid(), lane = tid & 63, wid = tid >> 6, wm = wid >> 1, wn = wid & 1, r = lane & 31, h = lane >> 5;
  const int srow = tid >> 3, sch = tid & 7;
  const int soff = srow * 128 + ((sch ^ ((srow >> 1) & 7)) << 4);
  const int nk = g.K >> 6;
  const int ntile = g.mtiles * g.ntiles;
  const bool banded = ((gridDim.x & 7) == 0) && ((g.mtiles & 63) == 0);
  const int nx = banded ? 8 : 1, bx = blockIdx.x % nx, bi = blockIdx.x / nx, nbx = gridDim.x / nx;
  const int per_band = 8 * g.ntiles;
  const int qtot = ntile / nx;
  int q = bi;
  if (q >= qtot) return;
  int mt, nt;
#define G_TILE(qq, MT, NT) do { if (banded) { const int bl_ = (qq) / per_band, rem_ = (qq) - bl_ * per_band; NT = rem_ >> 3; MT = (bl_ * 8 + bx) * 8 + (rem_ & 7); } \
    else { MT = (qq) / g.ntiles; NT = (qq) - MT * g.ntiles; } } while (0)
#define G_LOAD(AG, BG, kt, RA, RB) do { const int k0_ = (kt) * 64; int ac_ = k0_; if (g.remap) ac_ = k0_ < 512 ? k0_ : (k0_ < 1024 ? g.seg2 + k0_ - 512 : 2304 + k0_ - 1024); \
    _Pragma("unroll") for (int i = 0; i < 4; ++i) { RA[i] = *(const u32x4*)(AG + (size_t)(64 * i) * g.lda + ac_); RB[i] = *(const u32x4*)(BG + (size_t)(64 * i) * g.K + k0_); } } while (0)
#define G_WRITE(buf, RA, RB) do { _Pragma("unroll") for (int i = 0; i < 4; ++i) { *(u32x4*)(lds + (buf) * 65536 + i * 8192 + soff) = RA[i]; *(u32x4*)(lds + (buf) * 65536 + 32768 + i * 8192 + soff) = RB[i]; } } while (0)
#define G_COMPUTE(buf) do { _Pragma("unroll") for (int ks = 0; ks < 4; ++ks) { const int co_ = ((2 * ks + h) ^ ((r >> 1) & 7)) << 4; \
      const char* la_ = lds + (buf) * 65536 + (wm * 64 + r) * 128 + co_; const char* lb_ = lds + (buf) * 65536 + 32768 + (wn * 128 + r) * 128 + co_; \
      bf16x8 fa_[2], fb_[4]; fa_[0] = *(const bf16x8*)(la_); fa_[1] = *(const bf16x8*)(la_ + 4096); \
      _Pragma("unroll") for (int ni = 0; ni < 4; ++ni) fb_[ni] = *(const bf16x8*)(lb_ + ni * 4096); \
      _Pragma("unroll") for (int ni = 0; ni < 4; ++ni) { acc[0][ni] = MFMA32(fb_[ni], fa_[0], acc[0][ni]); acc[1][ni] = MFMA32(fb_[ni], fa_[1], acc[1][ni]); } } } while (0)
  G_TILE(q, mt, nt);
  const bf16_t* Ag = g.A + (size_t)(mt * 256 + srow) * g.lda + sch * 8;
  const bf16_t* Bg = g.Bt + (size_t)(nt * 256 + srow) * g.K + sch * 8;
  u32x4 ra0[4], rb0[4];
  G_LOAD(Ag, Bg, 0, ra0, rb0); G_WRITE(0, ra0, rb0); G_LOAD(Ag, Bg, 1, ra0, rb0); __syncthreads();
  for (;;) {
    const int qn = q + nbx; const bool has_next = qn < qtot;
    int mtn = mt, ntn = nt; if (has_next) G_TILE(qn, mtn, ntn);
    const bf16_t* Agn = g.A + (size_t)(mtn * 256 + srow) * g.lda + sch * 8;
    const bf16_t* Bgn = g.Bt + (size_t)(ntn * 256 + srow) * g.K + sch * 8;
    f32x16 acc[2][4];
#pragma unroll
    for (int a = 0; a < 2; ++a)
#pragma unroll
      for (int b = 0; b < 4; ++b)
#pragma unroll
        for (int i = 0; i < 16; ++i) acc[a][b][i] = 0.f;
    for (int kt = 0; kt < nk; kt += 2) {
      const bool last = kt + 2 >= nk;
      G_WRITE(1, ra0, rb0);
      if (!last) G_LOAD(Ag, Bg, kt + 2, ra0, rb0); else if (has_next) G_LOAD(Agn, Bgn, 0, ra0, rb0);
      G_COMPUTE(0);
      __syncthreads();
      if (!last || has_next) G_WRITE(0, ra0, rb0);
      if (!last) G_LOAD(Ag, Bg, kt + 3, ra0, rb0); else if (has_next) G_LOAD(Agn, Bgn, 1, ra0, rb0);
      G_COMPUTE(1);
      __syncthreads();
    }
    const int n_w = nt * 256 + wn * 128;
    if (EPI == EPI_IN) {
#pragma unroll
      for (int hu = 0; hu < 2; ++hu) {
        const int n_h = n_w + 64 * hu; const float* gain; const int mode = in_mode(p, layer, n_h, gain);
#pragma unroll
        for (int mi = 0; mi < 2; ++mi) {
          const int t = mt * 256 + wm * 64 + mi * 32 + r;
          int S, seq0, pos, sq; tok_info(t, S, seq0, pos, sq);
          const float rs = rsqrtf(p.rstd[(layer & 1) * NTOK + t] * (1.f / DM) + EPSF);
          head_store(acc[mi][2 * hu], acc[mi][2 * hu + 1], rs, mode, gain, p, pos, p.u + (size_t)(t - r) * UW + n_h, UW, lds + 131072);
        }
      }
    } else if (EPI == EPI_MEM) {
#pragma unroll
      for (int hu = 0; hu < 2; ++hu) {
        const int n_h = n_w + 64 * hu, l = n_h >> 9, c = n_h & 511;
        const int mode = c < 256 ? 1 : 0; const float* gain = p.mem_qk_g + (l * 2 + 1) * 64;
#pragma unroll
        for (int mi = 0; mi < 2; ++mi) {
          const int row = mt * 256 + wm * 64 + mi * 32 + r;
          head_store(acc[mi][2 * hu], acc[mi][2 * hu + 1], 1.f, mode, gain, p, 0, p.memkv + (size_t)(row - r) * 2048 + n_h, 2048, lds + 131072);
        }
      }
    } else {
      const int tid_ = ltid(), lane = tid_ & 63, r = lane & 31, h = lane >> 5;
      char* stg = lds + 131072 + (tid_ >> 6) * 4096;
#pragma unroll
      for (int mi = 0; mi < 2; ++mi) {
        const int t0 = mt * 256 + wm * 64 + mi * 32;
        const float* xin0 = layer == 0 ? (t0 < NTOKP ? p.xp + (size_t)t0 * DM : p.xs + (size_t)(t0 - NTOKP) * DM) : p.out + (size_t)t0 * DM;
        float* xo0 = p.out + (size_t)t0 * DM;
        bf16_t* xb0 = p.xb + (size_t)t0 * DM;
        float ssj[4] = {0.f, 0.f, 0.f, 0.f};
#pragma unroll
        for (int ni = 0; ni < 4; ++ni) {
#pragma unroll
          for (int g4 = 0; g4 < 4; ++g4) {
            f32x4 v; v[0] = acc[mi][ni][4 * g4]; v[1] = acc[mi][ni][4 * g4 + 1]; v[2] = acc[mi][ni][4 * g4 + 2]; v[3] = acc[mi][ni][4 * g4 + 3];
            *(f32x4*)(stg + r * 128 + (((2 * g4 + h) ^ (r & 7)) << 4)) = v;
          }
#pragma unroll
          for (int j = 0; j < 4; ++j) {
            const int row = (lane >> 3) + 8 * j, ch = lane & 7;
            const f32x4 a = *(const f32x4*)(stg + row * 128 + ((ch ^ (row & 7)) << 4));
            const size_t off = (size_t)row * DM + n_w + ni * 32 + ch * 4;
            f32x4 xv = *(const f32x4*)(xin0 + off);
            xv += a;
            *(f32x4*)(xo0 + off) = xv;
            if (layer < 3) {
              u32x2 w; w.x = cvtpk(xv[0], xv[1]); w.y = cvtpk(xv[2], xv[3]);
              *(u32x2*)(xb0 + off) = w;
              ssj[j] += xv[0] * xv[0] + xv[1] * xv[1] + xv[2] * xv[2] + xv[3] * xv[3];
            }
          }
        }
        if (layer < 3) {
#pragma unroll
          for (int j = 0; j < 4; ++j) {
            float v = ssj[j];
            v += shx(v, lane, 1); v += shx(v, lane, 2); v += shx(v, lane, 4);
            if ((lane & 7) == 0) atomicAdd(p.rstd + ((layer + 1) & 1) * NTOK + t0 + (lane >> 3) + 8 * j, v);
          }
        }
      }
    }
    if (!has_next) break;
    q = qn; mt = mtn; nt = ntn; Ag = Agn; Bg = Bgn;
  }
#undef G_TILE
#undef G_LOAD
#undef G_WRITE
#undef G_COMPUTE
}

enum { AM_PLAIN = 0, AM_SWA = 1, AM_DIFF = 2 };
struct AttnJob {
  const bf16_t* q;
  const bf16_t* k[2];
  const bf16_t* v;
  int ldk, ldv;
  int tile_lo, tile_hi;
  float m_init, l_init;
  int qpos0;
  bf16_t* o;
  const bf16_t* z;
  float lam, oscale;
  const float* subg;
  int dry;
};

template <int DV, int MODE>
DI void attn_finalize(char* lds, const AttnJob& J, f32x16 (&O)[DV / 32], const float lt, const int wid, const int r, const int h) {
  constexpr int NDV = DV / 32;
  const float inv = 1.f / lt;
  if (MODE != AM_DIFF) {
    bf16_t* orow = J.o + (size_t)r * UW; const bf16_t* zrow = J.z + (size_t)r * UW;
#pragma unroll
    for (int d = 0; d < NDV; ++d)
#pragma unroll
      for (int g4 = 0; g4 < 4; ++g4) {
        const int dv = 32 * d + 8 * g4 + 4 * h;
        const u32x2 zw = *(const u32x2*)(zrow + dv);
        const float y0 = O[d][4 * g4] * inv * silu(bflo(zw.x)), y1 = O[d][4 * g4 + 1] * inv * silu(bfhi(zw.x));
        const float y2 = O[d][4 * g4 + 2] * inv * silu(bflo(zw.y)), y3 = O[d][4 * g4 + 3] * inv * silu(bfhi(zw.y));
        u32x2 w; w.x = cvtpk(y0, y1); w.y = cvtpk(y2, y3);
        *(u32x2*)(orow + dv) = w;
      }
  } else {
    float* sc = (float*)(lds + 32768) + (wid >> 1) * (DV * 32);
    if (wid & 1) {
      const float f = inv * J.lam;
#pragma unroll
      for (int d = 0; d < NDV; ++d)
#pragma unroll
        for (int i = 0; i < 16; ++i) sc[(32 * d + crow(i, h)) * 32 + r] = O[d][i] * f;
    }
    __syncthreads();
    if (!(wid & 1)) {
      float ss = 0.f;
#pragma unroll
      for (int d = 0; d < NDV; ++d)
#pragma unroll
        for (int i = 0; i < 16; ++i) { const float a = O[d][i] * inv - sc[(32 * d + crow(i, h)) * 32 + r]; O[d][i] = a; ss += a * a; }
      ss = swapsum(ss);
      const float rn = rsqrtf(ss * (1.f / DV) + EPSF) * J.oscale;
      bf16_t* orow = J.o + (size_t)r * UW; const bf16_t* zrow = J.z + (size_t)r * UW;
#pragma unroll
      for (int d = 0; d < NDV; ++d)
#pragma unroll
        for (int g4 = 0; g4 < 4; ++g4) {
          const int dv = 32 * d + 8 * g4 + 4 * h;
          const u32x2 zw = *(const u32x2*)(zrow + dv);
          const f32x4 sg = *(const f32x4*)(J.subg + dv);
          const float y0 = O[d][4 * g4] * rn * sg[0] * silu(bflo(zw.x)), y1 = O[d][4 * g4 + 1] * rn * sg[1] * silu(bfhi(zw.x));
          const float y2 = O[d][4 * g4 + 2] * rn * sg[2] * silu(bflo(zw.y)), y3 = O[d][4 * g4 + 3] * rn * sg[3] * silu(bfhi(zw.y));
          u32x2 w; w.x = cvtpk(y0, y1); w.y = cvtpk(y2, y3);
          *(u32x2*)(orow + dv) = w;
        }
    }
  }
}

template <int DV, int NK, int MODE, bool FIXM, int GRP>
DI void attn_job(char* lds_wg, const AttnJob& J) {
  constexpr int NDV = DV / 32;
  constexpr float C = 0.125f * LOG2E;
  const int tid_wg = ltid(), tid = tid_wg & (AT - 1), lane = tid & 63, wid = tid >> 6, r = lane & 31, h = lane >> 5;
  char* lds = lds_wg + GRP * 65536;
  const int kstream = (NK == 2) ? (wid & 1) : 0;
  bf16x8 qf[4];
  const bf16_t* qrow = J.q + (size_t)r * UW + 8 * h;
#pragma unroll
  for (int ds = 0; ds < 4; ++ds) qf[ds] = *(const bf16x8*)(qrow + 16 * ds);
  f32x16 O[NDV];
#pragma unroll
  for (int d = 0; d < NDV; ++d)
#pragma unroll
    for (int i = 0; i < 16; ++i) O[d][i] = 0.f;
  float m = J.m_init, l = (h == 0) ? J.l_init : 0.f;
  f32x16 Osum;
#pragma unroll
  for (int i = 0; i < 16; ++i) Osum[i] = 0.f;
  const bf16x8 ones = {0x3F80, 0x3F80, 0x3F80, 0x3F80, 0x3F80, 0x3F80, 0x3F80, 0x3F80};
  const int ksrow = tid >> 3, ksch = tid & 7;
  const int kpi = (ksrow & ~12) | ((ksrow & 4) << 1) | ((ksrow & 8) >> 1);
  const int ksoff = kpi * 128 + ((ksch ^ ((kpi >> 1) & 7)) << 4);
  constexpr int VCH = DV / 8;
  constexpr int VI = (64 * VCH) / AT;
  const int vkey0 = tid / VCH, vc8 = (tid % VCH) * 8;
  u32x4 rk0[NK][2], rv0[VI], rk1[NK][2], rv1[VI];
#define A_LOAD(t, rk, rv) do { const size_t kb_ = (size_t)(t) * 64; \
    _Pragma("unroll") for (int s = 0; s < NK; ++s) _Pragma("unroll") for (int i = 0; i < 2; ++i) rk[s][i] = *(const u32x4*)(J.k[s] + (kb_ + ksrow + 32 * i) * J.ldk + ksch * 8); \
    _Pragma("unroll") for (int i = 0; i < VI; ++i) rv[i] = *(const u32x4*)(J.v + (kb_ + vkey0 + (AT / VCH) * i) * J.ldv + vc8); } while (0)
#define A_WRITE(st, rk, rv) do { char* b_ = lds + (st) * 32768; \
    _Pragma("unroll") for (int s = 0; s < NK; ++s) _Pragma("unroll") for (int i = 0; i < 2; ++i) *(u32x4*)(b_ + s * 8192 + i * 4096 + ksoff) = rk[s][i]; \
    _Pragma("unroll") for (int i = 0; i < VI; ++i) { const int key_ = vkey0 + (AT / VCH) * i; \
      *(u32x4*)(b_ + NK * 8192 + ((key_ >> 3) * NDV + (vc8 >> 5)) * 512 + (key_ & 7) * 64 + (vc8 & 31) * 2) = rv[i]; } } while (0)
  const int nt = J.tile_hi - J.tile_lo;
  constexpr bool DEEP2 = FIXM || MODE != AM_DIFF;
  constexpr bool ONESET = FIXM;
  A_LOAD(J.tile_lo, rk0, rv0); A_WRITE(0, rk0, rv0); if (ONESET) A_LOAD(J.tile_lo + 1, rk0, rv0); else if (DEEP2) A_LOAD(J.tile_lo + 1, rk1, rv1); __syncthreads();
  const int i16 = lane & 15;
  const int vrd = h * NDV * 512 + (i16 >> 2) * 64 + (((lane >> 4) & 1) * 16 + (i16 & 3) * 4) * 2;
  auto compute = [&](const int stage, const int tile) __attribute__((always_inline)) {
    bool active = true;
    if (MODE == AM_SWA) { const int k0 = tile * 64; active = !(k0 > J.qpos0 + 31 + 128 || k0 + 63 < J.qpos0 - 128); }
    if (active) {
      const char* Kl = lds + stage * 32768 + kstream * 8192 + r * 128;
      f32x16 sA, sB;
#pragma unroll
      for (int i = 0; i < 16; ++i) { sA[i] = 0.f; sB[i] = 0.f; }
      if (NDV == 2 || FIXM) {
        bf16x8 ka[4], kb[4];
#pragma unroll
        for (int ds = 0; ds < 4; ++ds) { const int co = ((2 * ds + h) ^ ((r >> 1) & 7)) << 4; ka[ds] = *(const bf16x8*)(Kl + co); kb[ds] = *(const bf16x8*)(Kl + 4096 + co); }
#pragma unroll
        for (int ds = 0; ds < 4; ++ds) { sA = MFMA32(ka[ds], qf[ds], sA); sB = MFMA32(kb[ds], qf[ds], sB); }
        __builtin_amdgcn_sched_group_barrier(0x100, 4, 0); __builtin_amdgcn_sched_group_barrier(0x008, 2, 0);
        __builtin_amdgcn_sched_group_barrier(0x100, 2, 0); __builtin_amdgcn_sched_group_barrier(0x008, 2, 0);
        __builtin_amdgcn_sched_group_barrier(0x100, 2, 0); __builtin_amdgcn_sched_group_barrier(0x008, 4, 0);
      } else {
#pragma unroll
        for (int ds = 0; ds < 4; ++ds) {
          const int co = ((2 * ds + h) ^ ((r >> 1) & 7)) << 4;
          const bf16x8 ka = *(const bf16x8*)(Kl + co), kb = *(const bf16x8*)(Kl + 4096 + co);
          sA = MFMA32(ka, qf[ds], sA); sB = MFMA32(kb, qf[ds], sB);
        }
      }
      if (MODE == AM_SWA) {
        const int qa = J.qpos0 + r, kbase = tile * 64 + 8 * h;
#pragma unroll
        for (int i = 0; i < 16; ++i) {
          const int ka_ = kbase + 16 * (i >> 3) + (i & 7);
          int d0 = qa - ka_; d0 = d0 < 0 ? -d0 : d0; if (d0 > 128) sA[i] = -INFINITY;
          int d1 = qa - (ka_ + 32); d1 = d1 < 0 ? -d1 : d1; if (d1 > 128) sB[i] = -INFINITY;
        }
      }
      if (FIXM) {
        const float nm = -J.m_init;
#pragma unroll
        for (int i = 0; i < 16; ++i) { sA[i] = __builtin_amdgcn_exp2f(fmaf(sA[i], C, nm)); sB[i] = __builtin_amdgcn_exp2f(fmaf(sB[i], C, nm)); l += sA[i] + sB[i]; }
      } else {
      float mx = sA[0];
#pragma unroll
      for (int i = 1; i < 16; ++i) mx = fmaxf(mx, sA[i]);
#pragma unroll
      for (int i = 0; i < 16; ++i) mx = fmaxf(mx, sB[i]);
      mx = swapmax(mx);
      const float mn = fmaxf(m, mx * C);
      const float alpha = __builtin_amdgcn_exp2f(m - mn);
      m = mn;
      float ps = 0.f;
#pragma unroll
      for (int i = 0; i < 16; ++i) { sA[i] = __builtin_amdgcn_exp2f(fmaf(sA[i], C, -mn)); sB[i] = __builtin_amdgcn_exp2f(fmaf(sB[i], C, -mn)); ps += sA[i] + sB[i]; }
      l = l * alpha + ps;
#pragma unroll
      for (int d = 0; d < NDV; ++d)
#pragma unroll
        for (int i = 0; i < 16; ++i) O[d][i] *= alpha;
      }
      bf16x8 pf[4];
      { u32x4 w;
        w.x = cvtpk(sA[0], sA[1]); w.y = cvtpk(sA[2], sA[3]); w.z = cvtpk(sA[4], sA[5]); w.w = cvtpk(sA[6], sA[7]); pf[0] = __builtin_bit_cast(bf16x8, w);
        w.x = cvtpk(sA[8], sA[9]); w.y = cvtpk(sA[10], sA[11]); w.z = cvtpk(sA[12], sA[13]); w.w = cvtpk(sA[14], sA[15]); pf[1] = __builtin_bit_cast(bf16x8, w);
        w.x = cvtpk(sB[0], sB[1]); w.y = cvtpk(sB[2], sB[3]); w.z = cvtpk(sB[4], sB[5]); w.w = cvtpk(sB[6], sB[7]); pf[2] = __builtin_bit_cast(bf16x8, w);
        w.x = cvtpk(sB[8], sB[9]); w.y = cvtpk(sB[10], sB[11]); w.z = cvtpk(sB[12], sB[13]); w.w = cvtpk(sB[14], sB[15]); pf[3] = __builtin_bit_cast(bf16x8, w); }
      const char* Vl = lds + stage * 32768 + NK * 8192 + vrd;
      if (FIXM) {
        bf16x8 vf[4][NDV];
#pragma unroll
        for (int ks = 0; ks < 4; ++ks) {
#pragma unroll
          for (int d = 0; d < NDV; ++d) {
            const s16x4 lo = __builtin_amdgcn_ds_read_tr16_b64_v4i16((LAS s16x4*)(Vl + ks * 2 * NDV * 512 + d * 512));
            const s16x4 hi = __builtin_amdgcn_ds_read_tr16_b64_v4i16((LAS s16x4*)(Vl + ks * 2 * NDV * 512 + d * 512 + 256));
            vf[ks][d] = __builtin_shufflevector(lo, hi, 0, 1, 2, 3, 4, 5, 6, 7);
          }
        }
#pragma unroll
        for (int ks = 0; ks < 4; ++ks) {
#pragma unroll
          for (int d = 0; d < NDV; ++d) O[d] = MFMA32(vf[ks][d], pf[ks], O[d]);
        }
        __builtin_amdgcn_sched_group_barrier(0x100, 4 * NDV, 0); __builtin_amdgcn_sched_group_barrier(0x008, NDV, 0);
        __builtin_amdgcn_sched_group_barrier(0x100, 2 * NDV, 0); __builtin_amdgcn_sched_group_barrier(0x008, NDV, 0);
        __builtin_amdgcn_sched_group_barrier(0x100, 2 * NDV, 0); __builtin_amdgcn_sched_group_barrier(0x008, 2 * NDV, 0);
      } else {
      if (FIXM) {
#pragma unroll
        for (int ks = 0; ks < 4; ++ks) Osum = MFMA32(ones, pf[ks], Osum);
      }
#pragma unroll
      for (int ks = 0; ks < 4; ++ks)
#pragma unroll
        for (int d = 0; d < NDV; ++d) {
          const s16x4 lo = __builtin_amdgcn_ds_read_tr16_b64_v4i16((LAS s16x4*)(Vl + ks * 2 * NDV * 512 + d * 512));
          const s16x4 hi = __builtin_amdgcn_ds_read_tr16_b64_v4i16((LAS s16x4*)(Vl + ks * 2 * NDV * 512 + d * 512 + 256));
          const bf16x8 vf = __builtin_shufflevector(lo, hi, 0, 1, 2, 3, 4, 5, 6, 7);
          O[d] = MFMA32(vf, pf[ks], O[d]);
        }
      }
    }
  };
  for (int it = 0; it < nt; it += 2) {
    if (ONESET) {
      A_WRITE(1, rk0, rv0);
      if (it + 2 < nt) A_LOAD(J.tile_lo + it + 2, rk0, rv0);
      compute(0, J.tile_lo + it);
      __syncthreads();
      if (it + 2 < nt) A_WRITE(0, rk0, rv0);
      if (it + 3 < nt) A_LOAD(J.tile_lo + it + 3, rk0, rv0);
      compute(1, J.tile_lo + it + 1);
      __syncthreads();
    } else if (DEEP2) {
      if (it + 2 < nt) A_LOAD(J.tile_lo + it + 2, rk0, rv0);
      compute(0, J.tile_lo + it);
      A_WRITE(1, rk1, rv1);
      __syncthreads();
      if (it + 3 < nt) A_LOAD(J.tile_lo + it + 3, rk1, rv1);
      compute(1, J.tile_lo + it + 1);
      if (it + 2 < nt) A_WRITE(0, rk0, rv0);
      __syncthreads();
    } else {
      compute(0, J.tile_lo + it);
      __builtin_amdgcn_sched_barrier(0);
      A_LOAD(J.tile_lo + it + 1, rk0, rv0); A_WRITE(1, rk0, rv0);
      __syncthreads();
      compute(1, J.tile_lo + it + 1);
      __builtin_amdgcn_sched_barrier(0);
      if (it + 2 < nt) { A_LOAD(J.tile_lo + it + 2, rk0, rv0); A_WRITE(0, rk0, rv0); }
      __syncthreads();
    }
  }
#undef A_LOAD
#undef A_WRITE
  if (J.dry) return;
  const float lt = swapsum(l);
  attn_finalize<DV, MODE>(lds, J, O, lt, wid, r, h);
}

template <int DV, int NK, int MODE, int GRP>
DI void attn_pipe(char* lds_wg, const AttnJob& J) {
  constexpr int NDV = DV / 32;
  constexpr float C = 0.125f * LOG2E;
  constexpr int KST = NK * 8192, VST = DV * 128, VB = 2 * KST;
  const int tid_wg = ltid(), tid = tid_wg & (AT - 1), lane = tid & 63, wid = tid >> 6, r = lane & 31, h = lane >> 5;
  char* lds = lds_wg + GRP * 65536;
  const int kstream = (NK == 2) ? (wid & 1) : 0;
  bf16x8 qf[4];
  const bf16_t* qrow = J.q + (size_t)r * UW + 8 * h;
#pragma unroll
  for (int ds = 0; ds < 4; ++ds) qf[ds] = *(const bf16x8*)(qrow + 16 * ds);
  f32x16 O[NDV], Osum;
#pragma unroll
  for (int d = 0; d < NDV; ++d)
#pragma unroll
    for (int i = 0; i < 16; ++i) O[d][i] = 0.f;
#pragma unroll
  for (int i = 0; i < 16; ++i) Osum[i] = 0.f;
  const bf16x8 ones = {0x3F80, 0x3F80, 0x3F80, 0x3F80, 0x3F80, 0x3F80, 0x3F80, 0x3F80};
  const float nm = -J.m_init;
  const int ksrow = tid >> 3, ksch = tid & 7;
  const int kpi = (ksrow & ~12) | ((ksrow & 4) << 1) | ((ksrow & 8) >> 1);
  const int ksoff = kpi * 128 + ((ksch ^ ((kpi >> 1) & 7)) << 4);
  constexpr int VCH = DV / 8, VI = (64 * VCH) / AT;
  const int vkey0 = tid / VCH, vc8 = (tid % VCH) * 8;
  u32x4 rk0[NK][2], rv0[VI], rk1[NK][2], rv1[VI];
#define K_LOAD(t, rk) do { const size_t kb_ = (size_t)(t) * 64; \
    _Pragma("unroll") for (int s = 0; s < NK; ++s) _Pragma("unroll") for (int i = 0; i < 2; ++i) rk[s][i] = *(const u32x4*)(J.k[s] + (kb_ + ksrow + 32 * i) * J.ldk + ksch * 8); } while (0)
#define V_LOAD(t, rv) do { const size_t kb_ = (size_t)(t) * 64; \
    _Pragma("unroll") for (int i = 0; i < VI; ++i) rv[i] = *(const u32x4*)(J.v + (kb_ + vkey0 + (AT / VCH) * i) * J.ldv + vc8); } while (0)
#define K_WRITE(st, rk) do { char* b_ = lds + (st) * KST; \
    _Pragma("unroll") for (int s = 0; s < NK; ++s) _Pragma("unroll") for (int i = 0; i < 2; ++i) *(u32x4*)(b_ + s * 8192 + i * 4096 + ksoff) = rk[s][i]; } while (0)
#define V_WRITE(st, rv) do { char* b_ = lds + VB + (st) * VST; \
    _Pragma("unroll") for (int i = 0; i < VI; ++i) { const int key_ = vkey0 + (AT / VCH) * i; \
      *(u32x4*)(b_ + ((key_ >> 3) * NDV + (vc8 >> 5)) * 512 + (key_ & 7) * 64 + (vc8 & 31) * 2) = rv[i]; } } while (0)
  const int nt = J.tile_hi - J.tile_lo, t0 = J.tile_lo;
  const int i16 = lane & 15;
  const int vrd = h * NDV * 512 + (i16 >> 2) * 64 + (((lane >> 4) & 1) * 16 + (i16 & 3) * 4) * 2;
  auto qk = [&](const int kst, f32x16& sA, f32x16& sB) __attribute__((always_inline)) {
    const char* Kl = lds + kst * KST + kstream * 8192 + r * 128;
#pragma unroll
    for (int i = 0; i < 16; ++i) { sA[i] = 0.f; sB[i] = 0.f; }
    bf16x8 ka[4], kb[4];
#pragma unroll
    for (int ds = 0; ds < 4; ++ds) { const int co = ((2 * ds + h) ^ ((r >> 1) & 7)) << 4; ka[ds] = *(const bf16x8*)(Kl + co); kb[ds] = *(const bf16x8*)(Kl + 4096 + co); }
    __builtin_amdgcn_sched_barrier(0);
#pragma unroll
    for (int ds = 0; ds < 4; ++ds) { sA = MFMA32(ka[ds], qf[ds], sA); sB = MFMA32(kb[ds], qf[ds], sB); }
  };
  auto smpv = [&](const int vst, f32x16& sA, f32x16& sB) __attribute__((always_inline)) {
    const char* Vl = lds + VB + vst * VST + vrd;
    bf16x8 vf[4][NDV];
#pragma unroll
    for (int ks = 0; ks < 4; ++ks)
#pragma unroll
      for (int d = 0; d < NDV; ++d) {
        const s16x4 lo = __builtin_amdgcn_ds_read_tr16_b64_v4i16((LAS s16x4*)(Vl + ks * 2 * NDV * 512 + d * 512));
        const s16x4 hi = __builtin_amdgcn_ds_read_tr16_b64_v4i16((LAS s16x4*)(Vl + ks * 2 * NDV * 512 + d * 512 + 256));
        vf[ks][d] = __builtin_shufflevector(lo, hi, 0, 1, 2, 3, 4, 5, 6, 7);
      }
    __builtin_amdgcn_sched_barrier(0);
#pragma unroll
    for (int i = 0; i < 16; ++i) { sA[i] = __builtin_amdgcn_exp2f(fmaf(sA[i], C, nm)); sB[i] = __builtin_amdgcn_exp2f(fmaf(sB[i], C, nm)); }
    bf16x8 pf[4];
    { u32x4 w;
      w.x = cvtpk(sA[0], sA[1]); w.y = cvtpk(sA[2], sA[3]); w.z = cvtpk(sA[4], sA[5]); w.w = cvtpk(sA[6], sA[7]); pf[0] = __builtin_bit_cast(bf16x8, w);
      w.x = cvtpk(sA[8], sA[9]); w.y = cvtpk(sA[10], sA[11]); w.z = cvtpk(sA[12], sA[13]); w.w = cvtpk(sA[14], sA[15]); pf[1] = __builtin_bit_cast(bf16x8, w);
      w.x = cvtpk(sB[0], sB[1]); w.y = cvtpk(sB[2], sB[3]); w.z = cvtpk(sB[4], sB[5]); w.w = cvtpk(sB[6], sB[7]); pf[2] = __builtin_bit_cast(bf16x8, w);
      w.x = cvtpk(sB[8], sB[9]); w.y = cvtpk(sB[10], sB[11]); w.z = cvtpk(sB[12], sB[13]); w.w = cvtpk(sB[14], sB[15]); pf[3] = __builtin_bit_cast(bf16x8, w); }
#pragma unroll
    for (int ks = 0; ks < 4; ++ks) Osum = MFMA32(ones, pf[ks], Osum);
#pragma unroll
    for (int ks = 0; ks < 4; ++ks)
#pragma unroll
      for (int d = 0; d < NDV; ++d) O[d] = MFMA32(vf[ks][d], pf[ks], O[d]);
  };
  K_LOAD(t0, rk0); V_LOAD(t0, rv0); K_LOAD(t0 + 1, rk1);
  K_WRITE(0, rk0); V_WRITE(0, rv0); K_WRITE(1, rk1);
  if (2 < nt) K_LOAD(t0 + 2, rk0);
  V_LOAD(t0 + 1, rv0);
  __syncthreads();
  f32x16 eA, eB, oA, oB;
  qk(0, eA, eB);
  __syncthreads();
  for (int j = 0; j < nt; j += 2) {
    if (j + 3 < nt) K_LOAD(t0 + j + 3, rk1);
    if (j + 2 < nt) V_LOAD(t0 + j + 2, rv1);
    qk(1, oA, oB);
    __builtin_amdgcn_sched_barrier(0);
    smpv(0, eA, eB);
    if (j + 2 < nt) K_WRITE(0, rk0);
    V_WRITE(1, rv0);
    __syncthreads();
    if (j + 4 < nt) K_LOAD(t0 + j + 4, rk0);
    if (j + 3 < nt) V_LOAD(t0 + j + 3, rv0);
    if (j + 2 < nt) qk(0, eA, eB);
    __builtin_amdgcn_sched_barrier(0);
    smpv(1, oA, oB);
    if (j + 3 < nt) K_WRITE(1, rk1);
    if (j + 2 < nt) V_WRITE(0, rv1);
    __syncthreads();
  }
#undef K_LOAD
#undef V_LOAD
#undef K_WRITE
#undef V_WRITE
  if (J.dry) return;
  attn_finalize<DV, MODE>(lds, J, O, Osum[0], wid, r, h);
}

#define PIPE_CALL(DV, NK, MODE) do { if (grp) attn_pipe<DV, NK, MODE, 1>(lds, J); else attn_pipe<DV, NK, MODE, 0>(lds, J); } while (0)
#define ATTN_CALL(DV, NK, MODE, FIXM) do { if (grp) attn_job<DV, NK, MODE, FIXM, 1>(lds, J); else attn_job<DV, NK, MODE, FIXM, 0>(lds, J); } while (0)
DI void mem_jobs(char* lds, const Params& p, int layer, int dry) {
  const int grp = __builtin_amdgcn_readfirstlane(ltid() >> 8);
  const int wid = (ltid() >> 6) & 3, vb = blockIdx.x * 2 + grp, vg = gridDim.x * 2;
  for (int job = vb; job < 768 * 4; job += vg) {
    const int qb = job >> 2, hm = job & 3, t0 = qb * 128;
    int S, seq0, pos, sq; tok_info(t0, S, seq0, pos, sq);
    AttnJob J;
    bf16_t* qo = p.u + (size_t)(t0 + 32 * wid) * UW + 2304 + hm * 64;
    J.q = qo; J.o = qo; J.z = p.u + (size_t)(t0 + 32 * wid) * UW + 2560 + 1024 + hm * 64;
    J.k[0] = J.k[1] = p.memkv + (size_t)(sq * 256) * 2048 + layer * 512 + hm * 64; J.v = J.k[0] + 256; J.ldk = J.ldv = 2048;
    J.tile_lo = 0; J.tile_hi = 4; J.m_init = -1e30f; J.l_init = 0.f; J.qpos0 = 0; J.lam = 0.f; J.oscale = 0.f; J.subg = nullptr; J.dry = dry;
    ATTN_CALL(64, 1, AM_PLAIN, false);
  }
}

DI void phase_mix_even(char* lds, const Params& p, int layer, int dry) {
  const int grp = __builtin_amdgcn_readfirstlane(ltid() >> 8);
  const int e = layer >> 1, wid = (ltid() >> 6) & 3, vb = blockIdx.x * 2 + grp, vg = gridDim.x * 2;
  for (int job = vb; job < 768 * 8; job += vg) {
    const int qb = job >> 3, hq = job & 7, kvh = hq >> 2, t0 = qb * 128;
    int S, seq0, pos, sq; tok_info(t0, S, seq0, pos, sq);
    AttnJob J;
    bf16_t* qo = p.u + (size_t)(t0 + 32 * wid) * UW + 1536 + hq * 64;
    J.q = qo; J.o = qo; J.z = p.u + (size_t)(t0 + 32 * wid) * UW + 2560 + 512 + hq * 64;
    J.k[0] = J.k[1] = p.u + (size_t)seq0 * UW + 2048 + kvh * 64; J.v = p.u + (size_t)seq0 * UW + 2176 + kvh * 64; J.ldk = J.ldv = UW;
    const int pt = pos >> 6;
    J.tile_lo = pt - 2 < 0 ? 0 : pt - 2; J.tile_hi = pt + 4 > (S >> 6) ? (S >> 6) : pt + 4;
    J.m_init = p.swa_sink[e * 8 + hq] * LOG2E; J.l_init = 1.f; J.qpos0 = pos + 32 * wid; J.lam = 0.f; J.oscale = 0.f; J.subg = nullptr; J.dry = dry;
    ATTN_CALL(64, 1, AM_SWA, false);
  }
  mem_jobs(lds, p, layer, dry);
  const float* cw = p.conv_w + e * 3 * 512;
  for (int idx = blockIdx.x * NTHREADS + ltid(); idx < NTOK * 64; idx += gridDim.x * NTHREADS) {
    const int t = idx >> 6, c0 = (idx & 63) * 8;
    int S, seq0, pos, sq; tok_info(t, S, seq0, pos, sq);
    bf16_t* ur = p.u + (size_t)t * UW;
    float ic[8], il[8], ir[8];
    { const u32x4 a = *(const u32x4*)(ur + 512 + c0), b = *(const u32x4*)(ur + 1024 + c0);
#pragma unroll
      for (int j = 0; j < 4; ++j) { ic[2 * j] = bflo(a[j]) * bflo(b[j]); ic[2 * j + 1] = bfhi(a[j]) * bfhi(b[j]); } }
    if (pos > 0) { const u32x4 a = *(const u32x4*)(ur - UW + 512 + c0), b = *(const u32x4*)(ur - UW + 1024 + c0);
#pragma unroll
      for (int j = 0; j < 4; ++j) { il[2 * j] = bflo(a[j]) * bflo(b[j]); il[2 * j + 1] = bfhi(a[j]) * bfhi(b[j]); } }
    else {
#pragma unroll
      for (int j = 0; j < 8; ++j) il[j] = 0.f; }
    if (pos < S - 1) { const u32x4 a = *(const u32x4*)(ur + UW + 512 + c0), b = *(const u32x4*)(ur + UW + 1024 + c0);
#pragma unroll
      for (int j = 0; j < 4; ++j) { ir[2 * j] = bflo(a[j]) * bflo(b[j]); ir[2 * j + 1] = bfhi(a[j]) * bfhi(b[j]); } }
    else {
#pragma unroll
      for (int j = 0; j < 8; ++j) ir[j] = 0.f; }
    const u32x4 gbw = *(const u32x4*)(ur + c0), zw = *(const u32x4*)(ur + 2560 + c0);
    float y[8];
#pragma unroll
    for (int j = 0; j < 8; ++j) {
      const float gb = (j & 1) ? bfhi(gbw[j >> 1]) : bflo(gbw[j >> 1]);
      const float z = (j & 1) ? bfhi(zw[j >> 1]) : bflo(zw[j >> 1]);
      const float cv = il[j] * cw[c0 + j] + ic[j] * cw[512 + c0 + j] + ir[j] * cw[1024 + c0 + j];
      y[j] = gb * cv * silu(z);
    }
    u32x4 w; w.x = cvtpk(y[0], y[1]); w.y = cvtpk(y[2], y[3]); w.z = cvtpk(y[4], y[5]); w.w = cvtpk(y[6], y[7]);
    if (!dry) *(u32x4*)(ur + c0) = w;
  }
}

DI void phase_mix_odd(char* lds, const Params& p, int layer, int dry) {
  const int grp = __builtin_amdgcn_readfirstlane(ltid() >> 8);
  const int o = layer >> 1, wid = (ltid() >> 6) & 3;
  const int nx = (gridDim.x & 7) == 0 ? 8 : 1, bx = blockIdx.x % nx, bi = (blockIdx.x / nx) * 2 + grp, nbx = (gridDim.x / nx) * 2;
  const float mb_dense = p.lam[8 + o * 2], mb_diff = p.lam[8 + o * 2 + 1];
  const bool fix_dense = mb_dense < 43.f, fix_diff = mb_diff < 43.f;
#pragma unroll 1
  for (int part = 0; part < 2; ++part) {
    const int gshift = part ? 7 : 8, nv = (16 / nx) << gshift;
#pragma unroll 1
    for (int v = bi; v < nv; v += nbx) {
      const int j = ((bx + nx * (v >> gshift)) << gshift) + (v & ((1 << gshift) - 1));
      int g, qb, kvh, seq0, S;
      if (!part) { g = j & 3; qb = (j >> 2) & 63; kvh = (j >> 8) & 1; seq0 = (j >> 9) * 8192; S = 8192; }
      else { g = j & 3; qb = (j >> 2) & 31; kvh = (j >> 7) & 1; seq0 = NTOKP + (j >> 8) * 4096; S = 4096; }
      const int hq = kvh * 4 + g, t0 = seq0 + qb * 128 + 32 * wid;
      AttnJob J;
      bf16_t* qo = p.u + (size_t)t0 * UW + hq * 64;
      J.q = qo; J.o = qo; J.z = p.u + (size_t)t0 * UW + 2560 + hq * 64;
      J.k[0] = J.k[1] = p.u + (size_t)seq0 * UW + 512 + kvh * 64; J.v = p.u + (size_t)seq0 * UW + 640 + kvh * 64; J.ldk = J.ldv = UW;
      J.tile_lo = 0; J.tile_hi = S >> 6; J.l_init = 0.f; J.qpos0 = 0; J.lam = 0.f; J.oscale = 0.f; J.subg = nullptr; J.dry = dry;
      if (fix_dense) { J.m_init = mb_dense; ATTN_CALL(64, 1, AM_PLAIN, true); }
      else { J.m_init = -1e30f; ATTN_CALL(64, 1, AM_PLAIN, false); }
    }
  }
  const float lam = p.lam[o * 2], osc = p.lam[o * 2 + 1];
#pragma unroll 1
  for (int part = 0; part < 2; ++part) {
    const int gshift = part ? 6 : 7, nv = (32 / nx) << gshift;
#pragma unroll 1
    for (int v = bi; v < nv; v += nbx) {
      const int j = ((bx + nx * (v >> gshift)) << gshift) + (v & ((1 << gshift) - 1));
      int qb, hh, seq0, S;
      if (!part) { qb = j & 127; hh = (j >> 7) & 3; seq0 = (j >> 9) * 8192; S = 8192; }
      else { qb = j & 63; hh = (j >> 6) & 3; seq0 = NTOKP + (j >> 8) * 4096; S = 4096; }
      const int mp = wid & 1, sub = wid >> 1, t0 = seq0 + qb * 64 + sub * 32;
      AttnJob J;
      J.q = p.u + (size_t)t0 * UW + 768 + (2 * hh + mp) * 64;
      J.o = p.u + (size_t)t0 * UW + 768 + hh * 128; J.z = p.u + (size_t)t0 * UW + 2560 + 512 + hh * 128;
      J.k[0] = p.u + (size_t)seq0 * UW + 1280 + (2 * hh) * 64; J.k[1] = J.k[0] + 64; J.v = p.u + (size_t)seq0 * UW + 1792 + hh * 128; J.ldk = J.ldv = UW;
      J.tile_lo = 0; J.tile_hi = S >> 6; J.l_init = 0.f; J.qpos0 = 0; J.lam = lam; J.oscale = osc; J.subg = p.diff_subln_g + o * 128; J.dry = dry;
      if (fix_diff) { J.m_init = mb_diff; ATTN_CALL(128, 2, AM_DIFF, true); }
      else { J.m_init = -1e30f; ATTN_CALL(128, 2, AM_DIFF, false); }
    }
  }
  mem_jobs(lds, p, layer, dry);
}

DI void phase_norm(const Params& p) {
  const int gw = blockIdx.x * 8 + (ltid() >> 6), nw = gridDim.x * 8;
  norm_rows(p.out, p.xb, p.rstd, 0, NTOK, gw, nw);
}

#define XB_TMO      128
#define XB_XCNT(j)  (256  + 64 * (j))
#define XB_XSUB(j)  (1280 + 64 * (j))
#define XB_XGEN(j)  (2304 + 64 * (j))
#define XB_TOP      3328
#define XB_TOPGEN   3392
#define XB_STATE    4096
#define XB_WORDS    8192
#define XB_SPIN_CAP (1u << 18)
DI unsigned xb_ld(unsigned* p) { return __hip_atomic_load(p, __ATOMIC_RELAXED, __HIP_MEMORY_SCOPE_AGENT); }
DI unsigned xb_add(unsigned* p, unsigned v) { return __hip_atomic_fetch_add(p, v, __ATOMIC_RELAXED, __HIP_MEMORY_SCOPE_AGENT); }
DI unsigned xb_xcc_id() { return (unsigned)__builtin_amdgcn_s_getreg((3 << 11) | 20) & 0xFu; }
#define XB_SPIN(cond, bar) do { unsigned _sp = 0; while (cond) { __builtin_amdgcn_s_sleep(1); \
    if ((++_sp & 255u) == 0u) { if (xb_ld(&(bar)[XB_TMO])) break; if (_sp > XB_SPIN_CAP) { atomicAdd(&(bar)[XB_TMO], 1u); break; } } } } while (0)
DI void xb_census(unsigned* bar, unsigned x, unsigned& nloc, unsigned& nx) {
  const unsigned G = gridDim.x;
  unsigned sum, cnt, mine, sp = 0u;
  for (;;) {
    sum = 0u; cnt = 0u; mine = 0u;
#pragma unroll
    for (unsigned j = 0; j < 16; ++j) { const unsigned c = xb_ld(&bar[XB_XCNT(j)]); sum += c; cnt += (c > 0u) ? 1u : 0u; mine = (j == x) ? c : mine; }
    if (sum == G) break;
    __builtin_amdgcn_s_sleep(1);
    if ((++sp & 255u) == 0u) { if (xb_ld(&bar[XB_TMO])) break; if (sp > XB_SPIN_CAP) { atomicAdd(&bar[XB_TMO], 1u); break; } }
  }
  nloc = mine > 0u ? mine : 1u; nx = cnt > 0u ? cnt : 1u;
}
DI void xcd_barrier(unsigned* bar) {
  asm volatile("s_waitcnt vmcnt(0)" ::: "memory");
  __syncthreads();
  if (threadIdx.x == 0) {
    __builtin_amdgcn_s_waitcnt(0);
    const unsigned x = xb_xcc_id();
    unsigned* st = bar + XB_STATE + 2 * blockIdx.x;
    unsigned nloc = xb_ld(st), nx = xb_ld(st + 1);
    if (nloc == 0u) { xb_census(bar, x, nloc, nx); __hip_atomic_store(st, nloc, __ATOMIC_RELAXED, __HIP_MEMORY_SCOPE_AGENT); __hip_atomic_store(st + 1, nx, __ATOMIC_RELAXED, __HIP_MEMORY_SCOPE_AGENT); }
    const unsigned old = xb_add(&bar[XB_XSUB(x)], 1u);
    const unsigned gen = old / nloc;
    if (old + 1u == (gen + 1u) * nloc) {
      __builtin_amdgcn_fence(__ATOMIC_RELEASE, "agent");
      asm volatile("s_waitcnt vmcnt(0)" ::: "memory");
      const unsigned og = xb_add(&bar[XB_TOP], 1u);
      const unsigned tg = og / nx;
      if (og + 1u == (tg + 1u) * nx) xb_add(&bar[XB_TOPGEN], 1u);
      else XB_SPIN(xb_ld(&bar[XB_TOPGEN]) == tg, bar);
      __builtin_amdgcn_fence(__ATOMIC_ACQUIRE, "agent");
      xb_add(&bar[XB_XGEN(x)], 1u);
      asm volatile("s_waitcnt vmcnt(0)" ::: "memory");
    } else {
      XB_SPIN(xb_ld(&bar[XB_XGEN(x)]) == gen, bar);
      __builtin_amdgcn_fence(__ATOMIC_ACQUIRE, "agent");
      asm volatile("s_waitcnt vmcnt(0)" ::: "memory");
    }
  }
  __syncthreads();
}

__global__ void __launch_bounds__(NTHREADS, 2) fwd_kernel(Params p) {
  __shared__ __attribute__((aligned(16))) char lds[LDS_BYTES];
  if (threadIdx.x == 0) (void)xb_add(&p.bar[XB_XCNT(xb_xcc_id())], 1u);
  int ph = p.phase_lo;
  if (ph == 0) {
    phase_prep(lds, p);
    ph = 1;
#if !MULTI_LAUNCH
    if (ph < p.phase_hi) cg::this_grid().sync();
#endif
  }
  for (; ph < p.phase_hi; ++ph) {
    {
      const int l = (ph - 1) / 3, s = (ph - 1) - 3 * l;
      if (s == 0) {
        if (l == 0) { GemmDesc g{p.memb, p.wt_mem, DM, DM, 16, 8, 0, 0}; gemm_phase<EPI_MEM>(lds, p, g, 0); }
        GemmDesc g{p.xb, p.wt_in + (size_t)l * UW * DM, DM, DM, NTOK / 256, UW / 256, 0, 0};
        const int nrep = ((p.probe >> 2) & 1) + 1;
#pragma unroll 1
        for (int rep = 0; rep < nrep; ++rep) gemm_phase<EPI_IN>(lds, p, g, l);
      } else if (s == 1) {
        const int nrep = ((l & 1) ? (p.probe & 1) : ((p.probe >> 1) & 1)) + 1;
#pragma unroll 1
        for (int rep = 0; rep < nrep; ++rep) {
          const int dry = rep + 1 < nrep;
          if (rep == 0) {
            float* z = p.rstd + ((l + 1) & 1) * NTOK;
            for (int i = blockIdx.x * NTHREADS + ltid(); i < NTOK; i += gridDim.x * NTHREADS) z[i] = 0.f;
          }
          if (__builtin_amdgcn_readfirstlane(ltid()) >= 256) __builtin_amdgcn_s_setprio(1);
          if (l & 1) phase_mix_odd(lds, p, l, dry); else phase_mix_even(lds, p, l, dry);
          __builtin_amdgcn_s_setprio(0);
        }
      } else if (s == 2) {
        GemmDesc g{p.u, p.wt_out + (size_t)l * DM * MIXW, UW, MIXW, NTOK / 256, DM / 256, 1, (l & 1) ? 768 : 1536};
        gemm_phase<EPI_OUT>(lds, p, g, l);
      }
    }
#if !MULTI_LAUNCH
    if (ph + 1 < p.phase_hi) xcd_barrier(p.bar);
#endif
  }
}

extern "C" void kernel_launch(void* const* d_in, const int* in_sizes, int n_in, void* d_out, int out_size, void* d_ws, size_t ws_size,
                              hipStream_t stream) {
  static int grid_blocks = 0;
  if (!grid_blocks) {
    int dev = 0, cus = 0, per_cu = 0;
    hipGetDevice(&dev);
    hipDeviceGetAttribute(&cus, hipDeviceAttributeMultiprocessorCount, dev);
    hipOccupancyMaxActiveBlocksPerMultiprocessor(&per_cu, fwd_kernel, NTHREADS, 0);
    if (per_cu > 1) per_cu = 1;
    if (per_cu < 1) per_cu = 1;
    int cap = cus * per_cu; if (cap > 256) cap = 256;
    grid_blocks = 8; while (grid_blocks * 2 <= cap) grid_blocks *= 2;
  }
  Params p{};
  p.xp = (const float*)d_in[0]; p.xs = (const float*)d_in[1]; p.memp = (const float*)d_in[2]; p.mems = (const float*)d_in[3];
  p.norm_g = (const float*)d_in[4]; p.w_in = (const float*)d_in[5]; p.w_out = (const float*)d_in[6]; p.mem_norm_g = (const float*)d_in[7];
  p.w_mem_kv = (const float*)d_in[8]; p.mem_qk_g = (const float*)d_in[9]; p.conv_w = (const float*)d_in[10]; p.swa_qk_g = (const float*)d_in[11];
  p.swa_sink = (const float*)d_in[12]; p.ax_qk_g = (const float*)d_in[13]; p.diff_qk_g = (const float*)d_in[14]; p.diff_lambda = (const float*)d_in[15];
  p.diff_subln_g = (const float*)d_in[16];
  p.out = (float*)d_out;
  char* w = (char*)d_ws; size_t off = 0;
  auto take = [&](size_t bytes) { char* r = w + off; off += (bytes + 255) & ~(size_t)255; return r; };
  p.u = (bf16_t*)take((size_t)NTOK * UW * 2);
  p.xb = (bf16_t*)take((size_t)NTOK * DM * 2);
  p.wt_in = (bf16_t*)take((size_t)4 * UW * DM * 2);
  p.wt_out = (bf16_t*)take((size_t)4 * DM * MIXW * 2);
  p.wt_mem = (bf16_t*)take((size_t)2048 * DM * 2);
  p.memb = (bf16_t*)take((size_t)4096 * DM * 2);
  p.memkv = (bf16_t*)take((size_t)4096 * 2048 * 2);
  p.rstd = (float*)take((size_t)NTOK * 4 * 2);
  p.rstd_mem = (float*)take(4096 * 4);
  p.tab1c = (float*)take(8192 * 32 * 4); p.tab1s = (float*)take(8192 * 32 * 4);
  p.tabac = (float*)take(128 * 16 * 4); p.tabas = (float*)take(128 * 16 * 4);
  p.lam = (float*)take(256);
  p.bar = (unsigned*)take(XB_WORDS * 4);
  if (off > ws_size) { fprintf(stderr, "workspace too small: need %zu have %zu\n", off, ws_size); return; }
#if MULTI_LAUNCH
  for (int ph = 0; ph < NPHASE; ++ph) {
    p.phase_lo = ph; p.phase_hi = ph + 1;
    hipLaunchKernelGGL(fwd_kernel, dim3(grid_blocks), dim3(NTHREADS), 0, stream, p);
  }
#else
  hipMemsetAsync(p.bar, 0, XB_WORDS * 4, stream);
  p.phase_lo = 0; p.phase_hi = NPHASE; p.probe = PROBE_ODD | (PROBE_EVEN << 1) | (PROBE_GIN << 2);
  void* args[] = {&p};
  hipError_t e = hipLaunchCooperativeKernel((void*)fwd_kernel, dim3(grid_blocks), dim3(NTHREADS), args, 0, stream);
  if (e != hipSuccess) fprintf(stderr, "cooperative launch failed: %s (grid %d)\n", hipGetErrorString(e), grid_blocks);
#endif
}
```

```cpp
#include <hip/hip_runtime.h>
#include <hip/hip_cooperative_groups.h>
#include <cstdint>
#include <cstdio>
namespace cg = cooperative_groups;

#ifndef MULTI_LAUNCH
#define MULTI_LAUNCH 0
#endif

#ifndef PROBE_ODD
#define PROBE_ODD 0
#endif
#ifndef PROBE_EVEN
#define PROBE_EVEN 0
#endif
#ifndef PROBE_GIN
#define PROBE_GIN 0
#endif
#define DI __device__ __forceinline__
#define LAS __attribute__((address_space(3)))
typedef unsigned short bf16_t;
typedef short bf16x8 __attribute__((ext_vector_type(8)));
typedef short s16x4 __attribute__((ext_vector_type(4)));
typedef float f32x16 __attribute__((ext_vector_type(16)));
typedef float f32x4 __attribute__((ext_vector_type(4)));
typedef unsigned u32x4 __attribute__((ext_vector_type(4)));
typedef unsigned u32x2 __attribute__((ext_vector_type(2)));

constexpr int NTOK = 98304, NTOKP = 65536, UW = 3840, DM = 1024, MIXW = 1280;
constexpr int NTHREADS = 512;
constexpr int AT = 256;
constexpr int LDS_BYTES = 131072 + 32768;
constexpr float EPSF = 1e-6f;
constexpr float LOG2E = 1.4426950408889634f;
constexpr int NPHASE = 13;

struct Params {
  const float *xp, *xs, *memp, *mems, *norm_g, *w_in, *w_out, *mem_norm_g, *w_mem_kv, *mem_qk_g, *conv_w, *swa_qk_g,
      *swa_sink, *ax_qk_g, *diff_qk_g, *diff_lambda, *diff_subln_g;
  float* out;
  bf16_t *u, *xb, *wt_in, *wt_out, *wt_mem, *memb, *memkv;
  float *rstd, *rstd_mem, *tab1c, *tab1s, *tabac, *tabas, *lam;
  unsigned* bar;
  int phase_lo, phase_hi, probe, pad_;
};

typedef __bf16 bf16x2_t __attribute__((ext_vector_type(2)));
typedef float f32x2 __attribute__((ext_vector_type(2)));
DI unsigned cvtpk(float lo, float hi) { f32x2 v = {lo, hi}; bf16x2_t b = __builtin_convertvector(v, bf16x2_t); return __builtin_bit_cast(unsigned, b); }
DI float bf2f(unsigned short b) { return __uint_as_float(((unsigned)b) << 16); }
DI float bflo(unsigned w) { return __uint_as_float(w << 16); }
DI float bfhi(unsigned w) { return __uint_as_float(w & 0xffff0000u); }
DI int ltid() { int t; asm volatile("v_mov_b32 %0, %1" : "=v"(t) : "v"(threadIdx.x)); return t; }
DI int crow(int i, int h) { return (i & 3) + 8 * (i >> 2) + 4 * h; }
DI float swapmax(float v) { auto rr = __builtin_amdgcn_permlane32_swap(__float_as_uint(v), __float_as_uint(v), false, false); return fmaxf(__uint_as_float(rr[0]), __uint_as_float(rr[1])); }
DI float swapsum(float v) { auto rr = __builtin_amdgcn_permlane32_swap(__float_as_uint(v), __float_as_uint(v), false, false); return __uint_as_float(rr[0]) + __uint_as_float(rr[1]); }
DI float shx(float v, int lane, int o) { return __int_as_float(__builtin_amdgcn_ds_bpermute(((lane ^ o) & 63) << 2, __float_as_int(v))); }
DI float silu(float z) { return z / (1.f + __expf(-z)); }
#define MFMA32(a, b, c) __builtin_amdgcn_mfma_f32_32x32x16_bf16((a), (b), (c), 0, 0, 0)

DI void tok_info(int t, int& S, int& seq0, int& pos, int& sq) {
  if (t < NTOKP) { S = 8192; seq0 = t & ~8191; pos = t & 8191; sq = t >> 13; }
  else { int tt = t - NTOKP; S = 4096; seq0 = NTOKP + (tt & ~4095); pos = tt & 4095; sq = 8 + (tt >> 12); }
}

DI void transpose_tile(char* lds, const float* src, const float* g, bf16_t* dst, int K, int N, int k0, int n0) {
  float* tile = (float*)lds;
  const int tid = ltid(), a = tid >> 6, b = tid & 63;
#pragma unroll 4
  for (int i = 0; i < 8; ++i) { int kk = i * 8 + a; float v = src[(size_t)(k0 + kk) * N + n0 + b]; if (g) v *= g[k0 + kk]; tile[kk * 65 + b] = v; }
  __syncthreads();
#pragma unroll 4
  for (int i = 0; i < 8; ++i) { int nn = i * 8 + a; float v = tile[b * 65 + nn]; dst[(size_t)(n0 + nn) * K + k0 + b] = (bf16_t)(cvtpk(v, v) & 0xffffu); }
  __syncthreads();
}

DI void norm_rows(const float* src, bf16_t* dst, float* ssq, int row_begin, int row_end, int gw, int nw) {
  const int lane = ltid() & 63;
  for (int row = row_begin + gw; row < row_end; row += nw) {
    const float* s = src + (size_t)(row - row_begin) * DM; bf16_t* d = dst + (size_t)row * DM;
    f32x4 v[4]; float ss = 0.f;
#pragma unroll
    for (int j = 0; j < 4; ++j) { v[j] = *(const f32x4*)(s + (lane + 64 * j) * 4); ss += v[j][0] * v[j][0] + v[j][1] * v[j][1] + v[j][2] * v[j][2] + v[j][3] * v[j][3]; }
#pragma unroll
    for (int o = 32; o > 0; o >>= 1) ss += shx(ss, lane, o);
    const float rs = ssq ? 1.f : rsqrtf(ss * (1.f / DM) + EPSF);
#pragma unroll
    for (int j = 0; j < 4; ++j) { u32x2 w; w.x = cvtpk(v[j][0] * rs, v[j][1] * rs); w.y = cvtpk(v[j][2] * rs, v[j][3] * rs); *(u32x2*)(d + (lane + 64 * j) * 4) = w; }
    if (ssq && lane == 0) ssq[row] = ss;
  }
}

DI void phase_prep(char* lds, const Params& p) {
  const int T_IN = 4 * 16 * 60, T_OUT = 4 * 20 * 16, T_MEM = 4 * 16 * 8;
  for (int t = blockIdx.x; t < T_IN + T_OUT + T_MEM; t += gridDim.x) {
    if (t < T_IN) { int l = t / 960, r = t % 960, kt = r / 60, nt = r % 60;
      transpose_tile(lds, p.w_in + (size_t)l * DM * UW, p.norm_g + l * DM, p.wt_in + (size_t)l * UW * DM, DM, UW, kt * 64, nt * 64); }
    else if (t < T_IN + T_OUT) { int tt = t - T_IN; int l = tt / 320, r = tt % 320, kt = r / 16, nt = r % 16;
      transpose_tile(lds, p.w_out + (size_t)l * MIXW * DM, nullptr, p.wt_out + (size_t)l * DM * MIXW, MIXW, DM, kt * 64, nt * 64); }
    else { int tt = t - T_IN - T_OUT; int l = tt / 128, r = tt % 128, kt = r / 8, nt = r % 8;
      transpose_tile(lds, p.w_mem_kv + (size_t)l * DM * 512, p.mem_norm_g + l * DM, p.wt_mem + (size_t)l * 512 * DM, DM, 512, kt * 64, nt * 64); }
  }
  const int gw = blockIdx.x * 8 + (ltid() >> 6), nw = gridDim.x * 8;
  norm_rows(p.memp, p.memb, nullptr, 0, 2048, gw, nw);
  norm_rows(p.mems, p.memb, nullptr, 2048, 4096, gw, nw);
  norm_rows(p.xp, p.xb, p.rstd, 0, NTOKP, gw, nw);
  norm_rows(p.xs, p.xb, p.rstd, NTOKP, NTOK, gw, nw);
  const int gt = blockIdx.x * NTHREADS + ltid(), nt_ = gridDim.x * NTHREADS;
  for (int i = gt; i < 8192 * 32; i += nt_) { int pos = i >> 5, f = i & 31; float inv = powf(10000.f, -(float)(2 * f) / 64.f); float ang = (float)pos * inv; p.tab1c[i] = cosf(ang); p.tab1s[i] = sinf(ang); }
  for (int i = gt; i < 128 * 16; i += nt_) { int pos = i >> 4, f = i & 15; float inv = powf(10000.f, -(float)(2 * f) / 32.f); float ang = (float)pos * inv; p.tabac[i] = cosf(ang); p.tabas[i] = sinf(ang); }
  if (blockIdx.x == 0 && ltid() < 64) {
    const int lane = ltid();
    for (int o = 0; o < 2; ++o) {
      const float* lv = p.diff_lambda + o * 256;
      float a = lv[lane] * lv[64 + lane], b = lv[128 + lane] * lv[192 + lane];
#pragma unroll
      for (int s = 32; s > 0; s >>= 1) { a += shx(a, lane, s); b += shx(b, lane, s); }
      float li = 0.8f - 0.6f * expf(-0.3f * (float)(2 * o + 1));
      if (lane == 0) { p.lam[o * 2] = expf(a) - expf(b) + li; p.lam[o * 2 + 1] = 1.f - li; }
      float g0 = fabsf(p.ax_qk_g[o * 128 + lane]), g1 = fabsf(p.ax_qk_g[o * 128 + 64 + lane]);
      float g2 = fabsf(p.diff_qk_g[o * 128 + lane]), g3 = fabsf(p.diff_qk_g[o * 128 + 64 + lane]);
#pragma unroll
      for (int s = 32; s > 0; s >>= 1) { g0 = fmaxf(g0, shx(g0, lane, s)); g1 = fmaxf(g1, shx(g1, lane, s)); g2 = fmaxf(g2, shx(g2, lane, s)); g3 = fmaxf(g3, shx(g3, lane, s)); }
      if (lane == 0) { p.lam[8 + o * 2] = 8.f * g0 * g1 * 1.02f * LOG2E; p.lam[8 + o * 2 + 1] = 8.f * g2 * g3 * 1.02f * LOG2E; }
    }
  }
}

struct GemmDesc { const bf16_t* A; const bf16_t* Bt; int lda, K, mtiles, ntiles, remap, seg2; };
enum { EPI_IN = 0, EPI_MEM = 1, EPI_OUT = 2 };

DI void head_store(f32x16 v0, f32x16 v1, float rs, int mode, const float* gain, const Params& p, int pos, bf16_t* obase, int ldo, char* stg_wg) {
  const int tid_ = ltid(), lane = tid_ & 63, r = lane & 31, h = lane >> 5;
  char* stg = stg_wg + (tid_ >> 6) * 4096;
  v0 *= rs; v1 *= rs;
  if (mode) {
    float ss = 0.f;
#pragma unroll
    for (int i = 0; i < 16; ++i) ss += v0[i] * v0[i] + v1[i] * v1[i];
    ss = swapsum(ss);
    const float inv = rsqrtf(ss * (1.f / 64.f) + EPSF);
#pragma unroll
    for (int g4 = 0; g4 < 4; ++g4) {
      const f32x4 ga = *(const f32x4*)(gain + 8 * g4 + 4 * h), gb = *(const f32x4*)(gain + 32 + 8 * g4 + 4 * h);
#pragma unroll
      for (int j = 0; j < 4; ++j) { v0[4 * g4 + j] *= inv * ga[j]; v1[4 * g4 + j] *= inv * gb[j]; }
    }
    if (mode == 2) {
#pragma unroll
      for (int g4 = 0; g4 < 4; ++g4) {
        const f32x4 c = *(const f32x4*)(p.tab1c + pos * 32 + 8 * g4 + 4 * h), s = *(const f32x4*)(p.tab1s + pos * 32 + 8 * g4 + 4 * h);
#pragma unroll
        for (int j = 0; j < 4; ++j) { const int i = 4 * g4 + j; const float x1 = v0[i], x2 = v1[i]; v0[i] = x1 * c[j] - x2 * s[j]; v1[i] = x2 * c[j] + x1 * s[j]; }
      }
    } else if (mode == 3) {
      const int row = pos >> 6, col = pos & 63;
#pragma unroll
      for (int g4 = 0; g4 < 2; ++g4) {
        const f32x4 c0 = *(const f32x4*)(p.tabac + row * 16 + 8 * g4 + 4 * h), s0 = *(const f32x4*)(p.tabas + row * 16 + 8 * g4 + 4 * h);
        const f32x4 c1 = *(const f32x4*)(p.tabac + col * 16 + 8 * g4 + 4 * h), s1 = *(const f32x4*)(p.tabas + col * 16 + 8 * g4 + 4 * h);
#pragma unroll
        for (int j = 0; j < 4; ++j) { const int i = 4 * g4 + j;
          float x1 = v0[i], x2 = v0[i + 8]; v0[i] = x1 * c0[j] - x2 * s0[j]; v0[i + 8] = x2 * c0[j] + x1 * s0[j];
          x1 = v1[i]; x2 = v1[i + 8]; v1[i] = x1 * c1[j] - x2 * s1[j]; v1[i + 8] = x2 * c1[j] + x1 * s1[j]; }
      }
    }
  }
#pragma unroll
  for (int g4 = 0; g4 < 4; ++g4) {
    u32x2 w0, w1; w0.x = cvtpk(v0[4 * g4], v0[4 * g4 + 1]); w0.y = cvtpk(v0[4 * g4 + 2], v0[4 * g4 + 3]);
    w1.x = cvtpk(v1[4 * g4], v1[4 * g4 + 1]); w1.y = cvtpk(v1[4 * g4 + 2], v1[4 * g4 + 3]);
    *(u32x2*)(stg + r * 128 + ((g4 ^ (r & 7)) << 4) + h * 8) = w0;
    *(u32x2*)(stg + r * 128 + (((4 + g4) ^ (r & 7)) << 4) + h * 8) = w1;
  }
#pragma unroll
  for (int j = 0; j < 4; ++j) {
    const int row = (lane >> 3) + 8 * j, ch = lane & 7;
    const u32x4 w = *(const u32x4*)(stg + row * 128 + ((ch ^ (row & 7)) << 4));
    *(u32x4*)(obase + (size_t)row * ldo + ch * 8) = w;
  }
}

DI int in_mode(const Params& p, int layer, int n_h, const float*& gain) {
  int mode = 0; gain = p.mem_qk_g;
  if ((layer & 1) == 0) { const int e = layer >> 1;
    if (n_h >= 1536 && n_h < 2048) { mode = 2; gain = p.swa_qk_g + (e * 2) * 64; }
    else if (n_h >= 2048 && n_h < 2176) { mode = 2; gain = p.swa_qk_g + (e * 2 + 1) * 64; }
    else if (n_h >= 2304 && n_h < 2560) { mode = 1; gain = p.mem_qk_g + (layer * 2) * 64; }
  } else { const int o = layer >> 1;
    if (n_h < 512) { mode = 3; gain = p.ax_qk_g + (o * 2) * 64; }
    else if (n_h < 640) { mode = 3; gain = p.ax_qk_g + (o * 2 + 1) * 64; }
    else if (n_h >= 768 && n_h < 1280) { mode = 2; gain = p.diff_qk_g + (o * 2) * 64; }
    else if (n_h >= 1280 && n_h < 1792) { mode = 2; gain = p.diff_qk_g + (o * 2 + 1) * 64; }
    else if (n_h >= 2304 && n_h < 2560) { mode = 1; gain = p.mem_qk_g + (layer * 2) * 64; }
  }
  return mode;
}

template <int EPI>
DI void gemm_phase(char* lds, const Params& p, const GemmDesc g, int layer) {
  const int tid = ltid(), lane = tid & 63, wid = tid >> 6, wm = wid >> 1, wn = wid & 1, r = lane & 31, h = lane >> 5;
  const int srow = tid >> 3, sch = tid & 7;
  const int soff = srow * 128 + ((sch ^ ((srow >> 1) & 7)) << 4);
  const int nk = g.K >> 6;
  const int ntile = g.mtiles * g.ntiles;
  const bool banded = ((gridDim.x & 7) == 0) && ((g.mtiles & 63) == 0);
  const int nx = banded ? 8 : 1, bx = blockIdx.x % nx, bi = blockIdx.x / nx, nbx = gridDim.x / nx;
  const int per_band = 8 * g.ntiles;
  const int qtot = ntile / nx;
  int q = bi;
  if (q >= qtot) return;
  int mt, nt;
#define G_TILE(qq, MT, NT) do { if (banded) { const int bl_ = (qq) / per_band, rem_ = (qq) - bl_ * per_band; NT = rem_ >> 3; MT = (bl_ * 8 + bx) * 8 + (rem_ & 7); } \
    else { MT = (qq) / g.ntiles; NT = (qq) - MT * g.ntiles; } } while (0)
#define G_LOAD(AG, BG, kt, RA, RB) do { const int k0_ = (kt) * 64; int ac_ = k0_; if (g.remap) ac_ = k0_ < 512 ? k0_ : (k0_ < 1024 ? g.seg2 + k0_ - 512 : 2304 + k0_ - 1024); \
    _Pragma("unroll") for (int i = 0; i < 4; ++i) { RA[i] = *(const u32x4*)(AG + (size_t)(64 * i) * g.lda + ac_); RB[i] = *(const u32x4*)(BG + (size_t)(64 * i) * g.K + k0_); } } while (0)
#define G_WRITE(buf, RA, RB) do { _Pragma("unroll") for (int i = 0; i < 4; ++i) { *(u32x4*)(lds + (buf) * 65536 + i * 8192 + soff) = RA[i]; *(u32x4*)(lds + (buf) * 65536 + 32768 + i * 8192 + soff) = RB[i]; } } while (0)
#define G_COMPUTE(buf) do { _Pragma("unroll") for (int ks = 0; ks < 4; ++ks) { const int co_ = ((2 * ks + h) ^ ((r >> 1) & 7)) << 4; \
      const char* la_ = lds + (buf) * 65536 + (wm * 64 + r) * 128 + co_; const char* lb_ = lds + (buf) * 65536 + 32768 + (wn * 128 + r) * 128 + co_; \
      bf16x8 fa_[2], fb_[4]; fa_[0] = *(const bf16x8*)(la_); fa_[1] = *(const bf16x8*)(la_ + 4096); \
      _Pragma("unroll") for (int ni = 0; ni < 4; ++ni) fb_[ni] = *(const bf16x8*)(lb_ + ni * 4096); \
      _Pragma("unroll") for (int ni = 0; ni < 4; ++ni) { acc[0][ni] = MFMA32(fb_[ni], fa_[0], acc[0][ni]); acc[1][ni] = MFMA32(fb_[ni], fa_[1], acc[1][ni]); } } } while (0)
  G_TILE(q, mt, nt);
  const bf16_t* Ag = g.A + (size_t)(mt * 256 + srow) * g.lda + sch * 8;
  const bf16_t* Bg = g.Bt + (size_t)(nt * 256 + srow) * g.K + sch * 8;
  u32x4 ra0[4], rb0[4];
  G_LOAD(Ag, Bg, 0, ra0, rb0); G_WRITE(0, ra0, rb0); G_LOAD(Ag, Bg, 1, ra0, rb0); __syncthreads();
  for (;;) {
    const int qn = q + nbx; const bool has_next = qn < qtot;
    int mtn = mt, ntn = nt; if (has_next) G_TILE(qn, mtn, ntn);
    const bf16_t* Agn = g.A + (size_t)(mtn * 256 + srow) * g.lda + sch * 8;
    const bf16_t* Bgn = g.Bt + (size_t)(ntn * 256 + srow) * g.K + sch * 8;
    f32x16 acc[2][4];
#pragma unroll
    for (int a = 0; a < 2; ++a)
#pragma unroll
      for (int b = 0; b < 4; ++b)
#pragma unroll
        for (int i = 0; i < 16; ++i) acc[a][b][i] = 0.f;
    for (int kt = 0; kt < nk; kt += 2) {
      const bool last = kt + 2 >= nk;
      G_WRITE(1, ra0, rb0);
      if (!last) G_LOAD(Ag, Bg, kt + 2, ra0, rb0); else if (has_next) G_LOAD(Agn, Bgn, 0, ra0, rb0);
      G_COMPUTE(0);
      __syncthreads();
      if (!last || has_next) G_WRITE(0, ra0, rb0);
      if (!last) G_LOAD(Ag, Bg, kt + 3, ra0, rb0); else if (has_next) G_LOAD(Agn, Bgn, 1, ra0, rb0);
      G_COMPUTE(1);
      __syncthreads();
    }
    const int n_w = nt * 256 + wn * 128;
    if (EPI == EPI_IN) {
#pragma unroll
      for (int hu = 0; hu < 2; ++hu) {
        const int n_h = n_w + 64 * hu; const float* gain; const int mode = in_mode(p, layer, n_h, gain);
#pragma unroll
        for (int mi = 0; mi < 2; ++mi) {
          const int t = mt * 256 + wm * 64 + mi * 32 + r;
          int S, seq0, pos, sq; tok_info(t, S, seq0, pos, sq);
          const float rs = rsqrtf(p.rstd[(layer & 1) * NTOK + t] * (1.f / DM) + EPSF);
          head_store(acc[mi][2 * hu], acc[mi][2 * hu + 1], rs, mode, gain, p, pos, p.u + (size_t)(t - r) * UW + n_h, UW, lds + 131072);
        }
      }
    } else if (EPI == EPI_MEM) {
#pragma unroll
      for (int hu = 0; hu < 2; ++hu) {
        const int n_h = n_w + 64 * hu, l = n_h >> 9, c = n_h & 511;
        const int mode = c < 256 ? 1 : 0; const float* gain = p.mem_qk_g + (l * 2 + 1) * 64;
#pragma unroll
        for (int mi = 0; mi < 2; ++mi) {
          const int row = mt * 256 + wm * 64 + mi * 32 + r;
          head_store(acc[mi][2 * hu], acc[mi][2 * hu + 1], 1.f, mode, gain, p, 0, p.memkv + (size_t)(row - r) * 2048 + n_h, 2048, lds + 131072);
        }
      }
    } else {
      const int tid_ = ltid(), lane = tid_ & 63, r = lane & 31, h = lane >> 5;
      char* stg = lds + 131072 + (tid_ >> 6) * 4096;
#pragma unroll
      for (int mi = 0; mi < 2; ++mi) {
        const int t0 = mt * 256 + wm * 64 + mi * 32;
        const float* xin0 = layer == 0 ? (t0 < NTOKP ? p.xp + (size_t)t0 * DM : p.xs + (size_t)(t0 - NTOKP) * DM) : p.out + (size_t)t0 * DM;
        float* xo0 = p.out + (size_t)t0 * DM;
        bf16_t* xb0 = p.xb + (size_t)t0 * DM;
        float ssj[4] = {0.f, 0.f, 0.f, 0.f};
#pragma unroll
        for (int ni = 0; ni < 4; ++ni) {
#pragma unroll
          for (int g4 = 0; g4 < 4; ++g4) {
            f32x4 v; v[0] = acc[mi][ni][4 * g4]; v[1] = acc[mi][ni][4 * g4 + 1]; v[2] = acc[mi][ni][4 * g4 + 2]; v[3] = acc[mi][ni][4 * g4 + 3];
            *(f32x4*)(stg + r * 128 + (((2 * g4 + h) ^ (r & 7)) << 4)) = v;
          }
#pragma unroll
          for (int j = 0; j < 4; ++j) {
            const int row = (lane >> 3) + 8 * j, ch = lane & 7;
            const f32x4 a = *(const f32x4*)(stg + row * 128 + ((ch ^ (row & 7)) << 4));
            const size_t off = (size_t)row * DM + n_w + ni * 32 + ch * 4;
            f32x4 xv = *(const f32x4*)(xin0 + off);
            xv += a;
            *(f32x4*)(xo0 + off) = xv;
            if (layer < 3) {
              u32x2 w; w.x = cvtpk(xv[0], xv[1]); w.y = cvtpk(xv[2], xv[3]);
              *(u32x2*)(xb0 + off) = w;
              ssj[j] += xv[0] * xv[0] + xv[1] * xv[1] + xv[2] * xv[2] + xv[3] * xv[3];
            }
          }
        }
        if (layer < 3) {
#pragma unroll
          for (int j = 0; j < 4; ++j) {
            float v = ssj[j];
            v += shx(v, lane, 1); v += shx(v, lane, 2); v += shx(v, lane, 4);
            if ((lane & 7) == 0) atomicAdd(p.rstd + ((layer + 1) & 1) * NTOK + t0 + (lane >> 3) + 8 * j, v);
          }
        }
      }
    }
    if (!has_next) break;
    q = qn; mt = mtn; nt = ntn; Ag = Agn; Bg = Bgn;
  }
#undef G_TILE
#undef G_LOAD
#undef G_WRITE
#undef G_COMPUTE
}

enum { AM_PLAIN = 0, AM_SWA = 1, AM_DIFF = 2 };
struct AttnJob {
  const bf16_t* q;
  const bf16_t* k[2];
  const bf16_t* v;
  int ldk, ldv;
  int tile_lo, tile_hi;
  float m_init, l_init;
  int qpos0;
  bf16_t* o;
  const bf16_t* z;
  float lam, oscale;
  const float* subg;
  int dry;
};

template <int DV, int MODE>
DI void attn_finalize(char* lds, const AttnJob& J, f32x16 (&O)[DV / 32], const float lt, const int wid, const int r, const int h) {
  constexpr int NDV = DV / 32;
  const float inv = 1.f / lt;
  if (MODE != AM_DIFF) {
    bf16_t* orow = J.o + (size_t)r * UW; const bf16_t* zrow = J.z + (size_t)r * UW;
#pragma unroll
    for (int d = 0; d < NDV; ++d)
#pragma unroll
      for (int g4 = 0; g4 < 4; ++g4) {
        const int dv = 32 * d + 8 * g4 + 4 * h;
        const u32x2 zw = *(const u32x2*)(zrow + dv);
        const float y0 = O[d][4 * g4] * inv * silu(bflo(zw.x)), y1 = O[d][4 * g4 + 1] * inv * silu(bfhi(zw.x));
        const float y2 = O[d][4 * g4 + 2] * inv * silu(bflo(zw.y)), y3 = O[d][4 * g4 + 3] * inv * silu(bfhi(zw.y));
        u32x2 w; w.x = cvtpk(y0, y1); w.y = cvtpk(y2, y3);
        *(u32x2*)(orow + dv) = w;
      }
  } else {
    float* sc = (float*)(lds + 32768) + (wid >> 1) * (DV * 32);
    if (wid & 1) {
      const float f = inv * J.lam;
#pragma unroll
      for (int d = 0; d < NDV; ++d)
#pragma unroll
        for (int i = 0; i < 16; ++i) sc[(32 * d + crow(i, h)) * 32 + r] = O[d][i] * f;
    }
    __syncthreads();
    if (!(wid & 1)) {
      float ss = 0.f;
#pragma unroll
      for (int d = 0; d < NDV; ++d)
#pragma unroll
        for (int i = 0; i < 16; ++i) { const float a = O[d][i] * inv - sc[(32 * d + crow(i, h)) * 32 + r]; O[d][i] = a; ss += a * a; }
      ss = swapsum(ss);
      const float rn = rsqrtf(ss * (1.f / DV) + EPSF) * J.oscale;
      bf16_t* orow = J.o + (size_t)r * UW; const bf16_t* zrow = J.z + (size_t)r * UW;
#pragma unroll
      for (int d = 0; d < NDV; ++d)
#pragma unroll
        for (int g4 = 0; g4 < 4; ++g4) {
          const int dv = 32 * d + 8 * g4 + 4 * h;
          const u32x2 zw = *(const u32x2*)(zrow + dv);
          const f32x4 sg = *(const f32x4*)(J.subg + dv);
          const float y0 = O[d][4 * g4] * rn * sg[0] * silu(bflo(zw.x)), y1 = O[d][4 * g4 + 1] * rn * sg[1] * silu(bfhi(zw.x));
          const float y2 = O[d][4 * g4 + 2] * rn * sg[2] * silu(bflo(zw.y)), y3 = O[d][4 * g4 + 3] * rn * sg[3] * silu(bfhi(zw.y));
          u32x2 w; w.x = cvtpk(y0, y1); w.y = cvtpk(y2, y3);
          *(u32x2*)(orow + dv) = w;
        }
    }
  }
}

template <int DV, int NK, int MODE, bool FIXM, int GRP>
DI void attn_job(char* lds_wg, const AttnJob& J) {
  constexpr int NDV = DV / 32;
  constexpr float C = 0.125f * LOG2E;
  const int tid_wg = ltid(), tid = tid_wg & (AT - 1), lane = tid & 63, wid = tid >> 6, r = lane & 31, h = lane >> 5;
  constexpr bool SHR = FIXM && MODE != AM_DIFF;
  constexpr int STN = SHR ? NTHREADS : AT;
  char* lds = lds_wg + (SHR ? 0 : GRP * 65536);
  const int st_ = SHR ? tid_wg : tid;
  const int kstream = (NK == 2) ? (wid & 1) : 0;
  bf16x8 qf[4];
  const bf16_t* qrow = J.q + (size_t)r * UW + 8 * h;
#pragma unroll
  for (int ds = 0; ds < 4; ++ds) qf[ds] = *(const bf16x8*)(qrow + 16 * ds);
  f32x16 O[NDV];
#pragma unroll
  for (int d = 0; d < NDV; ++d)
#pragma unroll
    for (int i = 0; i < 16; ++i) O[d][i] = 0.f;
  float m = J.m_init, l = (h == 0) ? J.l_init : 0.f;
  f32x16 Osum;
#pragma unroll
  for (int i = 0; i < 16; ++i) Osum[i] = 0.f;
  const bf16x8 ones = {0x3F80, 0x3F80, 0x3F80, 0x3F80, 0x3F80, 0x3F80, 0x3F80, 0x3F80};
  constexpr int KI = 512 / STN;
  const int ksrow = st_ >> 3, ksch = st_ & 7;
  const int kpi = (ksrow & ~12) | ((ksrow & 4) << 1) | ((ksrow & 8) >> 1);
  const int ksoff = kpi * 128 + ((ksch ^ ((kpi >> 1) & 7)) << 4);
  constexpr int VCH = DV / 8;
  constexpr int VI = (64 * VCH) / STN;
  const int vkey0 = st_ / VCH, vc8 = (st_ % VCH) * 8;
  u32x4 rk0[NK][KI], rv0[VI], rk1[NK][KI], rv1[VI];
#define A_LOAD(t, rk, rv) do { const size_t kb_ = (size_t)(t) * 64; \
    _Pragma("unroll") for (int s = 0; s < NK; ++s) _Pragma("unroll") for (int i = 0; i < KI; ++i) rk[s][i] = *(const u32x4*)(J.k[s] + (kb_ + ksrow + 32 * i) * J.ldk + ksch * 8); \
    _Pragma("unroll") for (int i = 0; i < VI; ++i) rv[i] = *(const u32x4*)(J.v + (kb_ + vkey0 + (STN / VCH) * i) * J.ldv + vc8); } while (0)
#define A_WRITE(st, rk, rv) do { char* b_ = lds + (st) * 32768; \
    _Pragma("unroll") for (int s = 0; s < NK; ++s) _Pragma("unroll") for (int i = 0; i < KI; ++i) *(u32x4*)(b_ + s * 8192 + i * 4096 + ksoff) = rk[s][i]; \
    _Pragma("unroll") for (int i = 0; i < VI; ++i) { const int key_ = vkey0 + (STN / VCH) * i; \
      *(u32x4*)(b_ + NK * 8192 + ((key_ >> 3) * NDV + (vc8 >> 5)) * 512 + (key_ & 7) * 64 + (vc8 & 31) * 2) = rv[i]; } } while (0)
  const int nt = J.tile_hi - J.tile_lo;
  constexpr bool DEEP2 = FIXM || MODE != AM_DIFF;
  constexpr bool ONESET = FIXM;
  A_LOAD(J.tile_lo, rk0, rv0); A_WRITE(0, rk0, rv0); if (ONESET) A_LOAD(J.tile_lo + 1, rk0, rv0); else if (DEEP2) A_LOAD(J.tile_lo + 1, rk1, rv1); __syncthreads();
  const int i16 = lane & 15;
  const int vrd = h * NDV * 512 + (i16 >> 2) * 64 + (((lane >> 4) & 1) * 16 + (i16 & 3) * 4) * 2;
  auto compute = [&](const int stage, const int tile) __attribute__((always_inline)) {
    bool active = true;
    if (MODE == AM_SWA) { const int k0 = tile * 64; active = !(k0 > J.qpos0 + 31 + 128 || k0 + 63 < J.qpos0 - 128); }
    if (active) {
      const char* Kl = lds + stage * 32768 + kstream * 8192 + r * 128;
      f32x16 sA, sB;
#pragma unroll
      for (int i = 0; i < 16; ++i) { sA[i] = 0.f; sB[i] = 0.f; }
      if (NDV == 2 || FIXM) {
        bf16x8 ka[4], kb[4];
#pragma unroll
        for (int ds = 0; ds < 4; ++ds) { const int co = ((2 * ds + h) ^ ((r >> 1) & 7)) << 4; ka[ds] = *(const bf16x8*)(Kl + co); kb[ds] = *(const bf16x8*)(Kl + 4096 + co); }
#pragma unroll
        for (int ds = 0; ds < 4; ++ds) { sA = MFMA32(ka[ds], qf[ds], sA); sB = MFMA32(kb[ds], qf[ds], sB); }
        __builtin_amdgcn_sched_group_barrier(0x100, 4, 0); __builtin_amdgcn_sched_group_barrier(0x008, 2, 0);
        __builtin_amdgcn_sched_group_barrier(0x100, 2, 0); __builtin_amdgcn_sched_group_barrier(0x008, 2, 0);
        __builtin_amdgcn_sched_group_barrier(0x100, 2, 0); __builtin_amdgcn_sched_group_barrier(0x008, 4, 0);
      } else {
#pragma unroll
        for (int ds = 0; ds < 4; ++ds) {
          const int co = ((2 * ds + h) ^ ((r >> 1) & 7)) << 4;
          const bf16x8 ka = *(const bf16x8*)(Kl + co), kb = *(const bf16x8*)(Kl + 4096 + co);
          sA = MFMA32(ka, qf[ds], sA); sB = MFMA32(kb, qf[ds], sB);
        }
      }
      if (MODE == AM_SWA) {
        const int qa = J.qpos0 + r, kbase = tile * 64 + 8 * h;
#pragma unroll
        for (int i = 0; i < 16; ++i) {
          const int ka_ = kbase + 16 * (i >> 3) + (i & 7);
          int d0 = qa - ka_; d0 = d0 < 0 ? -d0 : d0; if (d0 > 128) sA[i] = -INFINITY;
          int d1 = qa - (ka_ + 32); d1 = d1 < 0 ? -d1 : d1; if (d1 > 128) sB[i] = -INFINITY;
        }
      }
      if (FIXM) {
        const float nm = -J.m_init;
#pragma unroll
        for (int i = 0; i < 16; ++i) { sA[i] = __builtin_amdgcn_exp2f(fmaf(sA[i], C, nm)); sB[i] = __builtin_amdgcn_exp2f(fmaf(sB[i], C, nm)); l += sA[i] + sB[i]; }
      } else {
      float mx = sA[0];
#pragma unroll
      for (int i = 1; i < 16; ++i) mx = fmaxf(mx, sA[i]);
#pragma unroll
      for (int i = 0; i < 16; ++i) mx = fmaxf(mx, sB[i]);
      mx = swapmax(mx);
      const float mn = fmaxf(m, mx * C);
      const float alpha = __builtin_amdgcn_exp2f(m - mn);
      m = mn;
      float ps = 0.f;
#pragma unroll
      for (int i = 0; i < 16; ++i) { sA[i] = __builtin_amdgcn_exp2f(fmaf(sA[i], C, -mn)); sB[i] = __builtin_amdgcn_exp2f(fmaf(sB[i], C, -mn)); ps += sA[i] + sB[i]; }
      l = l * alpha + ps;
#pragma unroll
      for (int d = 0; d < NDV; ++d)
#pragma unroll
        for (int i = 0; i < 16; ++i) O[d][i] *= alpha;
      }
      bf16x8 pf[4];
      { u32x4 w;
        w.x = cvtpk(sA[0], sA[1]); w.y = cvtpk(sA[2], sA[3]); w.z = cvtpk(sA[4], sA[5]); w.w = cvtpk(sA[6], sA[7]); pf[0] = __builtin_bit_cast(bf16x8, w);
        w.x = cvtpk(sA[8], sA[9]); w.y = cvtpk(sA[10], sA[11]); w.z = cvtpk(sA[12], sA[13]); w.w = cvtpk(sA[14], sA[15]); pf[1] = __builtin_bit_cast(bf16x8, w);
        w.x = cvtpk(sB[0], sB[1]); w.y = cvtpk(sB[2], sB[3]); w.z = cvtpk(sB[4], sB[5]); w.w = cvtpk(sB[6], sB[7]); pf[2] = __builtin_bit_cast(bf16x8, w);
        w.x = cvtpk(sB[8], sB[9]); w.y = cvtpk(sB[10], sB[11]); w.z = cvtpk(sB[12], sB[13]); w.w = cvtpk(sB[14], sB[15]); pf[3] = __builtin_bit_cast(bf16x8, w); }
      const char* Vl = lds + stage * 32768 + NK * 8192 + vrd;
      if (FIXM) {
        bf16x8 vf[4][NDV];
#pragma unroll
        for (int ks = 0; ks < 4; ++ks) {
#pragma unroll
          for (int d = 0; d < NDV; ++d) {
            const s16x4 lo = __builtin_amdgcn_ds_read_tr16_b64_v4i16((LAS s16x4*)(Vl + ks * 2 * NDV * 512 + d * 512));
            const s16x4 hi = __builtin_amdgcn_ds_read_tr16_b64_v4i16((LAS s16x4*)(Vl + ks * 2 * NDV * 512 + d * 512 + 256));
            vf[ks][d] = __builtin_shufflevector(lo, hi, 0, 1, 2, 3, 4, 5, 6, 7);
          }
        }
#pragma unroll
        for (int ks = 0; ks < 4; ++ks) {
#pragma unroll
          for (int d = 0; d < NDV; ++d) O[d] = MFMA32(vf[ks][d], pf[ks], O[d]);
        }
        __builtin_amdgcn_sched_group_barrier(0x100, 4 * NDV, 0); __builtin_amdgcn_sched_group_barrier(0x008, NDV, 0);
        __builtin_amdgcn_sched_group_barrier(0x100, 2 * NDV, 0); __builtin_amdgcn_sched_group_barrier(0x008, NDV, 0);
        __builtin_amdgcn_sched_group_barrier(0x100, 2 * NDV, 0); __builtin_amdgcn_sched_group_barrier(0x008, 2 * NDV, 0);
      } else {
      if (FIXM) {
#pragma unroll
        for (int ks = 0; ks < 4; ++ks) Osum = MFMA32(ones, pf[ks], Osum);
      }
#pragma unroll
      for (int ks = 0; ks < 4; ++ks)
#pragma unroll
        for (int d = 0; d < NDV; ++d) {
          const s16x4 lo = __builtin_amdgcn_ds_read_tr16_b64_v4i16((LAS s16x4*)(Vl + ks * 2 * NDV * 512 + d * 512));
          const s16x4 hi = __builtin_amdgcn_ds_read_tr16_b64_v4i16((LAS s16x4*)(Vl + ks * 2 * NDV * 512 + d * 512 + 256));
          const bf16x8 vf = __builtin_shufflevector(lo, hi, 0, 1, 2, 3, 4, 5, 6, 7);
          O[d] = MFMA32(vf, pf[ks], O[d]);
        }
      }
    }
  };
  for (int it = 0; it < nt; it += 2) {
    if (ONESET) {
      A_WRITE(1, rk0, rv0);
      if (it + 2 < nt) A_LOAD(J.tile_lo + it + 2, rk0, rv0);
      compute(0, J.tile_lo + it);
      __syncthreads();
      if (it + 2 < nt) A_WRITE(0, rk0, rv0);
      if (it + 3 < nt) A_LOAD(J.tile_lo + it + 3, rk0, rv0);
      compute(1, J.tile_lo + it + 1);
      __syncthreads();
    } else if (DEEP2) {
      if (it + 2 < nt) A_LOAD(J.tile_lo + it + 2, rk0, rv0);
      compute(0, J.tile_lo + it);
      A_WRITE(1, rk1, rv1);
      __syncthreads();
      if (it + 3 < nt) A_LOAD(J.tile_lo + it + 3, rk1, rv1);
      compute(1, J.tile_lo + it + 1);
      if (it + 2 < nt) A_WRITE(0, rk0, rv0);
      __syncthreads();
    } else {
      compute(0, J.tile_lo + it);
      __builtin_amdgcn_sched_barrier(0);
      A_LOAD(J.tile_lo + it + 1, rk0, rv0); A_WRITE(1, rk0, rv0);
      __syncthreads();
      compute(1, J.tile_lo + it + 1);
      __builtin_amdgcn_sched_barrier(0);
      if (it + 2 < nt) { A_LOAD(J.tile_lo + it + 2, rk0, rv0); A_WRITE(0, rk0, rv0); }
      __syncthreads();
    }
  }
#undef A_LOAD
#undef A_WRITE
  if (J.dry) return;
  const float lt = swapsum(l);
  attn_finalize<DV, MODE>(SHR ? lds_wg + 32768 + GRP * 32768 : lds, J, O, lt, wid, r, h);
}

template <int DV, int NK, int MODE, int GRP>
DI void attn_pipe(char* lds_wg, const AttnJob& J) {
  constexpr int NDV = DV / 32;
  constexpr float C = 0.125f * LOG2E;
  constexpr int KST = NK * 8192, VST = DV * 128, VB = 2 * KST;
  const int tid_wg = ltid(), tid = tid_wg & (AT - 1), lane = tid & 63, wid = tid >> 6, r = lane & 31, h = lane >> 5;
  char* lds = lds_wg + GRP * 65536;
  const int kstream = (NK == 2) ? (wid & 1) : 0;
  bf16x8 qf[4];
  const bf16_t* qrow = J.q + (size_t)r * UW + 8 * h;
#pragma unroll
  for (int ds = 0; ds < 4; ++ds) qf[ds] = *(const bf16x8*)(qrow + 16 * ds);
  f32x16 O[NDV], Osum;
#pragma unroll
  for (int d = 0; d < NDV; ++d)
#pragma unroll
    for (int i = 0; i < 16; ++i) O[d][i] = 0.f;
#pragma unroll
  for (int i = 0; i < 16; ++i) Osum[i] = 0.f;
  const bf16x8 ones = {0x3F80, 0x3F80, 0x3F80, 0x3F80, 0x3F80, 0x3F80, 0x3F80, 0x3F80};
  const float nm = -J.m_init;
  const int ksrow = tid >> 3, ksch = tid & 7;
  const int kpi = (ksrow & ~12) | ((ksrow & 4) << 1) | ((ksrow & 8) >> 1);
  const int ksoff = kpi * 128 + ((ksch ^ ((kpi >> 1) & 7)) << 4);
  constexpr int VCH = DV / 8, VI = (64 * VCH) / AT;
  const int vkey0 = tid / VCH, vc8 = (tid % VCH) * 8;
  u32x4 rk0[NK][2], rv0[VI], rk1[NK][2], rv1[VI];
#define K_LOAD(t, rk) do { const size_t kb_ = (size_t)(t) * 64; \
    _Pragma("unroll") for (int s = 0; s < NK; ++s) _Pragma("unroll") for (int i = 0; i < 2; ++i) rk[s][i] = *(const u32x4*)(J.k[s] + (kb_ + ksrow + 32 * i) * J.ldk + ksch * 8); } while (0)
#define V_LOAD(t, rv) do { const size_t kb_ = (size_t)(t) * 64; \
    _Pragma("unroll") for (int i = 0; i < VI; ++i) rv[i] = *(const u32x4*)(J.v + (kb_ + vkey0 + (AT / VCH) * i) * J.ldv + vc8); } while (0)
#define K_WRITE(st, rk) do { char* b_ = lds + (st) * KST; \
    _Pragma("unroll") for (int s = 0; s < NK; ++s) _Pragma("unroll") for (int i = 0; i < 2; ++i) *(u32x4*)(b_ + s * 8192 + i * 4096 + ksoff) = rk[s][i]; } while (0)
#define V_WRITE(st, rv) do { char* b_ = lds + VB + (st) * VST; \
    _Pragma("unroll") for (int i = 0; i < VI; ++i) { const int key_ = vkey0 + (AT / VCH) * i; \
      *(u32x4*)(b_ + ((key_ >> 3) * NDV + (vc8 >> 5)) * 512 + (key_ & 7) * 64 + (vc8 & 31) * 2) = rv[i]; } } while (0)
  const int nt = J.tile_hi - J.tile_lo, t0 = J.tile_lo;
  const int i16 = lane & 15;
  const int vrd = h * NDV * 512 + (i16 >> 2) * 64 + (((lane >> 4) & 1) * 16 + (i16 & 3) * 4) * 2;
  auto qk = [&](const int kst, f32x16& sA, f32x16& sB) __attribute__((always_inline)) {
    const char* Kl = lds + kst * KST + kstream * 8192 + r * 128;
#pragma unroll
    for (int i = 0; i < 16; ++i) { sA[i] = 0.f; sB[i] = 0.f; }
    bf16x8 ka[4], kb[4];
#pragma unroll
    for (int ds = 0; ds < 4; ++ds) { const int co = ((2 * ds + h) ^ ((r >> 1) & 7)) << 4; ka[ds] = *(const bf16x8*)(Kl + co); kb[ds] = *(const bf16x8*)(Kl + 4096 + co); }
    __builtin_amdgcn_sched_barrier(0);
#pragma unroll
    for (int ds = 0; ds < 4; ++ds) { sA = MFMA32(ka[ds], qf[ds], sA); sB = MFMA32(kb[ds], qf[ds], sB); }
  };
  auto smpv = [&](const int vst, f32x16& sA, f32x16& sB) __attribute__((always_inline)) {
    const char* Vl = lds + VB + vst * VST + vrd;
    bf16x8 vf[4][NDV];
#pragma unroll
    for (int ks = 0; ks < 4; ++ks)
#pragma unroll
      for (int d = 0; d < NDV; ++d) {
        const s16x4 lo = __builtin_amdgcn_ds_read_tr16_b64_v4i16((LAS s16x4*)(Vl + ks * 2 * NDV * 512 + d * 512));
        const s16x4 hi = __builtin_amdgcn_ds_read_tr16_b64_v4i16((LAS s16x4*)(Vl + ks * 2 * NDV * 512 + d * 512 + 256));
        vf[ks][d] = __builtin_shufflevector(lo, hi, 0, 1, 2, 3, 4, 5, 6, 7);
      }
    __builtin_amdgcn_sched_barrier(0);
#pragma unroll
    for (int i = 0; i < 16; ++i) { sA[i] = __builtin_amdgcn_exp2f(fmaf(sA[i], C, nm)); sB[i] = __builtin_amdgcn_exp2f(fmaf(sB[i], C, nm)); }
    bf16x8 pf[4];
    { u32x4 w;
      w.x = cvtpk(sA[0], sA[1]); w.y = cvtpk(sA[2], sA[3]); w.z = cvtpk(sA[4], sA[5]); w.w = cvtpk(sA[6], sA[7]); pf[0] = __builtin_bit_cast(bf16x8, w);
      w.x = cvtpk(sA[8], sA[9]); w.y = cvtpk(sA[10], sA[11]); w.z = cvtpk(sA[12], sA[13]); w.w = cvtpk(sA[14], sA[15]); pf[1] = __builtin_bit_cast(bf16x8, w);
      w.x = cvtpk(sB[0], sB[1]); w.y = cvtpk(sB[2], sB[3]); w.z = cvtpk(sB[4], sB[5]); w.w = cvtpk(sB[6], sB[7]); pf[2] = __builtin_bit_cast(bf16x8, w);
      w.x = cvtpk(sB[8], sB[9]); w.y = cvtpk(sB[10], sB[11]); w.z = cvtpk(sB[12], sB[13]); w.w = cvtpk(sB[14], sB[15]); pf[3] = __builtin_bit_cast(bf16x8, w); }
#pragma unroll
    for (int ks = 0; ks < 4; ++ks) Osum = MFMA32(ones, pf[ks], Osum);
#pragma unroll
    for (int ks = 0; ks < 4; ++ks)
#pragma unroll
      for (int d = 0; d < NDV; ++d) O[d] = MFMA32(vf[ks][d], pf[ks], O[d]);
  };
  K_LOAD(t0, rk0); V_LOAD(t0, rv0); K_LOAD(t0 + 1, rk1);
  K_WRITE(0, rk0); V_WRITE(0, rv0); K_WRITE(1, rk1);
  if (2 < nt) K_LOAD(t0 + 2, rk0);
  V_LOAD(t0 + 1, rv0);
  __syncthreads();
  f32x16 eA, eB, oA, oB;
  qk(0, eA, eB);
  __syncthreads();
  for (int j = 0; j < nt; j += 2) {
    if (j + 3 < nt) K_LOAD(t0 + j + 3, rk1);
    if (j + 2 < nt) V_LOAD(t0 + j + 2, rv1);
    qk(1, oA, oB);
    __builtin_amdgcn_sched_barrier(0);
    smpv(0, eA, eB);
    if (j + 2 < nt) K_WRITE(0, rk0);
    V_WRITE(1, rv0);
    __syncthreads();
    if (j + 4 < nt) K_LOAD(t0 + j + 4, rk0);
    if (j + 3 < nt) V_LOAD(t0 + j + 3, rv0);
    if (j + 2 < nt) qk(0, eA, eB);
    __builtin_amdgcn_sched_barrier(0);
    smpv(1, oA, oB);
    if (j + 3 < nt) K_WRITE(1, rk1);
    if (j + 2 < nt) V_WRITE(0, rv1);
    __syncthreads();
  }
#undef K_LOAD
#undef V_LOAD
#undef K_WRITE
#undef V_WRITE
  if (J.dry) return;
  attn_finalize<DV, MODE>(lds, J, O, Osum[0], wid, r, h);
}

#define PIPE_CALL(DV, NK, MODE) do { if (grp) attn_pipe<DV, NK, MODE, 1>(lds, J); else attn_pipe<DV, NK, MODE, 0>(lds, J); } while (0)
#define ATTN_CALL(DV, NK, MODE, FIXM) do { if (grp) attn_job<DV, NK, MODE, FIXM, 1>(lds, J); else attn_job<DV, NK, MODE, FIXM, 0>(lds, J); } while (0)
DI void mem_jobs(char* lds, const Params& p, int layer, int dry) {
  const int grp = __builtin_amdgcn_readfirstlane(ltid() >> 8);
  const int wid = (ltid() >> 6) & 3, vb = blockIdx.x * 2 + grp, vg = gridDim.x * 2;
  for (int job = vb; job < 768 * 4; job += vg) {
    const int qb = job >> 2, hm = job & 3, t0 = qb * 128;
    int S, seq0, pos, sq; tok_info(t0, S, seq0, pos, sq);
    AttnJob J;
    bf16_t* qo = p.u + (size_t)(t0 + 32 * wid) * UW + 2304 + hm * 64;
    J.q = qo; J.o = qo; J.z = p.u + (size_t)(t0 + 32 * wid) * UW + 2560 + 1024 + hm * 64;
    J.k[0] = J.k[1] = p.memkv + (size_t)(sq * 256) * 2048 + layer * 512 + hm * 64; J.v = J.k[0] + 256; J.ldk = J.ldv = 2048;
    J.tile_lo = 0; J.tile_hi = 4; J.m_init = -1e30f; J.l_init = 0.f; J.qpos0 = 0; J.lam = 0.f; J.oscale = 0.f; J.subg = nullptr; J.dry = dry;
    ATTN_CALL(64, 1, AM_PLAIN, false);
  }
}

DI void phase_mix_even(char* lds, const Params& p, int layer, int dry) {
  const int grp = __builtin_amdgcn_readfirstlane(ltid() >> 8);
  const int e = layer >> 1, wid = (ltid() >> 6) & 3, vb = blockIdx.x * 2 + grp, vg = gridDim.x * 2;
  for (int job = vb; job < 768 * 8; job += vg) {
    const int qb = job >> 3, hq = job & 7, kvh = hq >> 2, t0 = qb * 128;
    int S, seq0, pos, sq; tok_info(t0, S, seq0, pos, sq);
    AttnJob J;
    bf16_t* qo = p.u + (size_t)(t0 + 32 * wid) * UW + 1536 + hq * 64;
    J.q = qo; J.o = qo; J.z = p.u + (size_t)(t0 + 32 * wid) * UW + 2560 + 512 + hq * 64;
    J.k[0] = J.k[1] = p.u + (size_t)seq0 * UW + 2048 + kvh * 64; J.v = p.u + (size_t)seq0 * UW + 2176 + kvh * 64; J.ldk = J.ldv = UW;
    const int pt = pos >> 6;
    J.tile_lo = pt - 2 < 0 ? 0 : pt - 2; J.tile_hi = pt + 4 > (S >> 6) ? (S >> 6) : pt + 4;
    J.m_init = p.swa_sink[e * 8 + hq] * LOG2E; J.l_init = 1.f; J.qpos0 = pos + 32 * wid; J.lam = 0.f; J.oscale = 0.f; J.subg = nullptr; J.dry = dry;
    ATTN_CALL(64, 1, AM_SWA, false);
  }
  mem_jobs(lds, p, layer, dry);
  const float* cw = p.conv_w + e * 3 * 512;
  for (int idx = blockIdx.x * NTHREADS + ltid(); idx < NTOK * 64; idx += gridDim.x * NTHREADS) {
    const int t = idx >> 6, c0 = (idx & 63) * 8;
    int S, seq0, pos, sq; tok_info(t, S, seq0, pos, sq);
    bf16_t* ur = p.u + (size_t)t * UW;
    float ic[8], il[8], ir[8];
    { const u32x4 a = *(const u32x4*)(ur + 512 + c0), b = *(const u32x4*)(ur + 1024 + c0);
#pragma unroll
      for (int j = 0; j < 4; ++j) { ic[2 * j] = bflo(a[j]) * bflo(b[j]); ic[2 * j + 1] = bfhi(a[j]) * bfhi(b[j]); } }
    if (pos > 0) { const u32x4 a = *(const u32x4*)(ur - UW + 512 + c0), b = *(const u32x4*)(ur - UW + 1024 + c0);
#pragma unroll
      for (int j = 0; j < 4; ++j) { il[2 * j] = bflo(a[j]) * bflo(b[j]); il[2 * j + 1] = bfhi(a[j]) * bfhi(b[j]); } }
    else {
#pragma unroll
      for (int j = 0; j < 8; ++j) il[j] = 0.f; }
    if (pos < S - 1) { const u32x4 a = *(const u32x4*)(ur + UW + 512 + c0), b = *(const u32x4*)(ur + UW + 1024 + c0);
#pragma unroll
      for (int j = 0; j < 4; ++j) { ir[2 * j] = bflo(a[j]) * bflo(b[j]); ir[2 * j + 1] = bfhi(a[j]) * bfhi(b[j]); } }
    else {
#pragma unroll
      for (int j = 0; j < 8; ++j) ir[j] = 0.f; }
    const u32x4 gbw = *(const u32x4*)(ur + c0), zw = *(const u32x4*)(ur + 2560 + c0);
    float y[8];
#pragma unroll
    for (int j = 0; j < 8; ++j) {
      const float gb = (j & 1) ? bfhi(gbw[j >> 1]) : bflo(gbw[j >> 1]);
      const float z = (j & 1) ? bfhi(zw[j >> 1]) : bflo(zw[j >> 1]);
      const float cv = il[j] * cw[c0 + j] + ic[j] * cw[512 + c0 + j] + ir[j] * cw[1024 + c0 + j];
      y[j] = gb * cv * silu(z);
    }
    u32x4 w; w.x = cvtpk(y[0], y[1]); w.y = cvtpk(y[2], y[3]); w.z = cvtpk(y[4], y[5]); w.w = cvtpk(y[6], y[7]);
    if (!dry) *(u32x4*)(ur + c0) = w;
  }
}

DI void phase_mix_odd(char* lds, const Params& p, int layer, int dry) {
  const int grp = __builtin_amdgcn_readfirstlane(ltid() >> 8);
  const int o = layer >> 1, wid = (ltid() >> 6) & 3;
  const int nx = (gridDim.x & 7) == 0 ? 8 : 1, bx = blockIdx.x % nx, bi = (blockIdx.x / nx) * 2 + grp, nbx = (gridDim.x / nx) * 2;
  const float mb_dense = p.lam[8 + o * 2], mb_diff = p.lam[8 + o * 2 + 1];
  const bool fix_dense = mb_dense < 43.f, fix_diff = mb_diff < 43.f;
#pragma unroll 1
  for (int part = 0; part < 2; ++part) {
    const int gshift = part ? 7 : 8, nv = (16 / nx) << gshift;
#pragma unroll 1
    for (int v = bi; v < nv; v += nbx) {
      const int j = ((bx + nx * (v >> gshift)) << gshift) + (v & ((1 << gshift) - 1));
      int g, qb, kvh, seq0, S;
      if (!part) { g = j & 3; qb = (j >> 2) & 63; kvh = (j >> 8) & 1; seq0 = (j >> 9) * 8192; S = 8192; }
      else { g = j & 3; qb = (j >> 2) & 31; kvh = (j >> 7) & 1; seq0 = NTOKP + (j >> 8) * 4096; S = 4096; }
      const int hq = kvh * 4 + g, t0 = seq0 + qb * 128 + 32 * wid;
      AttnJob J;
      bf16_t* qo = p.u + (size_t)t0 * UW + hq * 64;
      J.q = qo; J.o = qo; J.z = p.u + (size_t)t0 * UW + 2560 + hq * 64;
      J.k[0] = J.k[1] = p.u + (size_t)seq0 * UW + 512 + kvh * 64; J.v = p.u + (size_t)seq0 * UW + 640 + kvh * 64; J.ldk = J.ldv = UW;
      J.tile_lo = 0; J.tile_hi = S >> 6; J.l_init = 0.f; J.qpos0 = 0; J.lam = 0.f; J.oscale = 0.f; J.subg = nullptr; J.dry = dry;
      if (fix_dense) { J.m_init = mb_dense; ATTN_CALL(64, 1, AM_PLAIN, true); }
      else { J.m_init = -1e30f; ATTN_CALL(64, 1, AM_PLAIN, false); }
    }
  }
  const float lam = p.lam[o * 2], osc = p.lam[o * 2 + 1];
#pragma unroll 1
  for (int part = 0; part < 2; ++part) {
    const int gshift = part ? 6 : 7, nv = (32 / nx) << gshift;
#pragma unroll 1
    for (int v = bi; v < nv; v += nbx) {
      const int j = ((bx + nx * (v >> gshift)) << gshift) + (v & ((1 << gshift) - 1));
      int qb, hh, seq0, S;
      if (!part) { qb = j & 127; hh = (j >> 7) & 3; seq0 = (j >> 9) * 8192; S = 8192; }
      else { qb = j & 63; hh = (j >> 6) & 3; seq0 = NTOKP + (j >> 8) * 4096; S = 4096; }
      const int mp = wid & 1, sub = wid >> 1, t0 = seq0 + qb * 64 + sub * 32;
      AttnJob J;
      J.q = p.u + (size_t)t0 * UW + 768 + (2 * hh + mp) * 64;
      J.o = p.u + (size_t)t0 * UW + 768 + hh * 128; J.z = p.u + (size_t)t0 * UW + 2560 + 512 + hh * 128;
      J.k[0] = p.u + (size_t)seq0 * UW + 1280 + (2 * hh) * 64; J.k[1] = J.k[0] + 64; J.v = p.u + (size_t)seq0 * UW + 1792 + hh * 128; J.ldk = J.ldv = UW;
      J.tile_lo = 0; J.tile_hi = S >> 6; J.l_init = 0.f; J.qpos0 = 0; J.lam = lam; J.oscale = osc; J.subg = p.diff_subln_g + o * 128; J.dry = dry;
      if (fix_diff) { J.m_init = mb_diff; ATTN_CALL(128, 2, AM_DIFF, true); }
      else { J.m_init = -1e30f; ATTN_CALL(128, 2, AM_DIFF, false); }
    }
  }
  mem_jobs(lds, p, layer, dry);
}

DI void phase_norm(const Params& p) {
  const int gw = blockIdx.x * 8 + (ltid() >> 6), nw = gridDim.x * 8;
  norm_rows(p.out, p.xb, p.rstd, 0, NTOK, gw, nw);
}

#define XB_TMO      128
#define XB_XCNT(j)  (256  + 64 * (j))
#define XB_XSUB(j)  (1280 + 64 * (j))
#define XB_XGEN(j)  (2304 + 64 * (j))
#define XB_TOP      3328
#define XB_TOPGEN   3392
#define XB_STATE    4096
#define XB_WORDS    8192
#define XB_SPIN_CAP (1u << 18)
DI unsigned xb_ld(unsigned* p) { return __hip_atomic_load(p, __ATOMIC_RELAXED, __HIP_MEMORY_SCOPE_AGENT); }
DI unsigned xb_add(unsigned* p, unsigned v) { return __hip_atomic_fetch_add(p, v, __ATOMIC_RELAXED, __HIP_MEMORY_SCOPE_AGENT); }
DI unsigned xb_xcc_id() { return (unsigned)__builtin_amdgcn_s_getreg((3 << 11) | 20) & 0xFu; }
#define XB_SPIN(cond, bar) do { unsigned _sp = 0; while (cond) { __builtin_amdgcn_s_sleep(1); \
    if ((++_sp & 255u) == 0u) { if (xb_ld(&(bar)[XB_TMO])) break; if (_sp > XB_SPIN_CAP) { atomicAdd(&(bar)[XB_TMO], 1u); break; } } } } while (0)
DI void xb_census(unsigned* bar, unsigned x, unsigned& nloc, unsigned& nx) {
  const unsigned G = gridDim.x;
  unsigned sum, cnt, mine, sp = 0u;
  for (;;) {
    sum = 0u; cnt = 0u; mine = 0u;
#pragma unroll
    for (unsigned j = 0; j < 16; ++j) { const unsigned c = xb_ld(&bar[XB_XCNT(j)]); sum += c; cnt += (c > 0u) ? 1u : 0u; mine = (j == x) ? c : mine; }
    if (sum == G) break;
    __builtin_amdgcn_s_sleep(1);
    if ((++sp & 255u) == 0u) { if (xb_ld(&bar[XB_TMO])) break; if (sp > XB_SPIN_CAP) { atomicAdd(&bar[XB_TMO], 1u); break; } }
  }
  nloc = mine > 0u ? mine : 1u; nx = cnt > 0u ? cnt : 1u;
}
DI void xcd_barrier(unsigned* bar) {
  asm volatile("s_waitcnt vmcnt(0)" ::: "memory");
  __syncthreads();
  if (threadIdx.x == 0) {
    __builtin_amdgcn_s_waitcnt(0);
    const unsigned x = xb_xcc_id();
    unsigned* st = bar + XB_STATE + 2 * blockIdx.x;
    unsigned nloc = xb_ld(st), nx = xb_ld(st + 1);
    if (nloc == 0u) { xb_census(bar, x, nloc, nx); __hip_atomic_store(st, nloc, __ATOMIC_RELAXED, __HIP_MEMORY_SCOPE_AGENT); __hip_atomic_store(st + 1, nx, __ATOMIC_RELAXED, __HIP_MEMORY_SCOPE_AGENT); }
    const unsigned old = xb_add(&bar[XB_XSUB(x)], 1u);
    const unsigned gen = old / nloc;
    if (old + 1u == (gen + 1u) * nloc) {
      __builtin_amdgcn_fence(__ATOMIC_RELEASE, "agent");
      asm volatile("s_waitcnt vmcnt(0)" ::: "memory");
      const unsigned og = xb_add(&bar[XB_TOP], 1u);
      const unsigned tg = og / nx;
      if (og + 1u == (tg + 1u) * nx) xb_add(&bar[XB_TOPGEN], 1u);
      else XB_SPIN(xb_ld(&bar[XB_TOPGEN]) == tg, bar);
      __builtin_amdgcn_fence(__ATOMIC_ACQUIRE, "agent");
      xb_add(&bar[XB_XGEN(x)], 1u);
      asm volatile("s_waitcnt vmcnt(0)" ::: "memory");
    } else {
      XB_SPIN(xb_ld(&bar[XB_XGEN(x)]) == gen, bar);
      __builtin_amdgcn_fence(__ATOMIC_ACQUIRE, "agent");
      asm volatile("s_waitcnt vmcnt(0)" ::: "memory");
    }
  }
  __syncthreads();
}

__global__ void __launch_bounds__(NTHREADS, 2) fwd_kernel(Params p) {
  __shared__ __attribute__((aligned(16))) char lds[LDS_BYTES];
  if (threadIdx.x == 0) (void)xb_add(&p.bar[XB_XCNT(xb_xcc_id())], 1u);
  int ph = p.phase_lo;
  if (ph == 0) {
    phase_prep(lds, p);
    ph = 1;
#if !MULTI_LAUNCH
    if (ph < p.phase_hi) cg::this_grid().sync();
#endif
  }
  for (; ph < p.phase_hi; ++ph) {
    {
      const int l = (ph - 1) / 3, s = (ph - 1) - 3 * l;
      if (s == 0) {
        if (l == 0) { GemmDesc g{p.memb, p.wt_mem, DM, DM, 16, 8, 0, 0}; gemm_phase<EPI_MEM>(lds, p, g, 0); }
        GemmDesc g{p.xb, p.wt_in + (size_t)l * UW * DM, DM, DM, NTOK / 256, UW / 256, 0, 0};
        const int nrep = ((p.probe >> 2) & 1) + 1;
#pragma unroll 1
        for (int rep = 0; rep < nrep; ++rep) gemm_phase<EPI_IN>(lds, p, g, l);
      } else if (s == 1) {
        const int nrep = ((l & 1) ? (p.probe & 1) : ((p.probe >> 1) & 1)) + 1;
#pragma unroll 1
        for (int rep = 0; rep < nrep; ++rep) {
          const int dry = rep + 1 < nrep;
          if (rep == 0) {
            float* z = p.rstd + ((l + 1) & 1) * NTOK;
            for (int i = blockIdx.x * NTHREADS + ltid(); i < NTOK; i += gridDim.x * NTHREADS) z[i] = 0.f;
          }
          if (__builtin_amdgcn_readfirstlane(ltid()) >= 256) __builtin_amdgcn_s_setprio(1);
          if (l & 1) phase_mix_odd(lds, p, l, dry); else phase_mix_even(lds, p, l, dry);
          __builtin_amdgcn_s_setprio(0);
        }
      } else if (s == 2) {
        GemmDesc g{p.u, p.wt_out + (size_t)l * DM * MIXW, UW, MIXW, NTOK / 256, DM / 256, 1, (l & 1) ? 768 : 1536};
        gemm_phase<EPI_OUT>(lds, p, g, l);
      }
    }
#if !MULTI_LAUNCH
    if (ph + 1 < p.phase_hi) xcd_barrier(p.bar);
#endif
  }
}

extern "C" void kernel_launch(void* const* d_in, const int* in_sizes, int n_in, void* d_out, int out_size, void* d_ws, size_t ws_size,
                              hipStream_t stream) {
  static int grid_blocks = 0;
  if (!grid_blocks) {
    int dev = 0, cus = 0, per_cu = 0;
    hipGetDevice(&dev);
    hipDeviceGetAttribute(&cus, hipDeviceAttributeMultiprocessorCount, dev);
    hipOccupancyMaxActiveBlocksPerMultiprocessor(&per_cu, fwd_kernel, NTHREADS, 0);
    if (per_cu > 1) per_cu = 1;
    if (per_cu < 1) per_cu = 1;
    int cap = cus * per_cu; if (cap > 256) cap = 256;
    grid_blocks = 8; while (grid_blocks * 2 <= cap) grid_blocks *= 2;
  }
  Params p{};
  p.xp = (const float*)d_in[0]; p.xs = (const float*)d_in[1]; p.memp = (const float*)d_in[2]; p.mems = (const float*)d_in[3];
  p.norm_g = (const float*)d_in[4]; p.w_in = (const float*)d_in[5]; p.w_out = (const float*)d_in[6]; p.mem_norm_g = (const float*)d_in[7];
  p.w_mem_kv = (const float*)d_in[8]; p.mem_qk_g = (const float*)d_in[9]; p.conv_w = (const float*)d_in[10]; p.swa_qk_g = (const float*)d_in[11];
  p.swa_sink = (const float*)d_in[12]; p.ax_qk_g = (const float*)d_in[13]; p.diff_qk_g = (const float*)d_in[14]; p.diff_lambda = (const float*)d_in[15];
  p.diff_subln_g = (const float*)d_in[16];
  p.out = (float*)d_out;
  char* w = (char*)d_ws; size_t off = 0;
  auto take = [&](size_t bytes) { char* r = w + off; off += (bytes + 255) & ~(size_t)255; return r; };
  p.u = (bf16_t*)take((size_t)NTOK * UW * 2);
  p.xb = (bf16_t*)take((size_t)NTOK * DM * 2);
  p.wt_in = (bf16_t*)take((size_t)4 * UW * DM * 2);
  p.wt_out = (bf16_t*)take((size_t)4 * DM * MIXW * 2);
  p.wt_mem = (bf16_t*)take((size_t)2048 * DM * 2);
  p.memb = (bf16_t*)take((size_t)4096 * DM * 2);
  p.memkv = (bf16_t*)take((size_t)4096 * 2048 * 2);
  p.rstd = (float*)take((size_t)NTOK * 4 * 2);
  p.rstd_mem = (float*)take(4096 * 4);
  p.tab1c = (float*)take(8192 * 32 * 4); p.tab1s = (float*)take(8192 * 32 * 4);
  p.tabac = (float*)take(128 * 16 * 4); p.tabas = (float*)take(128 * 16 * 4);
  p.lam = (float*)take(256);
  p.bar = (unsigned*)take(XB_WORDS * 4);
  if (off > ws_size) { fprintf(stderr, "workspace too small: need %zu have %zu\n", off, ws_size); return; }
#if MULTI_LAUNCH
  for (int ph = 0; ph < NPHASE; ++ph) {
    p.phase_lo = ph; p.phase_hi = ph + 1;
    hipLaunchKernelGGL(fwd_kernel, dim3(grid_blocks), dim3(NTHREADS), 0, stream, p);
  }
#else
  hipMemsetAsync(p.bar, 0, XB_WORDS * 4, stream);
  p.phase_lo = 0; p.phase_hi = NPHASE; p.probe = PROBE_ODD | (PROBE_EVEN << 1) | (PROBE_GIN << 2);
  void* args[] = {&p};
  hipError_t e = hipLaunchCooperativeKernel((void*)fwd_kernel, dim3(grid_blocks), dim3(NTHREADS), args, 0, stream);
  if (e != hipSuccess) fprintf(stderr, "cooperative launch failed: %s (grid %d)\n", hipGetErrorString(e), grid_blocks);
#endif
}
```

```cpp
#include <hip/hip_runtime.h>
#include <hip/hip_cooperative_groups.h>
#include <cstdint>
#include <cstdio>
namespace cg = cooperative_groups;

#ifndef MULTI_LAUNCH
#define MULTI_LAUNCH 0
#endif

#ifndef PROBE_ODD
#define PROBE_ODD 0
#endif
#ifndef PROBE_EVEN
#define PROBE_EVEN 0
#endif
#ifndef PROBE_GIN
#define PROBE_GIN 0
#endif
#define DI __device__ __forceinline__
#define LAS __attribute__((address_space(3)))
typedef unsigned short bf16_t;
typedef short bf16x8 __attribute__((ext_vector_type(8)));
typedef short s16x4 __attribute__((ext_vector_type(4)));
typedef float f32x16 __attribute__((ext_vector_type(16)));
typedef float f32x4 __attribute__((ext_vector_type(4)));
typedef unsigned u32x4 __attribute__((ext_vector_type(4)));
typedef unsigned u32x2 __attribute__((ext_vector_type(2)));

constexpr int NTOK = 98304, NTOKP = 65536, UW = 3840, DM = 1024, MIXW = 1280;
constexpr int NTHREADS = 512;
constexpr int AT = 256;
constexpr int LDS_BYTES = 131072 + 32768;
constexpr float EPSF = 1e-6f;
constexpr float LOG2E = 1.4426950408889634f;
constexpr int NPHASE = 13;

struct Params {
  const float *xp, *xs, *memp, *mems, *norm_g, *w_in, *w_out, *mem_norm_g, *w_mem_kv, *mem_qk_g, *conv_w, *swa_qk_g,
      *swa_sink, *ax_qk_g, *diff_qk_g, *diff_lambda, *diff_subln_g;
  float* out;
  bf16_t *u, *xb, *wt_in, *wt_out, *wt_mem, *memb, *memkv;
  float *rstd, *rstd_mem, *tab1c, *tab1s, *tabac, *tabas, *lam;
  unsigned* bar;
  int phase_lo, phase_hi, probe, pad_;
};

typedef __bf16 bf16x2_t __attribute__((ext_vector_type(2)));
typedef float f32x2 __attribute__((ext_vector_type(2)));
DI unsigned cvtpk(float lo, float hi) { f32x2 v = {lo, hi}; bf16x2_t b = __builtin_convertvector(v, bf16x2_t); return __builtin_bit_cast(unsigned, b); }
DI float bf2f(unsigned short b) { return __uint_as_float(((unsigned)b) << 16); }
DI float bflo(unsigned w) { return __uint_as_float(w << 16); }
DI float bfhi(unsigned w) { return __uint_as_float(w & 0xffff0000u); }
DI int ltid() { int t; asm volatile("v_mov_b32 %0, %1" : "=v"(t) : "v"(threadIdx.x)); return t; }
DI int crow(int i, int h) { return (i & 3) + 8 * (i >> 2) + 4 * h; }
DI float swapmax(float v) { auto rr = __builtin_amdgcn_permlane32_swap(__float_as_uint(v), __float_as_uint(v), false, false); return fmaxf(__uint_as_float(rr[0]), __uint_as_float(rr[1])); }
DI float swapsum(float v) { auto rr = __builtin_amdgcn_permlane32_swap(__float_as_uint(v), __float_as_uint(v), false, false); return __uint_as_float(rr[0]) + __uint_as_float(rr[1]); }
DI float shx(float v, int lane, int o) { return __int_as_float(__builtin_amdgcn_ds_bpermute(((lane ^ o) & 63) << 2, __float_as_int(v))); }
DI float silu(float z) { return z / (1.f + __expf(-z)); }
#define MFMA32(a, b, c) __builtin_amdgcn_mfma_f32_32x32x16_bf16((a), (b), (c), 0, 0, 0)

DI void tok_info(int t, int& S, int& seq0, int& pos, int& sq) {
  if (t < NTOKP) { S = 8192; seq0 = t & ~8191; pos = t & 8191; sq = t >> 13; }
  else { int tt = t - NTOKP; S = 4096; seq0 = NTOKP + (tt & ~4095); pos = tt & 4095; sq = 8 + (tt >> 12); }
}

DI void transpose_tile(char* lds, const float* src, const float* g, bf16_t* dst, int K, int N, int k0, int n0) {
  float* tile = (float*)lds;
  const int tid = ltid(), a = tid >> 6, b = tid & 63;
#pragma unroll 4
  for (int i = 0; i < 8; ++i) { int kk = i * 8 + a; float v = src[(size_t)(k0 + kk) * N + n0 + b]; if (g) v *= g[k0 + kk]; tile[kk * 65 + b] = v; }
  __syncthreads();
#pragma unroll 4
  for (int i = 0; i < 8; ++i) { int nn = i * 8 + a; float v = tile[b * 65 + nn]; dst[(size_t)(n0 + nn) * K + k0 + b] = (bf16_t)(cvtpk(v, v) & 0xffffu); }
  __syncthreads();
}

DI void norm_rows(const float* src, bf16_t* dst, float* ssq, int row_begin, int row_end, int gw, int nw) {
  const int lane = ltid() & 63;
  for (int row = row_begin + gw; row < row_end; row += nw) {
    const float* s = src + (size_t)(row - row_begin) * DM; bf16_t* d = dst + (size_t)row * DM;
    f32x4 v[4]; float ss = 0.f;
#pragma unroll
    for (int j = 0; j < 4; ++j) { v[j] = *(const f32x4*)(s + (lane + 64 * j) * 4); ss += v[j][0] * v[j][0] + v[j][1] * v[j][1] + v[j][2] * v[j][2] + v[j][3] * v[j][3]; }
#pragma unroll
    for (int o = 32; o > 0; o >>= 1) ss += shx(ss, lane, o);
    const float rs = ssq ? 1.f : rsqrtf(ss * (1.f / DM) + EPSF);
#pragma unroll
    for (int j = 0; j < 4; ++j) { u32x2 w; w.x = cvtpk(v[j][0] * rs, v[j][1] * rs); w.y = cvtpk(v[j][2] * rs, v[j][3] * rs); *(u32x2*)(d + (lane + 64 * j) * 4) = w; }
    if (ssq && lane == 0) ssq[row] = ss;
  }
}

DI void phase_prep(char* lds, const Params& p) {
  const int T_IN = 4 * 16 * 60, T_OUT = 4 * 20 * 16, T_MEM = 4 * 16 * 8;
  for (int t = blockIdx.x; t < T_IN + T_OUT + T_MEM; t += gridDim.x) {
    if (t < T_IN) { int l = t / 960, r = t % 960, kt = r / 60, nt = r % 60;
      transpose_tile(lds, p.w_in + (size_t)l * DM * UW, p.norm_g + l * DM, p.wt_in + (size_t)l * UW * DM, DM, UW, kt * 64, nt * 64); }
    else if (t < T_IN + T_OUT) { int tt = t - T_IN; int l = tt / 320, r = tt % 320, kt = r / 16, nt = r % 16;
      transpose_tile(lds, p.w_out + (size_t)l * MIXW * DM, nullptr, p.wt_out + (size_t)l * DM * MIXW, MIXW, DM, kt * 64, nt * 64); }
    else { int tt = t - T_IN - T_OUT; int l = tt / 128, r = tt % 128, kt = r / 8, nt = r % 8;
      transpose_tile(lds, p.w_mem_kv + (size_t)l * DM * 512, p.mem_norm_g + l * DM, p.wt_mem + (size_t)l * 512 * DM, DM, 512, kt * 64, nt * 64); }
  }
  const int gw = blockIdx.x * 8 + __builtin_amdgcn_readfirstlane(ltid() >> 6), nw = gridDim.x * 8;
  norm_rows(p.memp, p.memb, nullptr, 0, 2048, gw, nw);
  norm_rows(p.mems, p.memb, nullptr, 2048, 4096, gw, nw);
  norm_rows(p.xp, p.xb, p.rstd, 0, NTOKP, gw, nw);
  norm_rows(p.xs, p.xb, p.rstd, NTOKP, NTOK, gw, nw);
  const int gt = blockIdx.x * NTHREADS + ltid(), nt_ = gridDim.x * NTHREADS;
  for (int i = gt; i < 8192 * 32; i += nt_) { int pos = i >> 5, f = i & 31; float inv = powf(10000.f, -(float)(2 * f) / 64.f); float ang = (float)pos * inv; p.tab1c[i] = cosf(ang); p.tab1s[i] = sinf(ang); }
  for (int i = gt; i < 128 * 16; i += nt_) { int pos = i >> 4, f = i & 15; float inv = powf(10000.f, -(float)(2 * f) / 32.f); float ang = (float)pos * inv; p.tabac[i] = cosf(ang); p.tabas[i] = sinf(ang); }
  if (blockIdx.x == 0 && ltid() < 64) {
    const int lane = ltid();
    for (int o = 0; o < 2; ++o) {
      const float* lv = p.diff_lambda + o * 256;
      float a = lv[lane] * lv[64 + lane], b = lv[128 + lane] * lv[192 + lane];
#pragma unroll
      for (int s = 32; s > 0; s >>= 1) { a += shx(a, lane, s); b += shx(b, lane, s); }
      float li = 0.8f - 0.6f * expf(-0.3f * (float)(2 * o + 1));
      if (lane == 0) { p.lam[o * 2] = expf(a) - expf(b) + li; p.lam[o * 2 + 1] = 1.f - li; }
      float g0 = fabsf(p.ax_qk_g[o * 128 + lane]), g1 = fabsf(p.ax_qk_g[o * 128 + 64 + lane]);
      float g2 = fabsf(p.diff_qk_g[o * 128 + lane]), g3 = fabsf(p.diff_qk_g[o * 128 + 64 + lane]);
#pragma unroll
      for (int s = 32; s > 0; s >>= 1) { g0 = fmaxf(g0, shx(g0, lane, s)); g1 = fmaxf(g1, shx(g1, lane, s)); g2 = fmaxf(g2, shx(g2, lane, s)); g3 = fmaxf(g3, shx(g3, lane, s)); }
      if (lane == 0) { p.lam[8 + o * 2] = 8.f * g0 * g1 * 1.02f * LOG2E; p.lam[8 + o * 2 + 1] = 8.f * g2 * g3 * 1.02f * LOG2E; }
    }
  }
}

struct GemmDesc { const bf16_t* A; const bf16_t* Bt; int lda, K, mtiles, ntiles, remap, seg2; };
enum { EPI_IN = 0, EPI_MEM = 1, EPI_OUT = 2 };

DI void head_store(f32x16 v0, f32x16 v1, float rs, int mode, const float* gain, const Params& p, int pos, bf16_t* obase, int ldo, char* stg_wg) {
  const int tid_ = ltid(), lane = tid_ & 63, r = lane & 31, h = lane >> 5;
  char* stg = stg_wg + (tid_ >> 6) * 4096;
  v0 *= rs; v1 *= rs;
  if (mode) {
    float ss = 0.f;
#pragma unroll
    for (int i = 0; i < 16; ++i) ss += v0[i] * v0[i] + v1[i] * v1[i];
    ss = swapsum(ss);
    const float inv = rsqrtf(ss * (1.f / 64.f) + EPSF);
#pragma unroll
    for (int g4 = 0; g4 < 4; ++g4) {
      const f32x4 ga = *(const f32x4*)(gain + 8 * g4 + 4 * h), gb = *(const f32x4*)(gain + 32 + 8 * g4 + 4 * h);
#pragma unroll
      for (int j = 0; j < 4; ++j) { v0[4 * g4 + j] *= inv * ga[j]; v1[4 * g4 + j] *= inv * gb[j]; }
    }
    if (mode == 2) {
#pragma unroll
      for (int g4 = 0; g4 < 4; ++g4) {
        const f32x4 c = *(const f32x4*)(p.tab1c + pos * 32 + 8 * g4 + 4 * h), s = *(const f32x4*)(p.tab1s + pos * 32 + 8 * g4 + 4 * h);
#pragma unroll
        for (int j = 0; j < 4; ++j) { const int i = 4 * g4 + j; const float x1 = v0[i], x2 = v1[i]; v0[i] = x1 * c[j] - x2 * s[j]; v1[i] = x2 * c[j] + x1 * s[j]; }
      }
    } else if (mode == 3) {
      const int row = pos >> 6, col = pos & 63;
#pragma unroll
      for (int g4 = 0; g4 < 2; ++g4) {
        const f32x4 c0 = *(const f32x4*)(p.tabac + row * 16 + 8 * g4 + 4 * h), s0 = *(const f32x4*)(p.tabas + row * 16 + 8 * g4 + 4 * h);
        const f32x4 c1 = *(const f32x4*)(p.tabac + col * 16 + 8 * g4 + 4 * h), s1 = *(const f32x4*)(p.tabas + col * 16 + 8 * g4 + 4 * h);
#pragma unroll
        for (int j = 0; j < 4; ++j) { const int i = 4 * g4 + j;
          float x1 = v0[i], x2 = v0[i + 8]; v0[i] = x1 * c0[j] - x2 * s0[j]; v0[i + 8] = x2 * c0[j] + x1 * s0[j];
          x1 = v1[i]; x2 = v1[i + 8]; v1[i] = x1 * c1[j] - x2 * s1[j]; v1[i + 8] = x2 * c1[j] + x1 * s1[j]; }
      }
    }
  }
#pragma unroll
  for (int g4 = 0; g4 < 4; ++g4) {
    u32x2 w0, w1; w0.x = cvtpk(v0[4 * g4], v0[4 * g4 + 1]); w0.y = cvtpk(v0[4 * g4 + 2], v0[4 * g4 + 3]);
    w1.x = cvtpk(v1[4 * g4], v1[4 * g4 + 1]); w1.y = cvtpk(v1[4 * g4 + 2], v1[4 * g4 + 3]);
    *(u32x2*)(stg + r * 128 + ((g4 ^ (r & 7)) << 4) + h * 8) = w0;
    *(u32x2*)(stg + r * 128 + (((4 + g4) ^ (r & 7)) << 4) + h * 8) = w1;
  }
#pragma unroll
  for (int j = 0; j < 4; ++j) {
    const int row = (lane >> 3) + 8 * j, ch = lane & 7;
    const u32x4 w = *(const u32x4*)(stg + row * 128 + ((ch ^ (row & 7)) << 4));
    *(u32x4*)(obase + (size_t)row * ldo + ch * 8) = w;
  }
}

DI int in_mode(const Params& p, int layer, int n_h, const float*& gain) {
  int mode = 0; gain = p.mem_qk_g;
  if ((layer & 1) == 0) { const int e = layer >> 1;
    if (n_h >= 1536 && n_h < 2048) { mode = 2; gain = p.swa_qk_g + (e * 2) * 64; }
    else if (n_h >= 2048 && n_h < 2176) { mode = 2; gain = p.swa_qk_g + (e * 2 + 1) * 64; }
    else if (n_h >= 2304 && n_h < 2560) { mode = 1; gain = p.mem_qk_g + (layer * 2) * 64; }
  } else { const int o = layer >> 1;
    if (n_h < 512) { mode = 3; gain = p.ax_qk_g + (o * 2) * 64; }
    else if (n_h < 640) { mode = 3; gain = p.ax_qk_g + (o * 2 + 1) * 64; }
    else if (n_h >= 768 && n_h < 1280) { mode = 2; gain = p.diff_qk_g + (o * 2) * 64; }
    else if (n_h >= 1280 && n_h < 1792) { mode = 2; gain = p.diff_qk_g + (o * 2 + 1) * 64; }
    else if (n_h >= 2304 && n_h < 2560) { mode = 1; gain = p.mem_qk_g + (layer * 2) * 64; }
  }
  return mode;
}

template <int EPI>
DI void gemm_phase(char* lds, const Params& p, const GemmDesc g, int layer) {
  const int tid = ltid(), lane = tid & 63, wid = __builtin_amdgcn_readfirstlane(tid >> 6), wm = wid >> 1, wn = wid & 1, r = lane & 31, h = lane >> 5;
  const int srow = tid >> 3, sch = tid & 7;
  const int soff = srow * 128 + ((sch ^ ((srow >> 1) & 7)) << 4);
  const int nk = g.K >> 6;
  const int ntile = g.mtiles * g.ntiles;
  const bool banded = ((gridDim.x & 7) == 0) && ((g.mtiles & 63) == 0);
  const int nx = banded ? 8 : 1, bx = blockIdx.x % nx, bi = blockIdx.x / nx, nbx = gridDim.x / nx;
  const int per_band = 8 * g.ntiles;
  const int qtot = ntile / nx;
  int q = bi;
  if (q >= qtot) return;
  int mt, nt;
#define G_TILE(qq, MT, NT) do { if (banded) { const int bl_ = (qq) / per_band, rem_ = (qq) - bl_ * per_band; NT = rem_ >> 3; MT = (bl_ * 8 + bx) * 8 + (rem_ & 7); } \
    else { MT = (qq) / g.ntiles; NT = (qq) - MT * g.ntiles; } } while (0)
#define G_LOAD(AG, BG, kt, RA, RB) do { const int k0_ = (kt) * 64; int ac_ = k0_; if (g.remap) ac_ = k0_ < 512 ? k0_ : (k0_ < 1024 ? g.seg2 + k0_ - 512 : 2304 + k0_ - 1024); \
    _Pragma("unroll") for (int i = 0; i < 4; ++i) { RA[i] = *(const u32x4*)(AG + (size_t)(64 * i) * g.lda + ac_); RB[i] = *(const u32x4*)(BG + (size_t)(64 * i) * g.K + k0_); } } while (0)
#define G_WRITE(buf, RA, RB) do { _Pragma("unroll") for (int i = 0; i < 4; ++i) { *(u32x4*)(lds + (buf) * 65536 + i * 8192 + soff) = RA[i]; *(u32x4*)(lds + (buf) * 65536 + 32768 + i * 8192 + soff) = RB[i]; } } while (0)
#define G_COMPUTE(buf) do { _Pragma("unroll") for (int ks = 0; ks < 4; ++ks) { const int co_ = ((2 * ks + h) ^ ((r >> 1) & 7)) << 4; \
      const char* la_ = lds + (buf) * 65536 + (wm * 64 + r) * 128 + co_; const char* lb_ = lds + (buf) * 65536 + 32768 + (wn * 128 + r) * 128 + co_; \
      bf16x8 fa_[2], fb_[4]; fa_[0] = *(const bf16x8*)(la_); fa_[1] = *(const bf16x8*)(la_ + 4096); \
      _Pragma("unroll") for (int ni = 0; ni < 4; ++ni) fb_[ni] = *(const bf16x8*)(lb_ + ni * 4096); \
      _Pragma("unroll") for (int ni = 0; ni < 4; ++ni) { acc[0][ni] = MFMA32(fb_[ni], fa_[0], acc[0][ni]); acc[1][ni] = MFMA32(fb_[ni], fa_[1], acc[1][ni]); } } } while (0)
  G_TILE(q, mt, nt);
  const bf16_t* Ag = g.A + (size_t)(mt * 256 + srow) * g.lda + sch * 8;
  const bf16_t* Bg = g.Bt + (size_t)(nt * 256 + srow) * g.K + sch * 8;
  u32x4 ra0[4], rb0[4];
  G_LOAD(Ag, Bg, 0, ra0, rb0); G_WRITE(0, ra0, rb0); G_LOAD(Ag, Bg, 1, ra0, rb0); __syncthreads();
  for (;;) {
    const int qn = q + nbx; const bool has_next = qn < qtot;
    int mtn = mt, ntn = nt; if (has_next) G_TILE(qn, mtn, ntn);
    const bf16_t* Agn = g.A + (size_t)(mtn * 256 + srow) * g.lda + sch * 8;
    const bf16_t* Bgn = g.Bt + (size_t)(ntn * 256 + srow) * g.K + sch * 8;
    f32x16 acc[2][4];
#pragma unroll
    for (int a = 0; a < 2; ++a)
#pragma unroll
      for (int b = 0; b < 4; ++b)
#pragma unroll
        for (int i = 0; i < 16; ++i) acc[a][b][i] = 0.f;
    for (int kt = 0; kt < nk; kt += 2) {
      const bool last = kt + 2 >= nk;
      G_WRITE(1, ra0, rb0);
      if (!last) G_LOAD(Ag, Bg, kt + 2, ra0, rb0); else if (has_next) G_LOAD(Agn, Bgn, 0, ra0, rb0);
      G_COMPUTE(0);
      __syncthreads();
      if (!last || has_next) G_WRITE(0, ra0, rb0);
      if (!last) G_LOAD(Ag, Bg, kt + 3, ra0, rb0); else if (has_next) G_LOAD(Agn, Bgn, 1, ra0, rb0);
      G_COMPUTE(1);
      __syncthreads();
    }
    const int n_w = nt * 256 + wn * 128;
    if (EPI == EPI_IN) {
#pragma unroll
      for (int hu = 0; hu < 2; ++hu) {
        const int n_h = n_w + 64 * hu; const float* gain; const int mode = in_mode(p, layer, n_h, gain);
#pragma unroll
        for (int mi = 0; mi < 2; ++mi) {
          const int t = mt * 256 + wm * 64 + mi * 32 + r;
          int S, seq0, pos, sq; tok_info(t, S, seq0, pos, sq);
          const float rs = rsqrtf(p.rstd[(layer & 1) * NTOK + t] * (1.f / DM) + EPSF);
          head_store(acc[mi][2 * hu], acc[mi][2 * hu + 1], rs, mode, gain, p, pos, p.u + (size_t)(t - r) * UW + n_h, UW, lds + 131072);
        }
      }
    } else if (EPI == EPI_MEM) {
#pragma unroll
      for (int hu = 0; hu < 2; ++hu) {
        const int n_h = n_w + 64 * hu, l = n_h >> 9, c = n_h & 511;
        const int mode = c < 256 ? 1 : 0; const float* gain = p.mem_qk_g + (l * 2 + 1) * 64;
#pragma unroll
        for (int mi = 0; mi < 2; ++mi) {
          const int row = mt * 256 + wm * 64 + mi * 32 + r;
          head_store(acc[mi][2 * hu], acc[mi][2 * hu + 1], 1.f, mode, gain, p, 0, p.memkv + (size_t)(row - r) * 2048 + n_h, 2048, lds + 131072);
        }
      }
    } else {
      const int tid_ = ltid(), lane = tid_ & 63, r = lane & 31, h = lane >> 5;
      char* stg = lds + 131072 + (tid_ >> 6) * 4096;
#pragma unroll
      for (int mi = 0; mi < 2; ++mi) {
        const int t0 = mt * 256 + wm * 64 + mi * 32;
        const float* xin0 = layer == 0 ? (t0 < NTOKP ? p.xp + (size_t)t0 * DM : p.xs + (size_t)(t0 - NTOKP) * DM) : p.out + (size_t)t0 * DM;
        float* xo0 = p.out + (size_t)t0 * DM;
        bf16_t* xb0 = p.xb + (size_t)t0 * DM;
        float ssj[4] = {0.f, 0.f, 0.f, 0.f};
#pragma unroll
        for (int ni = 0; ni < 4; ++ni) {
#pragma unroll
          for (int g4 = 0; g4 < 4; ++g4) {
            f32x4 v; v[0] = acc[mi][ni][4 * g4]; v[1] = acc[mi][ni][4 * g4 + 1]; v[2] = acc[mi][ni][4 * g4 + 2]; v[3] = acc[mi][ni][4 * g4 + 3];
            *(f32x4*)(stg + r * 128 + (((2 * g4 + h) ^ (r & 7)) << 4)) = v;
          }
#pragma unroll
          for (int j = 0; j < 4; ++j) {
            const int row = (lane >> 3) + 8 * j, ch = lane & 7;
            const f32x4 a = *(const f32x4*)(stg + row * 128 + ((ch ^ (row & 7)) << 4));
            const size_t off = (size_t)row * DM + n_w + ni * 32 + ch * 4;
            f32x4 xv = *(const f32x4*)(xin0 + off);
            xv += a;
            *(f32x4*)(xo0 + off) = xv;
            if (layer < 3) {
              u32x2 w; w.x = cvtpk(xv[0], xv[1]); w.y = cvtpk(xv[2], xv[3]);
              *(u32x2*)(xb0 + off) = w;
              ssj[j] += xv[0] * xv[0] + xv[1] * xv[1] + xv[2] * xv[2] + xv[3] * xv[3];
            }
          }
        }
        if (layer < 3) {
#pragma unroll
          for (int j = 0; j < 4; ++j) {
            float v = ssj[j];
            v += shx(v, lane, 1); v += shx(v, lane, 2); v += shx(v, lane, 4);
            if ((lane & 7) == 0) atomicAdd(p.rstd + ((layer + 1) & 1) * NTOK + t0 + (lane >> 3) + 8 * j, v);
          }
        }
      }
    }
    if (!has_next) break;
    q = qn; mt = mtn; nt = ntn; Ag = Agn; Bg = Bgn;
  }
#undef G_TILE
#undef G_LOAD
#undef G_WRITE
#undef G_COMPUTE
}

enum { AM_PLAIN = 0, AM_SWA = 1, AM_DIFF = 2 };
struct AttnJob {
  const bf16_t* q;
  const bf16_t* k[2];
  const bf16_t* v;
  int ldk, ldv;
  int tile_lo, tile_hi;
  float m_init, l_init;
  int qpos0;
  bf16_t* o;
  const bf16_t* z;
  float lam, oscale;
  const float* subg;
  int dry;
};

template <int DV, int MODE>
DI void attn_finalize(char* lds, const AttnJob& J, f32x16 (&O)[DV / 32], const float lt, const int wid, const int r, const int h) {
  constexpr int NDV = DV / 32;
  const float inv = 1.f / lt;
  if (MODE != AM_DIFF) {
    bf16_t* orow = J.o + (size_t)r * UW; const bf16_t* zrow = J.z + (size_t)r * UW;
#pragma unroll
    for (int d = 0; d < NDV; ++d)
#pragma unroll
      for (int g4 = 0; g4 < 4; ++g4) {
        const int dv = 32 * d + 8 * g4 + 4 * h;
        const u32x2 zw = *(const u32x2*)(zrow + dv);
        const float y0 = O[d][4 * g4] * inv * silu(bflo(zw.x)), y1 = O[d][4 * g4 + 1] * inv * silu(bfhi(zw.x));
        const float y2 = O[d][4 * g4 + 2] * inv * silu(bflo(zw.y)), y3 = O[d][4 * g4 + 3] * inv * silu(bfhi(zw.y));
        u32x2 w; w.x = cvtpk(y0, y1); w.y = cvtpk(y2, y3);
        *(u32x2*)(orow + dv) = w;
      }
  } else {
    float* sc = (float*)(lds + 32768) + (wid >> 1) * (DV * 32);
    if (wid & 1) {
      const float f = inv * J.lam;
#pragma unroll
      for (int d = 0; d < NDV; ++d)
#pragma unroll
        for (int i = 0; i < 16; ++i) sc[(32 * d + crow(i, h)) * 32 + r] = O[d][i] * f;
    }
    __syncthreads();
    if (!(wid & 1)) {
      float ss = 0.f;
#pragma unroll
      for (int d = 0; d < NDV; ++d)
#pragma unroll
        for (int i = 0; i < 16; ++i) { const float a = O[d][i] * inv - sc[(32 * d + crow(i, h)) * 32 + r]; O[d][i] = a; ss += a * a; }
      ss = swapsum(ss);
      const float rn = rsqrtf(ss * (1.f / DV) + EPSF) * J.oscale;
      bf16_t* orow = J.o + (size_t)r * UW; const bf16_t* zrow = J.z + (size_t)r * UW;
#pragma unroll
      for (int d = 0; d < NDV; ++d)
#pragma unroll
        for (int g4 = 0; g4 < 4; ++g4) {
          const int dv = 32 * d + 8 * g4 + 4 * h;
          const u32x2 zw = *(const u32x2*)(zrow + dv);
          const f32x4 sg = *(const f32x4*)(J.subg + dv);
          const float y0 = O[d][4 * g4] * rn * sg[0] * silu(bflo(zw.x)), y1 = O[d][4 * g4 + 1] * rn * sg[1] * silu(bfhi(zw.x));
          const float y2 = O[d][4 * g4 + 2] * rn * sg[2] * silu(bflo(zw.y)), y3 = O[d][4 * g4 + 3] * rn * sg[3] * silu(bfhi(zw.y));
          u32x2 w; w.x = cvtpk(y0, y1); w.y = cvtpk(y2, y3);
          *(u32x2*)(orow + dv) = w;
        }
    }
  }
}

template <int DV, int NK, int MODE, bool FIXM, int GRP>
DI void attn_job(char* lds_wg, const AttnJob& J) {
  constexpr int NDV = DV / 32;
  constexpr float C = 0.125f * LOG2E;
  const int tid_wg = ltid(), tid = tid_wg & (AT - 1), lane = tid & 63, wid = __builtin_amdgcn_readfirstlane(tid >> 6), r = lane & 31, h = lane >> 5;
  constexpr bool SHR = FIXM;
  constexpr int STN = SHR ? NTHREADS : AT;
  char* lds = lds_wg + (SHR ? 0 : GRP * 65536);
  const int st_ = SHR ? tid_wg : tid;
  const int kstream = (NK == 2) ? (wid & 1) : 0;
  bf16x8 qf[4];
  const bf16_t* qrow = J.q + (size_t)r * UW + 8 * h;
#pragma unroll
  for (int ds = 0; ds < 4; ++ds) qf[ds] = *(const bf16x8*)(qrow + 16 * ds);
  f32x16 O[NDV];
#pragma unroll
  for (int d = 0; d < NDV; ++d)
#pragma unroll
    for (int i = 0; i < 16; ++i) O[d][i] = 0.f;
  float m = J.m_init, l = (h == 0) ? J.l_init : 0.f;
  f32x16 Osum;
#pragma unroll
  for (int i = 0; i < 16; ++i) Osum[i] = 0.f;
  const bf16x8 ones = {0x3F80, 0x3F80, 0x3F80, 0x3F80, 0x3F80, 0x3F80, 0x3F80, 0x3F80};
  constexpr int KI = 512 / STN;
  const int ksrow = st_ >> 3, ksch = st_ & 7;
  const int kpi = (ksrow & ~12) | ((ksrow & 4) << 1) | ((ksrow & 8) >> 1);
  const int ksoff = kpi * 128 + ((ksch ^ ((kpi >> 1) & 7)) << 4);
  constexpr int VCH = DV / 8;
  constexpr int VI = (64 * VCH) / STN;
  const int vkey0 = st_ / VCH, vc8 = (st_ % VCH) * 8;
  u32x4 rk0[NK][KI], rv0[VI], rk1[NK][KI], rv1[VI];
#define A_LOAD(t, rk, rv) do { const size_t kb_ = (size_t)(t) * 64; \
    _Pragma("unroll") for (int s = 0; s < NK; ++s) _Pragma("unroll") for (int i = 0; i < KI; ++i) rk[s][i] = *(const u32x4*)(J.k[s] + (kb_ + ksrow + 32 * i) * J.ldk + ksch * 8); \
    _Pragma("unroll") for (int i = 0; i < VI; ++i) rv[i] = *(const u32x4*)(J.v + (kb_ + vkey0 + (STN / VCH) * i) * J.ldv + vc8); } while (0)
#define A_WRITE(st, rk, rv) do { char* b_ = lds + (st) * 32768; \
    _Pragma("unroll") for (int s = 0; s < NK; ++s) _Pragma("unroll") for (int i = 0; i < KI; ++i) *(u32x4*)(b_ + s * 8192 + i * 4096 + ksoff) = rk[s][i]; \
    _Pragma("unroll") for (int i = 0; i < VI; ++i) { const int key_ = vkey0 + (STN / VCH) * i; \
      *(u32x4*)(b_ + NK * 8192 + ((key_ >> 3) * NDV + (vc8 >> 5)) * 512 + (key_ & 7) * 64 + (vc8 & 31) * 2) = rv[i]; } } while (0)
  const int nt = J.tile_hi - J.tile_lo;
  constexpr bool DEEP2 = FIXM || MODE != AM_DIFF;
  constexpr bool ONESET = FIXM;
  A_LOAD(J.tile_lo, rk0, rv0); A_WRITE(0, rk0, rv0); if (ONESET) A_LOAD(J.tile_lo + 1, rk0, rv0); else if (DEEP2) A_LOAD(J.tile_lo + 1, rk1, rv1); __syncthreads();
  const int i16 = lane & 15;
  const int vrd = h * NDV * 512 + (i16 >> 2) * 64 + (((lane >> 4) & 1) * 16 + (i16 & 3) * 4) * 2;
  auto compute = [&](const int stage, const int tile) __attribute__((always_inline)) {
    bool active = true;
    if (MODE == AM_SWA) { const int k0 = tile * 64; active = !(k0 > J.qpos0 + 31 + 128 || k0 + 63 < J.qpos0 - 128); }
    if (active) {
      const char* Kl = lds + stage * 32768 + kstream * 8192 + r * 128;
      f32x16 sA, sB;
#pragma unroll
      for (int i = 0; i < 16; ++i) { sA[i] = 0.f; sB[i] = 0.f; }
      if (NDV == 2 || FIXM) {
        bf16x8 ka[4], kb[4];
#pragma unroll
        for (int ds = 0; ds < 4; ++ds) { const int co = ((2 * ds + h) ^ ((r >> 1) & 7)) << 4; ka[ds] = *(const bf16x8*)(Kl + co); kb[ds] = *(const bf16x8*)(Kl + 4096 + co); }
#pragma unroll
        for (int ds = 0; ds < 4; ++ds) { sA = MFMA32(ka[ds], qf[ds], sA); sB = MFMA32(kb[ds], qf[ds], sB); }
        __builtin_amdgcn_sched_group_barrier(0x100, 4, 0); __builtin_amdgcn_sched_group_barrier(0x008, 2, 0);
        __builtin_amdgcn_sched_group_barrier(0x100, 2, 0); __builtin_amdgcn_sched_group_barrier(0x008, 2, 0);
        __builtin_amdgcn_sched_group_barrier(0x100, 2, 0); __builtin_amdgcn_sched_group_barrier(0x008, 4, 0);
      } else {
#pragma unroll
        for (int ds = 0; ds < 4; ++ds) {
          const int co = ((2 * ds + h) ^ ((r >> 1) & 7)) << 4;
          const bf16x8 ka = *(const bf16x8*)(Kl + co), kb = *(const bf16x8*)(Kl + 4096 + co);
          sA = MFMA32(ka, qf[ds], sA); sB = MFMA32(kb, qf[ds], sB);
        }
      }
      if (MODE == AM_SWA) {
        const int qa = J.qpos0 + r, kbase = tile * 64 + 8 * h;
#pragma unroll
        for (int i = 0; i < 16; ++i) {
          const int ka_ = kbase + 16 * (i >> 3) + (i & 7);
          int d0 = qa - ka_; d0 = d0 < 0 ? -d0 : d0; if (d0 > 128) sA[i] = -INFINITY;
          int d1 = qa - (ka_ + 32); d1 = d1 < 0 ? -d1 : d1; if (d1 > 128) sB[i] = -INFINITY;
        }
      }
      if (FIXM) {
        const float nm = -J.m_init;
#pragma unroll
        for (int i = 0; i < 16; ++i) { sA[i] = __builtin_amdgcn_exp2f(fmaf(sA[i], C, nm)); sB[i] = __builtin_amdgcn_exp2f(fmaf(sB[i], C, nm)); l += sA[i] + sB[i]; }
      } else {
      float mx = sA[0];
#pragma unroll
      for (int i = 1; i < 16; ++i) mx = fmaxf(mx, sA[i]);
#pragma unroll
      for (int i = 0; i < 16; ++i) mx = fmaxf(mx, sB[i]);
      mx = swapmax(mx);
      const float mn = fmaxf(m, mx * C);
      const float alpha = __builtin_amdgcn_exp2f(m - mn);
      m = mn;
      float ps = 0.f;
#pragma unroll
      for (int i = 0; i < 16; ++i) { sA[i] = __builtin_amdgcn_exp2f(fmaf(sA[i], C, -mn)); sB[i] = __builtin_amdgcn_exp2f(fmaf(sB[i], C, -mn)); ps += sA[i] + sB[i]; }
      l = l * alpha + ps;
#pragma unroll
      for (int d = 0; d < NDV; ++d)
#pragma unroll
        for (int i = 0; i < 16; ++i) O[d][i] *= alpha;
      }
      bf16x8 pf[4];
      { u32x4 w;
        w.x = cvtpk(sA[0], sA[1]); w.y = cvtpk(sA[2], sA[3]); w.z = cvtpk(sA[4], sA[5]); w.w = cvtpk(sA[6], sA[7]); pf[0] = __builtin_bit_cast(bf16x8, w);
        w.x = cvtpk(sA[8], sA[9]); w.y = cvtpk(sA[10], sA[11]); w.z = cvtpk(sA[12], sA[13]); w.w = cvtpk(sA[14], sA[15]); pf[1] = __builtin_bit_cast(bf16x8, w);
        w.x = cvtpk(sB[0], sB[1]); w.y = cvtpk(sB[2], sB[3]); w.z = cvtpk(sB[4], sB[5]); w.w = cvtpk(sB[6], sB[7]); pf[2] = __builtin_bit_cast(bf16x8, w);
        w.x = cvtpk(sB[8], sB[9]); w.y = cvtpk(sB[10], sB[11]); w.z = cvtpk(sB[12], sB[13]); w.w = cvtpk(sB[14], sB[15]); pf[3] = __builtin_bit_cast(bf16x8, w); }
      const char* Vl = lds + stage * 32768 + NK * 8192 + vrd;
      if (FIXM) {
        bf16x8 vf[4][NDV];
#pragma unroll
        for (int ks = 0; ks < 4; ++ks) {
#pragma unroll
          for (int d = 0; d < NDV; ++d) {
            const s16x4 lo = __builtin_amdgcn_ds_read_tr16_b64_v4i16((LAS s16x4*)(Vl + ks * 2 * NDV * 512 + d * 512));
            const s16x4 hi = __builtin_amdgcn_ds_read_tr16_b64_v4i16((LAS s16x4*)(Vl + ks * 2 * NDV * 512 + d * 512 + 256));
            vf[ks][d] = __builtin_shufflevector(lo, hi, 0, 1, 2, 3, 4, 5, 6, 7);
          }
        }
#pragma unroll
        for (int ks = 0; ks < 4; ++ks) {
#pragma unroll
          for (int d = 0; d < NDV; ++d) O[d] = MFMA32(vf[ks][d], pf[ks], O[d]);
        }
        __builtin_amdgcn_sched_group_barrier(0x100, 4 * NDV, 0); __builtin_amdgcn_sched_group_barrier(0x008, NDV, 0);
        __builtin_amdgcn_sched_group_barrier(0x100, 2 * NDV, 0); __builtin_amdgcn_sched_group_barrier(0x008, NDV, 0);
        __builtin_amdgcn_sched_group_barrier(0x100, 2 * NDV, 0); __builtin_amdgcn_sched_group_barrier(0x008, 2 * NDV, 0);
      } else {
      if (FIXM) {
#pragma unroll
        for (int ks = 0; ks < 4; ++ks) Osum = MFMA32(ones, pf[ks], Osum);
      }
#pragma unroll
      for (int ks = 0; ks < 4; ++ks)
#pragma unroll
        for (int d = 0; d < NDV; ++d) {
          const s16x4 lo = __builtin_amdgcn_ds_read_tr16_b64_v4i16((LAS s16x4*)(Vl + ks * 2 * NDV * 512 + d * 512));
          const s16x4 hi = __builtin_amdgcn_ds_read_tr16_b64_v4i16((LAS s16x4*)(Vl + ks * 2 * NDV * 512 + d * 512 + 256));
          const bf16x8 vf = __builtin_shufflevector(lo, hi, 0, 1, 2, 3, 4, 5, 6, 7);
          O[d] = MFMA32(vf, pf[ks], O[d]);
        }
      }
    }
  };
  for (int it = 0; it < nt; it += 2) {
    if (ONESET) {
      A_WRITE(1, rk0, rv0);
      if (it + 2 < nt) A_LOAD(J.tile_lo + it + 2, rk0, rv0);
      compute(0, J.tile_lo + it);
      __syncthreads();
      if (it + 2 < nt) A_WRITE(0, rk0, rv0);
      if (it + 3 < nt) A_LOAD(J.tile_lo + it + 3, rk0, rv0);
      compute(1, J.tile_lo + it + 1);
      __syncthreads();
    } else if (DEEP2) {
      if (it + 2 < nt) A_LOAD(J.tile_lo + it + 2, rk0, rv0);
      compute(0, J.tile_lo + it);
      A_WRITE(1, rk1, rv1);
      __syncthreads();
      if (it + 3 < nt) A_LOAD(J.tile_lo + it + 3, rk1, rv1);
      compute(1, J.tile_lo + it + 1);
      if (it + 2 < nt) A_WRITE(0, rk0, rv0);
      __syncthreads();
    } else {
      compute(0, J.tile_lo + it);
      __builtin_amdgcn_sched_barrier(0);
      A_LOAD(J.tile_lo + it + 1, rk0, rv0); A_WRITE(1, rk0, rv0);
      __syncthreads();
      compute(1, J.tile_lo + it + 1);
      __builtin_amdgcn_sched_barrier(0);
      if (it + 2 < nt) { A_LOAD(J.tile_lo + it + 2, rk0, rv0); A_WRITE(0, rk0, rv0); }
      __syncthreads();
    }
  }
#undef A_LOAD
#undef A_WRITE
  if (J.dry) return;
  const float lt = swapsum(l);
  attn_finalize<DV, MODE>(SHR ? lds_wg + 32768 + GRP * 32768 : lds, J, O, lt, wid, r, h);
  if (SHR && MODE == AM_DIFF) __syncthreads();
}

template <int DV, int NK, int MODE, int GRP>
DI void attn_pipe(char* lds_wg, const AttnJob& J) {
  constexpr int NDV = DV / 32;
  constexpr float C = 0.125f * LOG2E;
  constexpr int KST = NK * 8192, VST = DV * 128, VB = 2 * KST;
  const int tid_wg = ltid(), tid = tid_wg & (AT - 1), lane = tid & 63, wid = tid >> 6, r = lane & 31, h = lane >> 5;
  char* lds = lds_wg + GRP * 65536;
  const int kstream = (NK == 2) ? (wid & 1) : 0;
  bf16x8 qf[4];
  const bf16_t* qrow = J.q + (size_t)r * UW + 8 * h;
#pragma unroll
  for (int ds = 0; ds < 4; ++ds) qf[ds] = *(const bf16x8*)(qrow + 16 * ds);
  f32x16 O[NDV], Osum;
#pragma unroll
  for (int d = 0; d < NDV; ++d)
#pragma unroll
    for (int i = 0; i < 16; ++i) O[d][i] = 0.f;
#pragma unroll
  for (int i = 0; i < 16; ++i) Osum[i] = 0.f;
  const bf16x8 ones = {0x3F80, 0x3F80, 0x3F80, 0x3F80, 0x3F80, 0x3F80, 0x3F80, 0x3F80};
  const float nm = -J.m_init;
  const int ksrow = tid >> 3, ksch = tid & 7;
  const int kpi = (ksrow & ~12) | ((ksrow & 4) << 1) | ((ksrow & 8) >> 1);
  const int ksoff = kpi * 128 + ((ksch ^ ((kpi >> 1) & 7)) << 4);
  constexpr int VCH = DV / 8, VI = (64 * VCH) / AT;
  const int vkey0 = tid / VCH, vc8 = (tid % VCH) * 8;
  u32x4 rk0[NK][2], rv0[VI], rk1[NK][2], rv1[VI];
#define K_LOAD(t, rk) do { const size_t kb_ = (size_t)(t) * 64; \
    _Pragma("unroll") for (int s = 0; s < NK; ++s) _Pragma("unroll") for (int i = 0; i < 2; ++i) rk[s][i] = *(const u32x4*)(J.k[s] + (kb_ + ksrow + 32 * i) * J.ldk + ksch * 8); } while (0)
#define V_LOAD(t, rv) do { const size_t kb_ = (size_t)(t) * 64; \
    _Pragma("unroll") for (int i = 0; i < VI; ++i) rv[i] = *(const u32x4*)(J.v + (kb_ + vkey0 + (AT / VCH) * i) * J.ldv + vc8); } while (0)
#define K_WRITE(st, rk) do { char* b_ = lds + (st) * KST; \
    _Pragma("unroll") for (int s = 0; s < NK; ++s) _Pragma("unroll") for (int i = 0; i < 2; ++i) *(u32x4*)(b_ + s * 8192 + i * 4096 + ksoff) = rk[s][i]; } while (0)
#define V_WRITE(st, rv) do { char* b_ = lds + VB + (st) * VST; \
    _Pragma("unroll") for (int i = 0; i < VI; ++i) { const int key_ = vkey0 + (AT / VCH) * i; \
      *(u32x4*)(b_ + ((key_ >> 3) * NDV + (vc8 >> 5)) * 512 + (key_ & 7) * 64 + (vc8 & 31) * 2) = rv[i]; } } while (0)
  const int nt = J.tile_hi - J.tile_lo, t0 = J.tile_lo;
  const int i16 = lane & 15;
  const int vrd = h * NDV * 512 + (i16 >> 2) * 64 + (((lane >> 4) & 1) * 16 + (i16 & 3) * 4) * 2;
  auto qk = [&](const int kst, f32x16& sA, f32x16& sB) __attribute__((always_inline)) {
    const char* Kl = lds + kst * KST + kstream * 8192 + r * 128;
#pragma unroll
    for (int i = 0; i < 16; ++i) { sA[i] = 0.f; sB[i] = 0.f; }
    bf16x8 ka[4], kb[4];
#pragma unroll
    for (int ds = 0; ds < 4; ++ds) { const int co = ((2 * ds + h) ^ ((r >> 1) & 7)) << 4; ka[ds] = *(const bf16x8*)(Kl + co); kb[ds] = *(const bf16x8*)(Kl + 4096 + co); }
    __builtin_amdgcn_sched_barrier(0);
#pragma unroll
    for (int ds = 0; ds < 4; ++ds) { sA = MFMA32(ka[ds], qf[ds], sA); sB = MFMA32(kb[ds], qf[ds], sB); }
  };
  auto smpv = [&](const int vst, f32x16& sA, f32x16& sB) __attribute__((always_inline)) {
    const char* Vl = lds + VB + vst * VST + vrd;
    bf16x8 vf[4][NDV];
#pragma unroll
    for (int ks = 0; ks < 4; ++ks)
#pragma unroll
      for (int d = 0; d < NDV; ++d) {
        const s16x4 lo = __builtin_amdgcn_ds_read_tr16_b64_v4i16((LAS s16x4*)(Vl + ks * 2 * NDV * 512 + d * 512));
        const s16x4 hi = __builtin_amdgcn_ds_read_tr16_b64_v4i16((LAS s16x4*)(Vl + ks * 2 * NDV * 512 + d * 512 + 256));
        vf[ks][d] = __builtin_shufflevector(lo, hi, 0, 1, 2, 3, 4, 5, 6, 7);
      }
    __builtin_amdgcn_sched_barrier(0);
#pragma unroll
    for (int i = 0; i < 16; ++i) { sA[i] = __builtin_amdgcn_exp2f(fmaf(sA[i], C, nm)); sB[i] = __builtin_amdgcn_exp2f(fmaf(sB[i], C, nm)); }
    bf16x8 pf[4];
    { u32x4 w;
      w.x = cvtpk(sA[0], sA[1]); w.y = cvtpk(sA[2], sA[3]); w.z = cvtpk(sA[4], sA[5]); w.w = cvtpk(sA[6], sA[7]); pf[0] = __builtin_bit_cast(bf16x8, w);
      w.x = cvtpk(sA[8], sA[9]); w.y = cvtpk(sA[10], sA[11]); w.z = cvtpk(sA[12], sA[13]); w.w = cvtpk(sA[14], sA[15]); pf[1] = __builtin_bit_cast(bf16x8, w);
      w.x = cvtpk(sB[0], sB[1]); w.y = cvtpk(sB[2], sB[3]); w.z = cvtpk(sB[4], sB[5]); w.w = cvtpk(sB[6], sB[7]); pf[2] = __builtin_bit_cast(bf16x8, w);
      w.x = cvtpk(sB[8], sB[9]); w.y = cvtpk(sB[10], sB[11]); w.z = cvtpk(sB[12], sB[13]); w.w = cvtpk(sB[14], sB[15]); pf[3] = __builtin_bit_cast(bf16x8, w); }
#pragma unroll
    for (int ks = 0; ks < 4; ++ks) Osum = MFMA32(ones, pf[ks], Osum);
#pragma unroll
    for (int ks = 0; ks < 4; ++ks)
#pragma unroll
      for (int d = 0; d < NDV; ++d) O[d] = MFMA32(vf[ks][d], pf[ks], O[d]);
  };
  K_LOAD(t0, rk0); V_LOAD(t0, rv0); K_LOAD(t0 + 1, rk1);
  K_WRITE(0, rk0); V_WRITE(0, rv0); K_WRITE(1, rk1);
  if (2 < nt) K_LOAD(t0 + 2, rk0);
  V_LOAD(t0 + 1, rv0);
  __syncthreads();
  f32x16 eA, eB, oA, oB;
  qk(0, eA, eB);
  __syncthreads();
  for (int j = 0; j < nt; j += 2) {
    if (j + 3 < nt) K_LOAD(t0 + j + 3, rk1);
    if (j + 2 < nt) V_LOAD(t0 + j + 2, rv1);
    qk(1, oA, oB);
    __builtin_amdgcn_sched_barrier(0);
    smpv(0, eA, eB);
    if (j + 2 < nt) K_WRITE(0, rk0);
    V_WRITE(1, rv0);
    __syncthreads();
    if (j + 4 < nt) K_LOAD(t0 + j + 4, rk0);
    if (j + 3 < nt) V_LOAD(t0 + j + 3, rv0);
    if (j + 2 < nt) qk(0, eA, eB);
    __builtin_amdgcn_sched_barrier(0);
    smpv(1, oA, oB);
    if (j + 3 < nt) K_WRITE(1, rk1);
    if (j + 2 < nt) V_WRITE(0, rv1);
    __syncthreads();
  }
#undef K_LOAD
#undef V_LOAD
#undef K_WRITE
#undef V_WRITE
  if (J.dry) return;
  attn_finalize<DV, MODE>(lds, J, O, Osum[0], wid, r, h);
}

#define PIPE_CALL(DV, NK, MODE) do { if (grp) attn_pipe<DV, NK, MODE, 1>(lds, J); else attn_pipe<DV, NK, MODE, 0>(lds, J); } while (0)
#define ATTN_CALL(DV, NK, MODE, FIXM) do { if (grp) attn_job<DV, NK, MODE, FIXM, 1>(lds, J); else attn_job<DV, NK, MODE, FIXM, 0>(lds, J); } while (0)
DI void mem_jobs(char* lds, const Params& p, int layer, int dry) {
  const int grp = __builtin_amdgcn_readfirstlane(ltid() >> 8);
  const int wid = __builtin_amdgcn_readfirstlane((ltid() >> 6) & 3), vb = blockIdx.x * 2 + grp, vg = gridDim.x * 2;
  for (int job = vb; job < 768 * 4; job += vg) {
    const int qb = job >> 2, hm = job & 3, t0 = qb * 128;
    int S, seq0, pos, sq; tok_info(t0, S, seq0, pos, sq);
    AttnJob J;
    bf16_t* qo = p.u + (size_t)(t0 + 32 * wid) * UW + 2304 + hm * 64;
    J.q = qo; J.o = qo; J.z = p.u + (size_t)(t0 + 32 * wid) * UW + 2560 + 1024 + hm * 64;
    J.k[0] = J.k[1] = p.memkv + (size_t)(sq * 256) * 2048 + layer * 512 + hm * 64; J.v = J.k[0] + 256; J.ldk = J.ldv = 2048;
    J.tile_lo = 0; J.tile_hi = 4; J.m_init = -1e30f; J.l_init = 0.f; J.qpos0 = 0; J.lam = 0.f; J.oscale = 0.f; J.subg = nullptr; J.dry = dry;
    ATTN_CALL(64, 1, AM_PLAIN, false);
  }
}

DI void phase_mix_even(char* lds, const Params& p, int layer, int dry) {
  const int grp = __builtin_amdgcn_readfirstlane(ltid() >> 8);
  const int e = layer >> 1, wid = __builtin_amdgcn_readfirstlane((ltid() >> 6) & 3), vb = blockIdx.x * 2 + grp, vg = gridDim.x * 2;
  for (int job = vb; job < 768 * 8; job += vg) {
    const int qb = job >> 3, hq = job & 7, kvh = hq >> 2, t0 = qb * 128;
    int S, seq0, pos, sq; tok_info(t0, S, seq0, pos, sq);
    AttnJob J;
    bf16_t* qo = p.u + (size_t)(t0 + 32 * wid) * UW + 1536 + hq * 64;
    J.q = qo; J.o = qo; J.z = p.u + (size_t)(t0 + 32 * wid) * UW + 2560 + 512 + hq * 64;
    J.k[0] = J.k[1] = p.u + (size_t)seq0 * UW + 2048 + kvh * 64; J.v = p.u + (size_t)seq0 * UW + 2176 + kvh * 64; J.ldk = J.ldv = UW;
    const int pt = pos >> 6;
    J.tile_lo = pt - 2 < 0 ? 0 : pt - 2; J.tile_hi = pt + 4 > (S >> 6) ? (S >> 6) : pt + 4;
    J.m_init = p.swa_sink[e * 8 + hq] * LOG2E; J.l_init = 1.f; J.qpos0 = pos + 32 * wid; J.lam = 0.f; J.oscale = 0.f; J.subg = nullptr; J.dry = dry;
    ATTN_CALL(64, 1, AM_SWA, false);
  }
  mem_jobs(lds, p, layer, dry);
  const float* cw = p.conv_w + e * 3 * 512;
  for (int idx = blockIdx.x * NTHREADS + ltid(); idx < NTOK * 64; idx += gridDim.x * NTHREADS) {
    const int t = idx >> 6, c0 = (idx & 63) * 8;
    int S, seq0, pos, sq; tok_info(t, S, seq0, pos, sq);
    bf16_t* ur = p.u + (size_t)t * UW;
    float ic[8], il[8], ir[8];
    { const u32x4 a = *(const u32x4*)(ur + 512 + c0), b = *(const u32x4*)(ur + 1024 + c0);
#pragma unroll
      for (int j = 0; j < 4; ++j) { ic[2 * j] = bflo(a[j]) * bflo(b[j]); ic[2 * j + 1] = bfhi(a[j]) * bfhi(b[j]); } }
    if (pos > 0) { const u32x4 a = *(const u32x4*)(ur - UW + 512 + c0), b = *(const u32x4*)(ur - UW + 1024 + c0);
#pragma unroll
      for (int j = 0; j < 4; ++j) { il[2 * j] = bflo(a[j]) * bflo(b[j]); il[2 * j + 1] = bfhi(a[j]) * bfhi(b[j]); } }
    else {
#pragma unroll
      for (int j = 0; j < 8; ++j) il[j] = 0.f; }
    if (pos < S - 1) { const u32x4 a = *(const u32x4*)(ur + UW + 512 + c0), b = *(const u32x4*)(ur + UW + 1024 + c0);
#pragma unroll
      for (int j = 0; j < 4; ++j) { ir[2 * j] = bflo(a[j]) * bflo(b[j]); ir[2 * j + 1] = bfhi(a[j]) * bfhi(b[j]); } }
    else {
#pragma unroll
      for (int j = 0; j < 8; ++j) ir[j] = 0.f; }
    const u32x4 gbw = *(const u32x4*)(ur + c0), zw = *(const u32x4*)(ur + 2560 + c0);
    float y[8];
#pragma unroll
    for (int j = 0; j < 8; ++j) {
      const float gb = (j & 1) ? bfhi(gbw[j >> 1]) : bflo(gbw[j >> 1]);
      const float z = (j & 1) ? bfhi(zw[j >> 1]) : bflo(zw[j >> 1]);
      const float cv = il[j] * cw[c0 + j] + ic[j] * cw[512 + c0 + j] + ir[j] * cw[1024 + c0 + j];
      y[j] = gb * cv * silu(z);
    }
    u32x4 w; w.x = cvtpk(y[0], y[1]); w.y = cvtpk(y[2], y[3]); w.z = cvtpk(y[4], y[5]); w.w = cvtpk(y[6], y[7]);
    if (!dry) *(u32x4*)(ur + c0) = w;
  }
}

DI void phase_mix_odd(char* lds, const Params& p, int layer, int dry) {
  const int grp = __builtin_amdgcn_readfirstlane(ltid() >> 8);
  const int o = layer >> 1, wid = __builtin_amdgcn_readfirstlane((ltid() >> 6) & 3);
  const int nx = (gridDim.x & 7) == 0 ? 8 : 1, bx = blockIdx.x % nx, bi = (blockIdx.x / nx) * 2 + grp, nbx = (gridDim.x / nx) * 2;
  const float mb_dense = p.lam[8 + o * 2], mb_diff = p.lam[8 + o * 2 + 1];
  const bool fix_dense = mb_dense < 43.f, fix_diff = mb_diff < 43.f;
#pragma unroll 1
  for (int part = 0; part < 2; ++part) {
    const int gshift = part ? 7 : 8, nv = (16 / nx) << gshift;
#pragma unroll 1
    for (int v = bi; v < nv; v += nbx) {
      const int j = ((bx + nx * (v >> gshift)) << gshift) + (v & ((1 << gshift) - 1));
      int g, qb, kvh, seq0, S;
      if (!part) { g = j & 3; qb = (j >> 2) & 63; kvh = (j >> 8) & 1; seq0 = (j >> 9) * 8192; S = 8192; }
      else { g = j & 3; qb = (j >> 2) & 31; kvh = (j >> 7) & 1; seq0 = NTOKP + (j >> 8) * 4096; S = 4096; }
      const int hq = kvh * 4 + g, t0 = seq0 + qb * 128 + 32 * wid;
      AttnJob J;
      bf16_t* qo = p.u + (size_t)t0 * UW + hq * 64;
      J.q = qo; J.o = qo; J.z = p.u + (size_t)t0 * UW + 2560 + hq * 64;
      J.k[0] = J.k[1] = p.u + (size_t)seq0 * UW + 512 + kvh * 64; J.v = p.u + (size_t)seq0 * UW + 640 + kvh * 64; J.ldk = J.ldv = UW;
      J.tile_lo = 0; J.tile_hi = S >> 6; J.l_init = 0.f; J.qpos0 = 0; J.lam = 0.f; J.oscale = 0.f; J.subg = nullptr; J.dry = dry;
      if (fix_dense) { J.m_init = mb_dense; ATTN_CALL(64, 1, AM_PLAIN, true); }
      else { J.m_init = -1e30f; ATTN_CALL(64, 1, AM_PLAIN, false); }
    }
  }
  const float lam = p.lam[o * 2], osc = p.lam[o * 2 + 1];
#pragma unroll 1
  for (int part = 0; part < 2; ++part) {
    const int gshift = part ? 6 : 7, nv = (32 / nx) << gshift;
#pragma unroll 1
    for (int v = bi; v < nv; v += nbx) {
      const int j = ((bx + nx * (v >> gshift)) << gshift) + (v & ((1 << gshift) - 1));
      int qb, hh, seq0, S;
      if (!part) { qb = j & 127; hh = (j >> 7) & 3; seq0 = (j >> 9) * 8192; S = 8192; }
      else { qb = j & 63; hh = (j >> 6) & 3; seq0 = NTOKP + (j >> 8) * 4096; S = 4096; }
      const int mp = wid & 1, sub = wid >> 1, t0 = seq0 + qb * 64 + sub * 32;
      AttnJob J;
      J.q = p.u + (size_t)t0 * UW + 768 + (2 * hh + mp) * 64;
      J.o = p.u + (size_t)t0 * UW + 768 + hh * 128; J.z = p.u + (size_t)t0 * UW + 2560 + 512 + hh * 128;
      J.k[0] = p.u + (size_t)seq0 * UW + 1280 + (2 * hh) * 64; J.k[1] = J.k[0] + 64; J.v = p.u + (size_t)seq0 * UW + 1792 + hh * 128; J.ldk = J.ldv = UW;
      J.tile_lo = 0; J.tile_hi = S >> 6; J.l_init = 0.f; J.qpos0 = 0; J.lam = lam; J.oscale = osc; J.subg = p.diff_subln_g + o * 128; J.dry = dry;
      if (fix_diff) { J.m_init = mb_diff; ATTN_CALL(128, 2, AM_DIFF, true); }
      else { J.m_init = -1e30f; ATTN_CALL(128, 2, AM_DIFF, false); }
    }
  }
  mem_jobs(lds, p, layer, dry);
}

DI void phase_norm(const Params& p) {
  const int gw = blockIdx.x * 8 + __builtin_amdgcn_readfirstlane(ltid() >> 6), nw = gridDim.x * 8;
  norm_rows(p.out, p.xb, p.rstd, 0, NTOK, gw, nw);
}

#define XB_TMO      128
#define XB_XCNT(j)  (256  + 64 * (j))
#define XB_XSUB(j)  (1280 + 64 * (j))
#define XB_XGEN(j)  (2304 + 64 * (j))
#define XB_TOP      3328
#define XB_TOPGEN   3392
#define XB_STATE    4096
#define XB_WORDS    8192
#define XB_SPIN_CAP (1u << 18)
DI unsigned xb_ld(unsigned* p) { return __hip_atomic_load(p, __ATOMIC_RELAXED, __HIP_MEMORY_SCOPE_AGENT); }
DI unsigned xb_add(unsigned* p, unsigned v) { return __hip_atomic_fetch_add(p, v, __ATOMIC_RELAXED, __HIP_MEMORY_SCOPE_AGENT); }
DI unsigned xb_xcc_id() { return (unsigned)__builtin_amdgcn_s_getreg((3 << 11) | 20) & 0xFu; }
#define XB_SPIN(cond, bar) do { unsigned _sp = 0; while (cond) { __builtin_amdgcn_s_sleep(1); \
    if ((++_sp & 255u) == 0u) { if (xb_ld(&(bar)[XB_TMO])) break; if (_sp > XB_SPIN_CAP) { atomicAdd(&(bar)[XB_TMO], 1u); break; } } } } while (0)
DI void xb_census(unsigned* bar, unsigned x, unsigned& nloc, unsigned& nx) {
  const unsigned G = gridDim.x;
  unsigned sum, cnt, mine, sp = 0u;
  for (;;) {
    sum = 0u; cnt = 0u; mine = 0u;
#pragma unroll
    for (unsigned j = 0; j < 16; ++j) { const unsigned c = xb_ld(&bar[XB_XCNT(j)]); sum += c; cnt += (c > 0u) ? 1u : 0u; mine = (j == x) ? c : mine; }
    if (sum == G) break;
    __builtin_amdgcn_s_sleep(1);
    if ((++sp & 255u) == 0u) { if (xb_ld(&bar[XB_TMO])) break; if (sp > XB_SPIN_CAP) { atomicAdd(&bar[XB_TMO], 1u); break; } }
  }
  nloc = mine > 0u ? mine : 1u; nx = cnt > 0u ? cnt : 1u;
}
DI void xcd_barrier(unsigned* bar) {
  asm volatile("s_waitcnt vmcnt(0)" ::: "memory");
  __syncthreads();
  if (threadIdx.x == 0) {
    __builtin_amdgcn_s_waitcnt(0);
    const unsigned x = xb_xcc_id();
    unsigned* st = bar + XB_STATE + 2 * blockIdx.x;
    unsigned nloc = xb_ld(st), nx = xb_ld(st + 1);
    if (nloc == 0u) { xb_census(bar, x, nloc, nx); __hip_atomic_store(st, nloc, __ATOMIC_RELAXED, __HIP_MEMORY_SCOPE_AGENT); __hip_atomic_store(st + 1, nx, __ATOMIC_RELAXED, __HIP_MEMORY_SCOPE_AGENT); }
    const unsigned old = xb_add(&bar[XB_XSUB(x)], 1u);
    const unsigned gen = old / nloc;
    if (old + 1u == (gen + 1u) * nloc) {
      __builtin_amdgcn_fence(__ATOMIC_RELEASE, "agent");
      asm volatile("s_waitcnt vmcnt(0)" ::: "memory");
      const unsigned og = xb_add(&bar[XB_TOP], 1u);
      const unsigned tg = og / nx;
      if (og + 1u == (tg + 1u) * nx) xb_add(&bar[XB_TOPGEN], 1u);
      else XB_SPIN(xb_ld(&bar[XB_TOPGEN]) == tg, bar);
      __builtin_amdgcn_fence(__ATOMIC_ACQUIRE, "agent");
      xb_add(&bar[XB_XGEN(x)], 1u);
      asm volatile("s_waitcnt vmcnt(0)" ::: "memory");
    } else {
      XB_SPIN(xb_ld(&bar[XB_XGEN(x)]) == gen, bar);
      __builtin_amdgcn_fence(__ATOMIC_ACQUIRE, "agent");
      asm volatile("s_waitcnt vmcnt(0)" ::: "memory");
    }
  }
  __syncthreads();
}

__global__ void __launch_bounds__(NTHREADS, 2) fwd_kernel(Params p) {
  __shared__ __attribute__((aligned(16))) char lds[LDS_BYTES];
  if (threadIdx.x == 0) (void)xb_add(&p.bar[XB_XCNT(xb_xcc_id())], 1u);
  int ph = p.phase_lo;
  if (ph == 0) {
    phase_prep(lds, p);
    ph = 1;
#if !MULTI_LAUNCH
    if (ph < p.phase_hi) cg::this_grid().sync();
#endif
  }
  for (; ph < p.phase_hi; ++ph) {
    {
      const int l = (ph - 1) / 3, s = (ph - 1) - 3 * l;
      if (s == 0) {
        if (l == 0) { GemmDesc g{p.memb, p.wt_mem, DM, DM, 16, 8, 0, 0}; gemm_phase<EPI_MEM>(lds, p, g, 0); }
        GemmDesc g{p.xb, p.wt_in + (size_t)l * UW * DM, DM, DM, NTOK / 256, UW / 256, 0, 0};
        const int nrep = ((p.probe >> 2) & 1) + 1;
#pragma unroll 1
        for (int rep = 0; rep < nrep; ++rep) gemm_phase<EPI_IN>(lds, p, g, l);
      } else if (s == 1) {
        const int nrep = ((l & 1) ? (p.probe & 1) : ((p.probe >> 1) & 1)) + 1;
#pragma unroll 1
        for (int rep = 0; rep < nrep; ++rep) {
          const int dry = rep + 1 < nrep;
          if (rep == 0) {
            float* z = p.rstd + ((l + 1) & 1) * NTOK;
            for (int i = blockIdx.x * NTHREADS + ltid(); i < NTOK; i += gridDim.x * NTHREADS) z[i] = 0.f;
          }
          if (__builtin_amdgcn_readfirstlane(ltid()) >= 256) __builtin_amdgcn_s_setprio(1);
          if (l & 1) phase_mix_odd(lds, p, l, dry); else phase_mix_even(lds, p, l, dry);
          __builtin_amdgcn_s_setprio(0);
        }
      } else if (s == 2) {
        GemmDesc g{p.u, p.wt_out + (size_t)l * DM * MIXW, UW, MIXW, NTOK / 256, DM / 256, 1, (l & 1) ? 768 : 1536};
        gemm_phase<EPI_OUT>(lds, p, g, l);
      }
    }
#if !MULTI_LAUNCH
    if (ph + 1 < p.phase_hi) xcd_barrier(p.bar);
#endif
  }
}

extern "C" void kernel_launch(void* const* d_in, const int* in_sizes, int n_in, void* d_out, int out_size, void* d_ws, size_t ws_size,
                              hipStream_t stream) {
  static int grid_blocks = 0;
  if (!grid_blocks) {
    int dev = 0, cus = 0, per_cu = 0;
    hipGetDevice(&dev);
    hipDeviceGetAttribute(&cus, hipDeviceAttributeMultiprocessorCount, dev);
    hipOccupancyMaxActiveBlocksPerMultiprocessor(&per_cu, fwd_kernel, NTHREADS, 0);
    if (per_cu > 1) per_cu = 1;
    if (per_cu < 1) per_cu = 1;
    int cap = cus * per_cu; if (cap > 256) cap = 256;
    grid_blocks = 8; while (grid_blocks * 2 <= cap) grid_blocks *= 2;
  }
  Params p{};
  p.xp = (const float*)d_in[0]; p.xs = (const float*)d_in[1]; p.memp = (const float*)d_in[2]; p.mems = (const float*)d_in[3];
  p.norm_g = (const float*)d_in[4]; p.w_in = (const float*)d_in[5]; p.w_out = (const float*)d_in[6]; p.mem_norm_g = (const float*)d_in[7];
  p.w_mem_kv = (const float*)d_in[8]; p.mem_qk_g = (const float*)d_in[9]; p.conv_w = (const float*)d_in[10]; p.swa_qk_g = (const float*)d_in[11];
  p.swa_sink = (const float*)d_in[12]; p.ax_qk_g = (const float*)d_in[13]; p.diff_qk_g = (const float*)d_in[14]; p.diff_lambda = (const float*)d_in[15];
  p.diff_subln_g = (const float*)d_in[16];
  p.out = (float*)d_out;
  char* w = (char*)d_ws; size_t off = 0;
  auto take = [&](size_t bytes) { char* r = w + off; off += (bytes + 255) & ~(size_t)255; return r; };
  p.u = (bf16_t*)take((size_t)NTOK * UW * 2);
  p.xb = (bf16_t*)take((size_t)NTOK * DM * 2);
  p.wt_in = (bf16_t*)take((size_t)4 * UW * DM * 2);
  p.wt_out = (bf16_t*)take((size_t)4 * DM * MIXW * 2);
  p.wt_mem = (bf16_t*)take((size_t)2048 * DM * 2);
  p.memb = (bf16_t*)take((size_t)4096 * DM * 2);
  p.memkv = (bf16_t*)take((size_t)4096 * 2048 * 2);
  p.rstd = (float*)take((size_t)NTOK * 4 * 2);
  p.rstd_mem = (float*)take(4096 * 4);
  p.tab1c = (float*)take(8192 * 32 * 4); p.tab1s = (float*)take(8192 * 32 * 4);
  p.tabac = (float*)take(128 * 16 * 4); p.tabas = (float*)take(128 * 16 * 4);
  p.lam = (float*)take(256);
  p.bar = (unsigned*)take(XB_WORDS * 4);
  if (off > ws_size) { fprintf(stderr, "workspace too small: need %zu have %zu\n", off, ws_size); return; }
#if MULTI_LAUNCH
  for (int ph = 0; ph < NPHASE; ++ph) {
    p.phase_lo = ph; p.phase_hi = ph + 1;
    hipLaunchKernelGGL(fwd_kernel, dim3(grid_blocks), dim3(NTHREADS), 0, stream, p);
  }
#else
  hipMemsetAsync(p.bar, 0, XB_WORDS * 4, stream);
  p.phase_lo = 0; p.phase_hi = NPHASE; p.probe = PROBE_ODD | (PROBE_EVEN << 1) | (PROBE_GIN << 2);
  void* args[] = {&p};
  hipError_t e = hipLaunchCooperativeKernel((void*)fwd_kernel, dim3(grid_blocks), dim3(NTHREADS), args, 0, stream);
  if (e != hipSuccess) fprintf(stderr, "cooperative launch failed: %s (grid %d)\n", hipGetErrorString(e), grid_blocks);
#endif
}
```

```cpp
#include <hip/hip_runtime.h>
#include <hip/hip_cooperative_groups.h>
#include <cstdint>
#include <cstdio>
namespace cg = cooperative_groups;

#ifndef MULTI_LAUNCH
#define MULTI_LAUNCH 0
#endif

#ifndef PROBE_ODD
#define PROBE_ODD 0
#endif
#ifndef PROBE_EVEN
#define PROBE_EVEN 0
#endif
#ifndef PROBE_GIN
#define PROBE_GIN 0
#endif
#define DI __device__ __forceinline__
#define LAS __attribute__((address_space(3)))
typedef unsigned short bf16_t;
typedef short bf16x8 __attribute__((ext_vector_type(8)));
typedef short s16x4 __attribute__((ext_vector_type(4)));
typedef float f32x16 __attribute__((ext_vector_type(16)));
typedef float f32x4 __attribute__((ext_vector_type(4)));
typedef unsigned u32x4 __attribute__((ext_vector_type(4)));
typedef unsigned u32x2 __attribute__((ext_vector_type(2)));

constexpr int NTOK = 98304, NTOKP = 65536, UW = 3840, DM = 1024, MIXW = 1280;
constexpr int NTHREADS = 512;
constexpr int AT = 256;
constexpr int LDS_BYTES = 131072 + 32768;
constexpr float EPSF = 1e-6f;
constexpr float LOG2E = 1.4426950408889634f;
constexpr int NPHASE = 13;

struct Params {
  const float *xp, *xs, *memp, *mems, *norm_g, *w_in, *w_out, *mem_norm_g, *w_mem_kv, *mem_qk_g, *conv_w, *swa_qk_g,
      *swa_sink, *ax_qk_g, *diff_qk_g, *diff_lambda, *diff_subln_g;
  float* out;
  bf16_t *u, *xb, *wt_in, *wt_out, *wt_mem, *memb, *memkv;
  float *rstd, *rstd_mem, *tab1c, *tab1s, *tabac, *tabas, *lam;
  unsigned* bar;
  int phase_lo, phase_hi, probe, pad_;
};

typedef __bf16 bf16x2_t __attribute__((ext_vector_type(2)));
typedef float f32x2 __attribute__((ext_vector_type(2)));
DI unsigned cvtpk(float lo, float hi) { f32x2 v = {lo, hi}; bf16x2_t b = __builtin_convertvector(v, bf16x2_t); return __builtin_bit_cast(unsigned, b); }
DI float bf2f(unsigned short b) { return __uint_as_float(((unsigned)b) << 16); }
DI float bflo(unsigned w) { return __uint_as_float(w << 16); }
DI float bfhi(unsigned w) { return __uint_as_float(w & 0xffff0000u); }
DI int ltid() { int t; asm volatile("v_mov_b32 %0, %1" : "=v"(t) : "v"(threadIdx.x)); return t; }
DI int crow(int i, int h) { return (i & 3) + 8 * (i >> 2) + 4 * h; }
DI float swapmax(float v) { auto rr = __builtin_amdgcn_permlane32_swap(__float_as_uint(v), __float_as_uint(v), false, false); return fmaxf(__uint_as_float(rr[0]), __uint_as_float(rr[1])); }
DI float swapsum(float v) { auto rr = __builtin_amdgcn_permlane32_swap(__float_as_uint(v), __float_as_uint(v), false, false); return __uint_as_float(rr[0]) + __uint_as_float(rr[1]); }
DI float shx(float v, int lane, int o) { return __int_as_float(__builtin_amdgcn_ds_bpermute(((lane ^ o) & 63) << 2, __float_as_int(v))); }
DI float silu(float z) { return z / (1.f + __expf(-z)); }
#define MFMA32(a, b, c) __builtin_amdgcn_mfma_f32_32x32x16_bf16((a), (b), (c), 0, 0, 0)

DI void tok_info(int t, int& S, int& seq0, int& pos, int& sq) {
  if (t < NTOKP) { S = 8192; seq0 = t & ~8191; pos = t & 8191; sq = t >> 13; }
  else { int tt = t - NTOKP; S = 4096; seq0 = NTOKP + (tt & ~4095); pos = tt & 4095; sq = 8 + (tt >> 12); }
}

DI void transpose_tile(char* lds, const float* src, const float* g, bf16_t* dst, int K, int N, int k0, int n0) {
  float* tile = (float*)lds;
  const int tid = ltid(), a = tid >> 6, b = tid & 63;
#pragma unroll 4
  for (int i = 0; i < 8; ++i) { int kk = i * 8 + a; float v = src[(size_t)(k0 + kk) * N + n0 + b]; if (g) v *= g[k0 + kk]; tile[kk * 65 + b] = v; }
  __syncthreads();
#pragma unroll 4
  for (int i = 0; i < 8; ++i) { int nn = i * 8 + a; float v = tile[b * 65 + nn]; dst[(size_t)(n0 + nn) * K + k0 + b] = (bf16_t)(cvtpk(v, v) & 0xffffu); }
  __syncthreads();
}

DI void norm_rows(const float* src, bf16_t* dst, float* ssq, int row_begin, int row_end, int gw, int nw) {
  const int lane = ltid() & 63;
  for (int row = row_begin + gw; row < row_end; row += nw) {
    const float* s = src + (size_t)(row - row_begin) * DM; bf16_t* d = dst + (size_t)row * DM;
    f32x4 v[4]; float ss = 0.f;
#pragma unroll
    for (int j = 0; j < 4; ++j) { v[j] = *(const f32x4*)(s + (lane + 64 * j) * 4); ss += v[j][0] * v[j][0] + v[j][1] * v[j][1] + v[j][2] * v[j][2] + v[j][3] * v[j][3]; }
#pragma unroll
    for (int o = 32; o > 0; o >>= 1) ss += shx(ss, lane, o);
    const float rs = ssq ? 1.f : rsqrtf(ss * (1.f / DM) + EPSF);
#pragma unroll
    for (int j = 0; j < 4; ++j) { u32x2 w; w.x = cvtpk(v[j][0] * rs, v[j][1] * rs); w.y = cvtpk(v[j][2] * rs, v[j][3] * rs); *(u32x2*)(d + (lane + 64 * j) * 4) = w; }
    if (ssq && lane == 0) ssq[row] = ss;
  }
}

DI void phase_prep(char* lds, const Params& p) {
  const int T_IN = 4 * 16 * 60, T_OUT = 4 * 20 * 16, T_MEM = 4 * 16 * 8;
  for (int t = blockIdx.x; t < T_IN + T_OUT + T_MEM; t += gridDim.x) {
    if (t < T_IN) { int l = t / 960, r = t % 960, kt = r / 60, nt = r % 60;
      transpose_tile(lds, p.w_in + (size_t)l * DM * UW, p.norm_g + l * DM, p.wt_in + (size_t)l * UW * DM, DM, UW, kt * 64, nt * 64); }
    else if (t < T_IN + T_OUT) { int tt = t - T_IN; int l = tt / 320, r = tt % 320, kt = r / 16, nt = r % 16;
      transpose_tile(lds, p.w_out + (size_t)l * MIXW * DM, nullptr, p.wt_out + (size_t)l * DM * MIXW, MIXW, DM, kt * 64, nt * 64); }
    else { int tt = t - T_IN - T_OUT; int l = tt / 128, r = tt % 128, kt = r / 8, nt = r % 8;
      transpose_tile(lds, p.w_mem_kv + (size_t)l * DM * 512, p.mem_norm_g + l * DM, p.wt_mem + (size_t)l * 512 * DM, DM, 512, kt * 64, nt * 64); }
  }
  const int gw = blockIdx.x * 8 + __builtin_amdgcn_readfirstlane(ltid() >> 6), nw = gridDim.x * 8;
  norm_rows(p.memp, p.memb, nullptr, 0, 2048, gw, nw);
  norm_rows(p.mems, p.memb, nullptr, 2048, 4096, gw, nw);
  norm_rows(p.xp, p.xb, p.rstd, 0, NTOKP, gw, nw);
  norm_rows(p.xs, p.xb, p.rstd, NTOKP, NTOK, gw, nw);
  const int gt = blockIdx.x * NTHREADS + ltid(), nt_ = gridDim.x * NTHREADS;
  for (int i = gt; i < 8192 * 32; i += nt_) { int pos = i >> 5, f = i & 31; float inv = powf(10000.f, -(float)(2 * f) / 64.f); float ang = (float)pos * inv; p.tab1c[i] = cosf(ang); p.tab1s[i] = sinf(ang); }
  for (int i = gt; i < 128 * 16; i += nt_) { int pos = i >> 4, f = i & 15; float inv = powf(10000.f, -(float)(2 * f) / 32.f); float ang = (float)pos * inv; p.tabac[i] = cosf(ang); p.tabas[i] = sinf(ang); }
  if (blockIdx.x == 0 && ltid() < 64) {
    const int lane = ltid();
    for (int o = 0; o < 2; ++o) {
      const float* lv = p.diff_lambda + o * 256;
      float a = lv[lane] * lv[64 + lane], b = lv[128 + lane] * lv[192 + lane];
#pragma unroll
      for (int s = 32; s > 0; s >>= 1) { a += shx(a, lane, s); b += shx(b, lane, s); }
      float li = 0.8f - 0.6f * expf(-0.3f * (float)(2 * o + 1));
      if (lane == 0) { p.lam[o * 2] = expf(a) - expf(b) + li; p.lam[o * 2 + 1] = 1.f - li; }
      float g0 = fabsf(p.ax_qk_g[o * 128 + lane]), g1 = fabsf(p.ax_qk_g[o * 128 + 64 + lane]);
      float g2 = fabsf(p.diff_qk_g[o * 128 + lane]), g3 = fabsf(p.diff_qk_g[o * 128 + 64 + lane]);
#pragma unroll
      for (int s = 32; s > 0; s >>= 1) { g0 = fmaxf(g0, shx(g0, lane, s)); g1 = fmaxf(g1, shx(g1, lane, s)); g2 = fmaxf(g2, shx(g2, lane, s)); g3 = fmaxf(g3, shx(g3, lane, s)); }
      if (lane == 0) { p.lam[8 + o * 2] = 8.f * g0 * g1 * 1.02f * LOG2E; p.lam[8 + o * 2 + 1] = 8.f * g2 * g3 * 1.02f * LOG2E; }
    }
  }
}

struct GemmDesc { const bf16_t* A; const bf16_t* Bt; int lda, K, mtiles, ntiles, remap, seg2; };
enum { EPI_IN = 0, EPI_MEM = 1, EPI_OUT = 2 };

DI void head_store(f32x16 v0, f32x16 v1, float rs, int mode, const float* gain, const Params& p, int pos, bf16_t* obase, int ldo, char* stg_wg) {
  const int tid_ = ltid(), lane = tid_ & 63, r = lane & 31, h = lane >> 5;
  char* stg = stg_wg + (tid_ >> 6) * 4096;
  v0 *= rs; v1 *= rs;
  if (mode) {
    float ss = 0.f;
#pragma unroll
    for (int i = 0; i < 16; ++i) ss += v0[i] * v0[i] + v1[i] * v1[i];
    ss = swapsum(ss);
    const float inv = rsqrtf(ss * (1.f / 64.f) + EPSF);
#pragma unroll
    for (int g4 = 0; g4 < 4; ++g4) {
      const f32x4 ga = *(const f32x4*)(gain + 8 * g4 + 4 * h), gb = *(const f32x4*)(gain + 32 + 8 * g4 + 4 * h);
#pragma unroll
      for (int j = 0; j < 4; ++j) { v0[4 * g4 + j] *= inv * ga[j]; v1[4 * g4 + j] *= inv * gb[j]; }
    }
    if (mode == 2) {
#pragma unroll
      for (int g4 = 0; g4 < 4; ++g4) {
        const f32x4 c = *(const f32x4*)(p.tab1c + pos * 32 + 8 * g4 + 4 * h), s = *(const f32x4*)(p.tab1s + pos * 32 + 8 * g4 + 4 * h);
#pragma unroll
        for (int j = 0; j < 4; ++j) { const int i = 4 * g4 + j; const float x1 = v0[i], x2 = v1[i]; v0[i] = x1 * c[j] - x2 * s[j]; v1[i] = x2 * c[j] + x1 * s[j]; }
      }
    } else if (mode == 3) {
      const int row = pos >> 6, col = pos & 63;
#pragma unroll
      for (int g4 = 0; g4 < 2; ++g4) {
        const f32x4 c0 = *(const f32x4*)(p.tabac + row * 16 + 8 * g4 + 4 * h), s0 = *(const f32x4*)(p.tabas + row * 16 + 8 * g4 + 4 * h);
        const f32x4 c1 = *(const f32x4*)(p.tabac + col * 16 + 8 * g4 + 4 * h), s1 = *(const f32x4*)(p.tabas + col * 16 + 8 * g4 + 4 * h);
#pragma unroll
        for (int j = 0; j < 4; ++j) { const int i = 4 * g4 + j;
          float x1 = v0[i], x2 = v0[i + 8]; v0[i] = x1 * c0[j] - x2 * s0[j]; v0[i + 8] = x2 * c0[j] + x1 * s0[j];
          x1 = v1[i]; x2 = v1[i + 8]; v1[i] = x1 * c1[j] - x2 * s1[j]; v1[i + 8] = x2 * c1[j] + x1 * s1[j]; }
      }
    }
  }
#pragma unroll
  for (int g4 = 0; g4 < 4; ++g4) {
    u32x2 w0, w1; w0.x = cvtpk(v0[4 * g4], v0[4 * g4 + 1]); w0.y = cvtpk(v0[4 * g4 + 2], v0[4 * g4 + 3]);
    w1.x = cvtpk(v1[4 * g4], v1[4 * g4 + 1]); w1.y = cvtpk(v1[4 * g4 + 2], v1[4 * g4 + 3]);
    *(u32x2*)(stg + r * 128 + ((g4 ^ (r & 7)) << 4) + h * 8) = w0;
    *(u32x2*)(stg + r * 128 + (((4 + g4) ^ (r & 7)) << 4) + h * 8) = w1;
  }
#pragma unroll
  for (int j = 0; j < 4; ++j) {
    const int row = (lane >> 3) + 8 * j, ch = lane & 7;
    const u32x4 w = *(const u32x4*)(stg + row * 128 + ((ch ^ (row & 7)) << 4));
    *(u32x4*)(obase + (size_t)row * ldo + ch * 8) = w;
  }
}

DI int in_mode(const Params& p, int layer, int n_h, const float*& gain) {
  int mode = 0; gain = p.mem_qk_g;
  if ((layer & 1) == 0) { const int e = layer >> 1;
    if (n_h >= 1536 && n_h < 2048) { mode = 2; gain = p.swa_qk_g + (e * 2) * 64; }
    else if (n_h >= 2048 && n_h < 2176) { mode = 2; gain = p.swa_qk_g + (e * 2 + 1) * 64; }
    else if (n_h >= 2304 && n_h < 2560) { mode = 1; gain = p.mem_qk_g + (layer * 2) * 64; }
  } else { const int o = layer >> 1;
    if (n_h < 512) { mode = 3; gain = p.ax_qk_g + (o * 2) * 64; }
    else if (n_h < 640) { mode = 3; gain = p.ax_qk_g + (o * 2 + 1) * 64; }
    else if (n_h >= 768 && n_h < 1280) { mode = 2; gain = p.diff_qk_g + (o * 2) * 64; }
    else if (n_h >= 1280 && n_h < 1792) { mode = 2; gain = p.diff_qk_g + (o * 2 + 1) * 64; }
    else if (n_h >= 2304 && n_h < 2560) { mode = 1; gain = p.mem_qk_g + (layer * 2) * 64; }
  }
  return mode;
}

template <int EPI>
DI void gemm_phase(char* lds, const Params& p, const GemmDesc g, int layer) {
  const int tid = ltid(), lane = tid & 63, wid = __builtin_amdgcn_readfirstlane(tid >> 6), wm = wid >> 1, wn = wid & 1, r = lane & 31, h = lane >> 5;
  const int srow = tid >> 3, sch = tid & 7;
  const int soff = srow * 128 + ((sch ^ ((srow >> 1) & 7)) << 4);
  const int nk = g.K >> 6;
  const int ntile = g.mtiles * g.ntiles;
  const bool banded = ((gridDim.x & 7) == 0) && ((g.mtiles & 63) == 0);
  const int nx = banded ? 8 : 1, bx = blockIdx.x % nx, bi = blockIdx.x / nx, nbx = gridDim.x / nx;
  const int per_band = 8 * g.ntiles;
  const int qtot = ntile / nx;
  int q = bi;
  if (q >= qtot) return;
  int mt, nt;
#define G_TILE(qq, MT, NT) do { if (banded) { const int bl_ = (qq) / per_band, rem_ = (qq) - bl_ * per_band; NT = rem_ >> 3; MT = (bl_ * 8 + bx) * 8 + (rem_ & 7); } \
    else { MT = (qq) / g.ntiles; NT = (qq) - MT * g.ntiles; } } while (0)
#define G_LOAD(AG, BG, kt, RA, RB) do { const int k0_ = (kt) * 64; int ac_ = k0_; if (g.remap) ac_ = k0_ < 512 ? k0_ : (k0_ < 1024 ? g.seg2 + k0_ - 512 : 2304 + k0_ - 1024); \
    _Pragma("unroll") for (int i = 0; i < 4; ++i) { RA[i] = *(const u32x4*)(AG + (size_t)(64 * i) * g.lda + ac_); RB[i] = *(const u32x4*)(BG + (size_t)(64 * i) * g.K + k0_); } } while (0)
#define G_WRITE(buf, RA, RB) do { _Pragma("unroll") for (int i = 0; i < 4; ++i) { *(u32x4*)(lds + (buf) * 65536 + i * 8192 + soff) = RA[i]; *(u32x4*)(lds + (buf) * 65536 + 32768 + i * 8192 + soff) = RB[i]; } } while (0)
#define G_COMPUTE(buf) do { _Pragma("unroll") for (int ks = 0; ks < 4; ++ks) { const int co_ = ((2 * ks + h) ^ ((r >> 1) & 7)) << 4; \
      const char* la_ = lds + (buf) * 65536 + (wm * 64 + r) * 128 + co_; const char* lb_ = lds + (buf) * 65536 + 32768 + (wn * 128 + r) * 128 + co_; \
      bf16x8 fa_[2], fb_[4]; fa_[0] = *(const bf16x8*)(la_); fa_[1] = *(const bf16x8*)(la_ + 4096); \
      _Pragma("unroll") for (int ni = 0; ni < 4; ++ni) fb_[ni] = *(const bf16x8*)(lb_ + ni * 4096); \
      _Pragma("unroll") for (int ni = 0; ni < 4; ++ni) { acc[0][ni] = MFMA32(fb_[ni], fa_[0], acc[0][ni]); acc[1][ni] = MFMA32(fb_[ni], fa_[1], acc[1][ni]); } } } while (0)
  G_TILE(q, mt, nt);
  const bf16_t* Ag = g.A + (size_t)(mt * 256 + srow) * g.lda + sch * 8;
  const bf16_t* Bg = g.Bt + (size_t)(nt * 256 + srow) * g.K + sch * 8;
  u32x4 ra0[4], rb0[4];
  G_LOAD(Ag, Bg, 0, ra0, rb0); G_WRITE(0, ra0, rb0); G_LOAD(Ag, Bg, 1, ra0, rb0); __syncthreads();
  for (;;) {
    const int qn = q + nbx; const bool has_next = qn < qtot;
    int mtn = mt, ntn = nt; if (has_next) G_TILE(qn, mtn, ntn);
    const bf16_t* Agn = g.A + (size_t)(mtn * 256 + srow) * g.lda + sch * 8;
    const bf16_t* Bgn = g.Bt + (size_t)(ntn * 256 + srow) * g.K + sch * 8;
    f32x16 acc[2][4];
#pragma unroll
    for (int a = 0; a < 2; ++a)
#pragma unroll
      for (int b = 0; b < 4; ++b)
#pragma unroll
        for (int i = 0; i < 16; ++i) acc[a][b][i] = 0.f;
    for (int kt = 0; kt < nk; kt += 2) {
      const bool last = kt + 2 >= nk;
      G_WRITE(1, ra0, rb0);
      if (!last) G_LOAD(Ag, Bg, kt + 2, ra0, rb0); else if (has_next) G_LOAD(Agn, Bgn, 0, ra0, rb0);
      G_COMPUTE(0);
      __syncthreads();
      if (!last || has_next) G_WRITE(0, ra0, rb0);
      if (!last) G_LOAD(Ag, Bg, kt + 3, ra0, rb0); else if (has_next) G_LOAD(Agn, Bgn, 1, ra0, rb0);
      G_COMPUTE(1);
      __syncthreads();
    }
    const int n_w = nt * 256 + wn * 128;
    if (EPI == EPI_IN) {
#pragma unroll
      for (int hu = 0; hu < 2; ++hu) {
        const int n_h = n_w + 64 * hu; const float* gain; const int mode = in_mode(p, layer, n_h, gain);
#pragma unroll
        for (int mi = 0; mi < 2; ++mi) {
          const int t = mt * 256 + wm * 64 + mi * 32 + r;
          int S, seq0, pos, sq; tok_info(t, S, seq0, pos, sq);
          const float rs = rsqrtf(p.rstd[(layer & 1) * NTOK + t] * (1.f / DM) + EPSF);
          head_store(acc[mi][2 * hu], acc[mi][2 * hu + 1], rs, mode, gain, p, pos, p.u + (size_t)(t - r) * UW + n_h, UW, lds + 131072);
        }
      }
    } else if (EPI == EPI_MEM) {
#pragma unroll
      for (int hu = 0; hu < 2; ++hu) {
        const int n_h = n_w + 64 * hu, l = n_h >> 9, c = n_h & 511;
        const int mode = c < 256 ? 1 : 0; const float* gain = p.mem_qk_g + (l * 2 + 1) * 64;
#pragma unroll
        for (int mi = 0; mi < 2; ++mi) {
          const int row = mt * 256 + wm * 64 + mi * 32 + r;
          head_store(acc[mi][2 * hu], acc[mi][2 * hu + 1], 1.f, mode, gain, p, 0, p.memkv + (size_t)(row - r) * 2048 + n_h, 2048, lds + 131072);
        }
      }
    } else {
      const int tid_ = ltid(), lane = tid_ & 63, r = lane & 31, h = lane >> 5;
      char* stg = lds + 131072 + (tid_ >> 6) * 4096;
#pragma unroll
      for (int mi = 0; mi < 2; ++mi) {
        const int t0 = mt * 256 + wm * 64 + mi * 32;
        const float* xin0 = layer == 0 ? (t0 < NTOKP ? p.xp + (size_t)t0 * DM : p.xs + (size_t)(t0 - NTOKP) * DM) : p.out + (size_t)t0 * DM;
        float* xo0 = p.out + (size_t)t0 * DM;
        bf16_t* xb0 = p.xb + (size_t)t0 * DM;
        float ssj[4] = {0.f, 0.f, 0.f, 0.f};
#pragma unroll
        for (int ni = 0; ni < 4; ++ni) {
#pragma unroll
          for (int g4 = 0; g4 < 4; ++g4) {
            f32x4 v; v[0] = acc[mi][ni][4 * g4]; v[1] = acc[mi][ni][4 * g4 + 1]; v[2] = acc[mi][ni][4 * g4 + 2]; v[3] = acc[mi][ni][4 * g4 + 3];
            *(f32x4*)(stg + r * 128 + (((2 * g4 + h) ^ (r & 7)) << 4)) = v;
          }
#pragma unroll
          for (int j = 0; j < 4; ++j) {
            const int row = (lane >> 3) + 8 * j, ch = lane & 7;
            const f32x4 a = *(const f32x4*)(stg + row * 128 + ((ch ^ (row & 7)) << 4));
            const size_t off = (size_t)row * DM + n_w + ni * 32 + ch * 4;
            f32x4 xv = *(const f32x4*)(xin0 + off);
            xv += a;
            *(f32x4*)(xo0 + off) = xv;
            if (layer < 3) {
              u32x2 w; w.x = cvtpk(xv[0], xv[1]); w.y = cvtpk(xv[2], xv[3]);
              *(u32x2*)(xb0 + off) = w;
              ssj[j] += xv[0] * xv[0] + xv[1] * xv[1] + xv[2] * xv[2] + xv[3] * xv[3];
            }
          }
        }
        if (layer < 3) {
#pragma unroll
          for (int j = 0; j < 4; ++j) {
            float v = ssj[j];
            v += shx(v, lane, 1); v += shx(v, lane, 2); v += shx(v, lane, 4);
            if ((lane & 7) == 0) atomicAdd(p.rstd + ((layer + 1) & 1) * NTOK + t0 + (lane >> 3) + 8 * j, v);
          }
        }
      }
    }
    if (!has_next) break;
    q = qn; mt = mtn; nt = ntn; Ag = Agn; Bg = Bgn;
  }
#undef G_TILE
#undef G_LOAD
#undef G_WRITE
#undef G_COMPUTE
}

enum { AM_PLAIN = 0, AM_SWA = 1, AM_DIFF = 2 };
struct AttnJob {
  const bf16_t* q;
  const bf16_t* k[2];
  const bf16_t* v;
  int ldk, ldv;
  int tile_lo, tile_hi;
  float m_init, l_init;
  int qpos0;
  bf16_t* o;
  const bf16_t* z;
  float lam, oscale;
  const float* subg;
  int dry;
};

template <int DV, int MODE>
DI void attn_finalize(char* lds, const AttnJob& J, f32x16 (&O)[DV / 32], const float lt, const int wid, const int r, const int h) {
  constexpr int NDV = DV / 32;
  const float inv = 1.f / lt;
  if (MODE != AM_DIFF) {
    bf16_t* orow = J.o + (size_t)r * UW; const bf16_t* zrow = J.z + (size_t)r * UW;
#pragma unroll
    for (int d = 0; d < NDV; ++d)
#pragma unroll
      for (int g4 = 0; g4 < 4; ++g4) {
        const int dv = 32 * d + 8 * g4 + 4 * h;
        const u32x2 zw = *(const u32x2*)(zrow + dv);
        const float y0 = O[d][4 * g4] * inv * silu(bflo(zw.x)), y1 = O[d][4 * g4 + 1] * inv * silu(bfhi(zw.x));
        const float y2 = O[d][4 * g4 + 2] * inv * silu(bflo(zw.y)), y3 = O[d][4 * g4 + 3] * inv * silu(bfhi(zw.y));
        u32x2 w; w.x = cvtpk(y0, y1); w.y = cvtpk(y2, y3);
        *(u32x2*)(orow + dv) = w;
      }
  } else {
    float* sc = (float*)(lds + 32768) + (wid >> 1) * (DV * 32);
    if (wid & 1) {
      const float f = inv * J.lam;
#pragma unroll
      for (int d = 0; d < NDV; ++d)
#pragma unroll
        for (int i = 0; i < 16; ++i) sc[(32 * d + crow(i, h)) * 32 + r] = O[d][i] * f;
    }
    __syncthreads();
    if (!(wid & 1)) {
      float ss = 0.f;
#pragma unroll
      for (int d = 0; d < NDV; ++d)
#pragma unroll
        for (int i = 0; i < 16; ++i) { const float a = O[d][i] * inv - sc[(32 * d + crow(i, h)) * 32 + r]; O[d][i] = a; ss += a * a; }
      ss = swapsum(ss);
      const float rn = rsqrtf(ss * (1.f / DV) + EPSF) * J.oscale;
      bf16_t* orow = J.o + (size_t)r * UW; const bf16_t* zrow = J.z + (size_t)r * UW;
#pragma unroll
      for (int d = 0; d < NDV; ++d)
#pragma unroll
        for (int g4 = 0; g4 < 4; ++g4) {
          const int dv = 32 * d + 8 * g4 + 4 * h;
          const u32x2 zw = *(const u32x2*)(zrow + dv);
          const f32x4 sg = *(const f32x4*)(J.subg + dv);
          const float y0 = O[d][4 * g4] * rn * sg[0] * silu(bflo(zw.x)), y1 = O[d][4 * g4 + 1] * rn * sg[1] * silu(bfhi(zw.x));
          const float y2 = O[d][4 * g4 + 2] * rn * sg[2] * silu(bflo(zw.y)), y3 = O[d][4 * g4 + 3] * rn * sg[3] * silu(bfhi(zw.y));
          u32x2 w; w.x = cvtpk(y0, y1); w.y = cvtpk(y2, y3);
          *(u32x2*)(orow + dv) = w;
        }
    }
  }
}

template <int DV, int NK, int MODE, bool FIXM, int GRP>
DI void attn_job(char* lds_wg, const AttnJob& J) {
  constexpr int NDV = DV / 32;
  constexpr float C = 0.125f * LOG2E;
  const int tid_wg = ltid(), tid = tid_wg & (AT - 1), lane = tid & 63, wid = __builtin_amdgcn_readfirstlane(tid >> 6), r = lane & 31, h = lane >> 5;
  constexpr bool SHR = FIXM || MODE == AM_SWA;
  constexpr int STN = SHR ? NTHREADS : AT;
  char* lds = lds_wg + (SHR ? 0 : GRP * 65536);
  const int st_ = SHR ? tid_wg : tid;
  const int kstream = (NK == 2) ? (wid & 1) : 0;
  bf16x8 qf[4];
  const bf16_t* qrow = J.q + (size_t)r * UW + 8 * h;
#pragma unroll
  for (int ds = 0; ds < 4; ++ds) qf[ds] = *(const bf16x8*)(qrow + 16 * ds);
  f32x16 O[NDV];
#pragma unroll
  for (int d = 0; d < NDV; ++d)
#pragma unroll
    for (int i = 0; i < 16; ++i) O[d][i] = 0.f;
  float m = J.m_init, l = (h == 0) ? J.l_init : 0.f;
  f32x16 Osum;
#pragma unroll
  for (int i = 0; i < 16; ++i) Osum[i] = 0.f;
  const bf16x8 ones = {0x3F80, 0x3F80, 0x3F80, 0x3F80, 0x3F80, 0x3F80, 0x3F80, 0x3F80};
  constexpr int KI = 512 / STN;
  const int ksrow = st_ >> 3, ksch = st_ & 7;
  const int kpi = (ksrow & ~12) | ((ksrow & 4) << 1) | ((ksrow & 8) >> 1);
  const int ksoff = kpi * 128 + ((ksch ^ ((kpi >> 1) & 7)) << 4);
  constexpr int VCH = DV / 8;
  constexpr int VI = (64 * VCH) / STN;
  const int vkey0 = st_ / VCH, vc8 = (st_ % VCH) * 8;
  u32x4 rk0[NK][KI], rv0[VI], rk1[NK][KI], rv1[VI];
#define A_LOAD(t, rk, rv) do { const size_t kb_ = (size_t)(t) * 64; \
    _Pragma("unroll") for (int s = 0; s < NK; ++s) _Pragma("unroll") for (int i = 0; i < KI; ++i) rk[s][i] = *(const u32x4*)(J.k[s] + (kb_ + ksrow + 32 * i) * J.ldk + ksch * 8); \
    _Pragma("unroll") for (int i = 0; i < VI; ++i) rv[i] = *(const u32x4*)(J.v + (kb_ + vkey0 + (STN / VCH) * i) * J.ldv + vc8); } while (0)
#define A_WRITE(st, rk, rv) do { char* b_ = lds + (st) * 32768; \
    _Pragma("unroll") for (int s = 0; s < NK; ++s) _Pragma("unroll") for (int i = 0; i < KI; ++i) *(u32x4*)(b_ + s * 8192 + i * 4096 + ksoff) = rk[s][i]; \
    _Pragma("unroll") for (int i = 0; i < VI; ++i) { const int key_ = vkey0 + (STN / VCH) * i; \
      *(u32x4*)(b_ + NK * 8192 + ((key_ >> 3) * NDV + (vc8 >> 5)) * 512 + (key_ & 7) * 64 + (vc8 & 31) * 2) = rv[i]; } } while (0)
  const int nt = J.tile_hi - J.tile_lo;
  constexpr bool DEEP2 = FIXM || MODE != AM_DIFF;
  constexpr bool ONESET = FIXM;
  A_LOAD(J.tile_lo, rk0, rv0); A_WRITE(0, rk0, rv0); if (ONESET) A_LOAD(J.tile_lo + 1, rk0, rv0); else if (DEEP2) A_LOAD(J.tile_lo + 1, rk1, rv1); __syncthreads();
  const int i16 = lane & 15;
  const int vrd = h * NDV * 512 + (i16 >> 2) * 64 + (((lane >> 4) & 1) * 16 + (i16 & 3) * 4) * 2;
  auto compute = [&](const int stage, const int tile) __attribute__((always_inline)) {
    bool active = true;
    if (MODE == AM_SWA) { const int k0 = tile * 64; active = !(k0 > J.qpos0 + 31 + 128 || k0 + 63 < J.qpos0 - 128); }
    if (active) {
      const char* Kl = lds + stage * 32768 + kstream * 8192 + r * 128;
      f32x16 sA, sB;
#pragma unroll
      for (int i = 0; i < 16; ++i) { sA[i] = 0.f; sB[i] = 0.f; }
      if (NDV == 2 || FIXM) {
        bf16x8 ka[4], kb[4];
#pragma unroll
        for (int ds = 0; ds < 4; ++ds) { const int co = ((2 * ds + h) ^ ((r >> 1) & 7)) << 4; ka[ds] = *(const bf16x8*)(Kl + co); kb[ds] = *(const bf16x8*)(Kl + 4096 + co); }
#pragma unroll
        for (int ds = 0; ds < 4; ++ds) { sA = MFMA32(ka[ds], qf[ds], sA); sB = MFMA32(kb[ds], qf[ds], sB); }
        __builtin_amdgcn_sched_group_barrier(0x100, 4, 0); __builtin_amdgcn_sched_group_barrier(0x008, 2, 0);
        __builtin_amdgcn_sched_group_barrier(0x100, 2, 0); __builtin_amdgcn_sched_group_barrier(0x008, 2, 0);
        __builtin_amdgcn_sched_group_barrier(0x100, 2, 0); __builtin_amdgcn_sched_group_barrier(0x008, 4, 0);
      } else {
#pragma unroll
        for (int ds = 0; ds < 4; ++ds) {
          const int co = ((2 * ds + h) ^ ((r >> 1) & 7)) << 4;
          const bf16x8 ka = *(const bf16x8*)(Kl + co), kb = *(const bf16x8*)(Kl + 4096 + co);
          sA = MFMA32(ka, qf[ds], sA); sB = MFMA32(kb, qf[ds], sB);
        }
      }
      if (MODE == AM_SWA) {
        const int qa = J.qpos0 + r, kbase = tile * 64 + 8 * h;
#pragma unroll
        for (int i = 0; i < 16; ++i) {
          const int ka_ = kbase + 16 * (i >> 3) + (i & 7);
          int d0 = qa - ka_; d0 = d0 < 0 ? -d0 : d0; if (d0 > 128) sA[i] = -INFINITY;
          int d1 = qa - (ka_ + 32); d1 = d1 < 0 ? -d1 : d1; if (d1 > 128) sB[i] = -INFINITY;
        }
      }
      if (FIXM) {
        const float nm = -J.m_init;
#pragma unroll
        for (int i = 0; i < 16; ++i) { sA[i] = __builtin_amdgcn_exp2f(fmaf(sA[i], C, nm)); sB[i] = __builtin_amdgcn_exp2f(fmaf(sB[i], C, nm)); l += sA[i] + sB[i]; }
      } else {
      float mx = sA[0];
#pragma unroll
      for (int i = 1; i < 16; ++i) mx = fmaxf(mx, sA[i]);
#pragma unroll
      for (int i = 0; i < 16; ++i) mx = fmaxf(mx, sB[i]);
      mx = swapmax(mx);
      const float mn = fmaxf(m, mx * C);
      const float alpha = __builtin_amdgcn_exp2f(m - mn);
      m = mn;
      float ps = 0.f;
#pragma unroll
      for (int i = 0; i < 16; ++i) { sA[i] = __builtin_amdgcn_exp2f(fmaf(sA[i], C, -mn)); sB[i] = __builtin_amdgcn_exp2f(fmaf(sB[i], C, -mn)); ps += sA[i] + sB[i]; }
      l = l * alpha + ps;
#pragma unroll
      for (int d = 0; d < NDV; ++d)
#pragma unroll
        for (int i = 0; i < 16; ++i) O[d][i] *= alpha;
      }
      bf16x8 pf[4];
      { u32x4 w;
        w.x = cvtpk(sA[0], sA[1]); w.y = cvtpk(sA[2], sA[3]); w.z = cvtpk(sA[4], sA[5]); w.w = cvtpk(sA[6], sA[7]); pf[0] = __builtin_bit_cast(bf16x8, w);
        w.x = cvtpk(sA[8], sA[9]); w.y = cvtpk(sA[10], sA[11]); w.z = cvtpk(sA[12], sA[13]); w.w = cvtpk(sA[14], sA[15]); pf[1] = __builtin_bit_cast(bf16x8, w);
        w.x = cvtpk(sB[0], sB[1]); w.y = cvtpk(sB[2], sB[3]); w.z = cvtpk(sB[4], sB[5]); w.w = cvtpk(sB[6], sB[7]); pf[2] = __builtin_bit_cast(bf16x8, w);
        w.x = cvtpk(sB[8], sB[9]); w.y = cvtpk(sB[10], sB[11]); w.z = cvtpk(sB[12], sB[13]); w.w = cvtpk(sB[14], sB[15]); pf[3] = __builtin_bit_cast(bf16x8, w); }
      const char* Vl = lds + stage * 32768 + NK * 8192 + vrd;
      if (FIXM) {
        bf16x8 vf[4][NDV];
#pragma unroll
        for (int ks = 0; ks < 4; ++ks) {
#pragma unroll
          for (int d = 0; d < NDV; ++d) {
            const s16x4 lo = __builtin_amdgcn_ds_read_tr16_b64_v4i16((LAS s16x4*)(Vl + ks * 2 * NDV * 512 + d * 512));
            const s16x4 hi = __builtin_amdgcn_ds_read_tr16_b64_v4i16((LAS s16x4*)(Vl + ks * 2 * NDV * 512 + d * 512 + 256));
            vf[ks][d] = __builtin_shufflevector(lo, hi, 0, 1, 2, 3, 4, 5, 6, 7);
          }
        }
#pragma unroll
        for (int ks = 0; ks < 4; ++ks) {
#pragma unroll
          for (int d = 0; d < NDV; ++d) O[d] = MFMA32(vf[ks][d], pf[ks], O[d]);
        }
        __builtin_amdgcn_sched_group_barrier(0x100, 4 * NDV, 0); __builtin_amdgcn_sched_group_barrier(0x008, NDV, 0);
        __builtin_amdgcn_sched_group_barrier(0x100, 2 * NDV, 0); __builtin_amdgcn_sched_group_barrier(0x008, NDV, 0);
        __builtin_amdgcn_sched_group_barrier(0x100, 2 * NDV, 0); __builtin_amdgcn_sched_group_barrier(0x008, 2 * NDV, 0);
      } else {
      if (FIXM) {
#pragma unroll
        for (int ks = 0; ks < 4; ++ks) Osum = MFMA32(ones, pf[ks], Osum);
      }
#pragma unroll
      for (int ks = 0; ks < 4; ++ks)
#pragma unroll
        for (int d = 0; d < NDV; ++d) {
          const s16x4 lo = __builtin_amdgcn_ds_read_tr16_b64_v4i16((LAS s16x4*)(Vl + ks * 2 * NDV * 512 + d * 512));
          const s16x4 hi = __builtin_amdgcn_ds_read_tr16_b64_v4i16((LAS s16x4*)(Vl + ks * 2 * NDV * 512 + d * 512 + 256));
          const bf16x8 vf = __builtin_shufflevector(lo, hi, 0, 1, 2, 3, 4, 5, 6, 7);
          O[d] = MFMA32(vf, pf[ks], O[d]);
        }
      }
    }
  };
  for (int it = 0; it < nt; it += 2) {
    if (ONESET) {
      A_WRITE(1, rk0, rv0);
      if (it + 2 < nt) A_LOAD(J.tile_lo + it + 2, rk0, rv0);
      compute(0, J.tile_lo + it);
      __syncthreads();
      if (it + 2 < nt) A_WRITE(0, rk0, rv0);
      if (it + 3 < nt) A_LOAD(J.tile_lo + it + 3, rk0, rv0);
      compute(1, J.tile_lo + it + 1);
      __syncthreads();
    } else if (DEEP2) {
      if (it + 2 < nt) A_LOAD(J.tile_lo + it + 2, rk0, rv0);
      compute(0, J.tile_lo + it);
      A_WRITE(1, rk1, rv1);
      __syncthreads();
      if (it + 3 < nt) A_LOAD(J.tile_lo + it + 3, rk1, rv1);
      compute(1, J.tile_lo + it + 1);
      if (it + 2 < nt) A_WRITE(0, rk0, rv0);
      __syncthreads();
    } else {
      compute(0, J.tile_lo + it);
      __builtin_amdgcn_sched_barrier(0);
      A_LOAD(J.tile_lo + it + 1, rk0, rv0); A_WRITE(1, rk0, rv0);
      __syncthreads();
      compute(1, J.tile_lo + it + 1);
      __builtin_amdgcn_sched_barrier(0);
      if (it + 2 < nt) { A_LOAD(J.tile_lo + it + 2, rk0, rv0); A_WRITE(0, rk0, rv0); }
      __syncthreads();
    }
  }
#undef A_LOAD
#undef A_WRITE
  if (J.dry) return;
  const float lt = swapsum(l);
  attn_finalize<DV, MODE>(SHR ? lds_wg + 32768 + GRP * 32768 : lds, J, O, lt, wid, r, h);
  if (SHR && MODE == AM_DIFF) __syncthreads();
}

template <int DV, int NK, int MODE, int GRP>
DI void attn_pipe(char* lds_wg, const AttnJob& J) {
  constexpr int NDV = DV / 32;
  constexpr float C = 0.125f * LOG2E;
  constexpr int KST = NK * 8192, VST = DV * 128, VB = 2 * KST;
  const int tid_wg = ltid(), tid = tid_wg & (AT - 1), lane = tid & 63, wid = tid >> 6, r = lane & 31, h = lane >> 5;
  char* lds = lds_wg + GRP * 65536;
  const int kstream = (NK == 2) ? (wid & 1) : 0;
  bf16x8 qf[4];
  const bf16_t* qrow = J.q + (size_t)r * UW + 8 * h;
#pragma unroll
  for (int ds = 0; ds < 4; ++ds) qf[ds] = *(const bf16x8*)(qrow + 16 * ds);
  f32x16 O[NDV], Osum;
#pragma unroll
  for (int d = 0; d < NDV; ++d)
#pragma unroll
    for (int i = 0; i < 16; ++i) O[d][i] = 0.f;
#pragma unroll
  for (int i = 0; i < 16; ++i) Osum[i] = 0.f;
  const bf16x8 ones = {0x3F80, 0x3F80, 0x3F80, 0x3F80, 0x3F80, 0x3F80, 0x3F80, 0x3F80};
  const float nm = -J.m_init;
  const int ksrow = tid >> 3, ksch = tid & 7;
  const int kpi = (ksrow & ~12) | ((ksrow & 4) << 1) | ((ksrow & 8) >> 1);
  const int ksoff = kpi * 128 + ((ksch ^ ((kpi >> 1) & 7)) << 4);
  constexpr int VCH = DV / 8, VI = (64 * VCH) / AT;
  const int vkey0 = tid / VCH, vc8 = (tid % VCH) * 8;
  u32x4 rk0[NK][2], rv0[VI], rk1[NK][2], rv1[VI];
#define K_LOAD(t, rk) do { const size_t kb_ = (size_t)(t) * 64; \
    _Pragma("unroll") for (int s = 0; s < NK; ++s) _Pragma("unroll") for (int i = 0; i < 2; ++i) rk[s][i] = *(const u32x4*)(J.k[s] + (kb_ + ksrow + 32 * i) * J.ldk + ksch * 8); } while (0)
#define V_LOAD(t, rv) do { const size_t kb_ = (size_t)(t) * 64; \
    _Pragma("unroll") for (int i = 0; i < VI; ++i) rv[i] = *(const u32x4*)(J.v + (kb_ + vkey0 + (AT / VCH) * i) * J.ldv + vc8); } while (0)
#define K_WRITE(st, rk) do { char* b_ = lds + (st) * KST; \
    _Pragma("unroll") for (int s = 0; s < NK; ++s) _Pragma("unroll") for (int i = 0; i < 2; ++i) *(u32x4*)(b_ + s * 8192 + i * 4096 + ksoff) = rk[s][i]; } while (0)
#define V_WRITE(st, rv) do { char* b_ = lds + VB + (st) * VST; \
    _Pragma("unroll") for (int i = 0; i < VI; ++i) { const int key_ = vkey0 + (AT / VCH) * i; \
      *(u32x4*)(b_ + ((key_ >> 3) * NDV + (vc8 >> 5)) * 512 + (key_ & 7) * 64 + (vc8 & 31) * 2) = rv[i]; } } while (0)
  const int nt = J.tile_hi - J.tile_lo, t0 = J.tile_lo;
  const int i16 = lane & 15;
  const int vrd = h * NDV * 512 + (i16 >> 2) * 64 + (((lane >> 4) & 1) * 16 + (i16 & 3) * 4) * 2;
  auto qk = [&](const int kst, f32x16& sA, f32x16& sB) __attribute__((always_inline)) {
    const char* Kl = lds + kst * KST + kstream * 8192 + r * 128;
#pragma unroll
    for (int i = 0; i < 16; ++i) { sA[i] = 0.f; sB[i] = 0.f; }
    bf16x8 ka[4], kb[4];
#pragma unroll
    for (int ds = 0; ds < 4; ++ds) { const int co = ((2 * ds + h) ^ ((r >> 1) & 7)) << 4; ka[ds] = *(const bf16x8*)(Kl + co); kb[ds] = *(const bf16x8*)(Kl + 4096 + co); }
    __builtin_amdgcn_sched_barrier(0);
#pragma unroll
    for (int ds = 0; ds < 4; ++ds) { sA = MFMA32(ka[ds], qf[ds], sA); sB = MFMA32(kb[ds], qf[ds], sB); }
  };
  auto smpv = [&](const int vst, f32x16& sA, f32x16& sB) __attribute__((always_inline)) {
    const char* Vl = lds + VB + vst * VST + vrd;
    bf16x8 vf[4][NDV];
#pragma unroll
    for (int ks = 0; ks < 4; ++ks)
#pragma unroll
      for (int d = 0; d < NDV; ++d) {
        const s16x4 lo = __builtin_amdgcn_ds_read_tr16_b64_v4i16((LAS s16x4*)(Vl + ks * 2 * NDV * 512 + d * 512));
        const s16x4 hi = __builtin_amdgcn_ds_read_tr16_b64_v4i16((LAS s16x4*)(Vl + ks * 2 * NDV * 512 + d * 512 + 256));
        vf[ks][d] = __builtin_shufflevector(lo, hi, 0, 1, 2, 3, 4, 5, 6, 7);
      }
    __builtin_amdgcn_sched_barrier(0);
#pragma unroll
    for (int i = 0; i < 16; ++i) { sA[i] = __builtin_amdgcn_exp2f(fmaf(sA[i], C, nm)); sB[i] = __builtin_amdgcn_exp2f(fmaf(sB[i], C, nm)); }
    bf16x8 pf[4];
    { u32x4 w;
      w.x = cvtpk(sA[0], sA[1]); w.y = cvtpk(sA[2], sA[3]); w.z = cvtpk(sA[4], sA[5]); w.w = cvtpk(sA[6], sA[7]); pf[0] = __builtin_bit_cast(bf16x8, w);
      w.x = cvtpk(sA[8], sA[9]); w.y = cvtpk(sA[10], sA[11]); w.z = cvtpk(sA[12], sA[13]); w.w = cvtpk(sA[14], sA[15]); pf[1] = __builtin_bit_cast(bf16x8, w);
      w.x = cvtpk(sB[0], sB[1]); w.y = cvtpk(sB[2], sB[3]); w.z = cvtpk(sB[4], sB[5]); w.w = cvtpk(sB[6], sB[7]); pf[2] = __builtin_bit_cast(bf16x8, w);
      w.x = cvtpk(sB[8], sB[9]); w.y = cvtpk(sB[10], sB[11]); w.z = cvtpk(sB[12], sB[13]); w.w = cvtpk(sB[14], sB[15]); pf[3] = __builtin_bit_cast(bf16x8, w); }
#pragma unroll
    for (int ks = 0; ks < 4; ++ks) Osum = MFMA32(ones, pf[ks], Osum);
#pragma unroll
    for (int ks = 0; ks < 4; ++ks)
#pragma unroll
      for (int d = 0; d < NDV; ++d) O[d] = MFMA32(vf[ks][d], pf[ks], O[d]);
  };
  K_LOAD(t0, rk0); V_LOAD(t0, rv0); K_LOAD(t0 + 1, rk1);
  K_WRITE(0, rk0); V_WRITE(0, rv0); K_WRITE(1, rk1);
  if (2 < nt) K_LOAD(t0 + 2, rk0);
  V_LOAD(t0 + 1, rv0);
  __syncthreads();
  f32x16 eA, eB, oA, oB;
  qk(0, eA, eB);
  __syncthreads();
  for (int j = 0; j < nt; j += 2) {
    if (j + 3 < nt) K_LOAD(t0 + j + 3, rk1);
    if (j + 2 < nt) V_LOAD(t0 + j + 2, rv1);
    qk(1, oA, oB);
    __builtin_amdgcn_sched_barrier(0);
    smpv(0, eA, eB);
    if (j + 2 < nt) K_WRITE(0, rk0);
    V_WRITE(1, rv0);
    __syncthreads();
    if (j + 4 < nt) K_LOAD(t0 + j + 4, rk0);
    if (j + 3 < nt) V_LOAD(t0 + j + 3, rv0);
    if (j + 2 < nt) qk(0, eA, eB);
    __builtin_amdgcn_sched_barrier(0);
    smpv(1, oA, oB);
    if (j + 3 < nt) K_WRITE(1, rk1);
    if (j + 2 < nt) V_WRITE(0, rv1);
    __syncthreads();
  }
#undef K_LOAD
#undef V_LOAD
#undef K_WRITE
#undef V_WRITE
  if (J.dry) return;
  attn_finalize<DV, MODE>(lds, J, O, Osum[0], wid, r, h);
}

#define PIPE_CALL(DV, NK, MODE) do { if (grp) attn_pipe<DV, NK, MODE, 1>(lds, J); else attn_pipe<DV, NK, MODE, 0>(lds, J); } while (0)
#define ATTN_CALL(DV, NK, MODE, FIXM) do { if (grp) attn_job<DV, NK, MODE, FIXM, 1>(lds, J); else attn_job<DV, NK, MODE, FIXM, 0>(lds, J); } while (0)
DI void mem_jobs(char* lds, const Params& p, int layer, int dry) {
  const int grp = __builtin_amdgcn_readfirstlane(ltid() >> 8);
  const int wid = __builtin_amdgcn_readfirstlane((ltid() >> 6) & 3), vb = blockIdx.x * 2 + grp, vg = gridDim.x * 2;
  for (int job = vb; job < 768 * 4; job += vg) {
    const int qb = job >> 2, hm = job & 3, t0 = qb * 128;
    int S, seq0, pos, sq; tok_info(t0, S, seq0, pos, sq);
    AttnJob J;
    bf16_t* qo = p.u + (size_t)(t0 + 32 * wid) * UW + 2304 + hm * 64;
    J.q = qo; J.o = qo; J.z = p.u + (size_t)(t0 + 32 * wid) * UW + 2560 + 1024 + hm * 64;
    J.k[0] = J.k[1] = p.memkv + (size_t)(sq * 256) * 2048 + layer * 512 + hm * 64; J.v = J.k[0] + 256; J.ldk = J.ldv = 2048;
    J.tile_lo = 0; J.tile_hi = 4; J.m_init = -1e30f; J.l_init = 0.f; J.qpos0 = 0; J.lam = 0.f; J.oscale = 0.f; J.subg = nullptr; J.dry = dry;
    ATTN_CALL(64, 1, AM_PLAIN, false);
  }
}

DI void phase_mix_even(char* lds, const Params& p, int layer, int dry) {
  const int grp = __builtin_amdgcn_readfirstlane(ltid() >> 8);
  const int e = layer >> 1, wid = __builtin_amdgcn_readfirstlane((ltid() >> 6) & 3), vb = blockIdx.x * 2 + grp, vg = gridDim.x * 2;
  for (int job = vb; job < 768 * 8; job += vg) {
    const int qb = job >> 3, hq = job & 7, kvh = hq >> 2, t0 = qb * 128;
    int S, seq0, pos, sq; tok_info(t0, S, seq0, pos, sq);
    AttnJob J;
    bf16_t* qo = p.u + (size_t)(t0 + 32 * wid) * UW + 1536 + hq * 64;
    J.q = qo; J.o = qo; J.z = p.u + (size_t)(t0 + 32 * wid) * UW + 2560 + 512 + hq * 64;
    J.k[0] = J.k[1] = p.u + (size_t)seq0 * UW + 2048 + kvh * 64; J.v = p.u + (size_t)seq0 * UW + 2176 + kvh * 64; J.ldk = J.ldv = UW;
    const int pt = pos >> 6;
    J.tile_lo = pt - 2 < 0 ? 0 : pt - 2; J.tile_hi = pt + 4 > (S >> 6) ? (S >> 6) : pt + 4;
    J.m_init = p.swa_sink[e * 8 + hq] * LOG2E; J.l_init = 1.f; J.qpos0 = pos + 32 * wid; J.lam = 0.f; J.oscale = 0.f; J.subg = nullptr; J.dry = dry;
    ATTN_CALL(64, 1, AM_SWA, false);
  }
  mem_jobs(lds, p, layer, dry);
  const float* cw = p.conv_w + e * 3 * 512;
  for (int idx = blockIdx.x * NTHREADS + ltid(); idx < NTOK * 64; idx += gridDim.x * NTHREADS) {
    const int t = idx >> 6, c0 = (idx & 63) * 8;
    int S, seq0, pos, sq; tok_info(t, S, seq0, pos, sq);
    bf16_t* ur = p.u + (size_t)t * UW;
    float ic[8], il[8], ir[8];
    { const u32x4 a = *(const u32x4*)(ur + 512 + c0), b = *(const u32x4*)(ur + 1024 + c0);
#pragma unroll
      for (int j = 0; j < 4; ++j) { ic[2 * j] = bflo(a[j]) * bflo(b[j]); ic[2 * j + 1] = bfhi(a[j]) * bfhi(b[j]); } }
    if (pos > 0) { const u32x4 a = *(const u32x4*)(ur - UW + 512 + c0), b = *(const u32x4*)(ur - UW + 1024 + c0);
#pragma unroll
      for (int j = 0; j < 4; ++j) { il[2 * j] = bflo(a[j]) * bflo(b[j]); il[2 * j + 1] = bfhi(a[j]) * bfhi(b[j]); } }
    else {
#pragma unroll
      for (int j = 0; j < 8; ++j) il[j] = 0.f; }
    if (pos < S - 1) { const u32x4 a = *(const u32x4*)(ur + UW + 512 + c0), b = *(const u32x4*)(ur + UW + 1024 + c0);
#pragma unroll
      for (int j = 0; j < 4; ++j) { ir[2 * j] = bflo(a[j]) * bflo(b[j]); ir[2 * j + 1] = bfhi(a[j]) * bfhi(b[j]); } }
    else {
#pragma unroll
      for (int j = 0; j < 8; ++j) ir[j] = 0.f; }
    const u32x4 gbw = *(const u32x4*)(ur + c0), zw = *(const u32x4*)(ur + 2560 + c0);
    float y[8];
#pragma unroll
    for (int j = 0; j < 8; ++j) {
      const float gb = (j & 1) ? bfhi(gbw[j >> 1]) : bflo(gbw[j >> 1]);
      const float z = (j & 1) ? bfhi(zw[j >> 1]) : bflo(zw[j >> 1]);
      const float cv = il[j] * cw[c0 + j] + ic[j] * cw[512 + c0 + j] + ir[j] * cw[1024 + c0 + j];
      y[j] = gb * cv * silu(z);
    }
    u32x4 w; w.x = cvtpk(y[0], y[1]); w.y = cvtpk(y[2], y[3]); w.z = cvtpk(y[4], y[5]); w.w = cvtpk(y[6], y[7]);
    if (!dry) *(u32x4*)(ur + c0) = w;
  }
}

DI void phase_mix_odd(char* lds, const Params& p, int layer, int dry) {
  const int grp = __builtin_amdgcn_readfirstlane(ltid() >> 8);
  const int o = layer >> 1, wid = __builtin_amdgcn_readfirstlane((ltid() >> 6) & 3);
  const int nx = (gridDim.x & 7) == 0 ? 8 : 1, bx = blockIdx.x % nx, bi = (blockIdx.x / nx) * 2 + grp, nbx = (gridDim.x / nx) * 2;
  const float mb_dense = p.lam[8 + o * 2], mb_diff = p.lam[8 + o * 2 + 1];
  const bool fix_dense = mb_dense < 43.f, fix_diff = mb_diff < 43.f;
#pragma unroll 1
  for (int part = 0; part < 2; ++part) {
    const int gshift = part ? 7 : 8, nv = (16 / nx) << gshift;
#pragma unroll 1
    for (int v = bi; v < nv; v += nbx) {
      const int j = ((bx + nx * (v >> gshift)) << gshift) + (v & ((1 << gshift) - 1));
      int g, qb, kvh, seq0, S;
      if (!part) { g = j & 3; qb = (j >> 2) & 63; kvh = (j >> 8) & 1; seq0 = (j >> 9) * 8192; S = 8192; }
      else { g = j & 3; qb = (j >> 2) & 31; kvh = (j >> 7) & 1; seq0 = NTOKP + (j >> 8) * 4096; S = 4096; }
      const int hq = kvh * 4 + g, t0 = seq0 + qb * 128 + 32 * wid;
      AttnJob J;
      bf16_t* qo = p.u + (size_t)t0 * UW + hq * 64;
      J.q = qo; J.o = qo; J.z = p.u + (size_t)t0 * UW + 2560 + hq * 64;
      J.k[0] = J.k[1] = p.u + (size_t)seq0 * UW + 512 + kvh * 64; J.v = p.u + (size_t)seq0 * UW + 640 + kvh * 64; J.ldk = J.ldv = UW;
      J.tile_lo = 0; J.tile_hi = S >> 6; J.l_init = 0.f; J.qpos0 = 0; J.lam = 0.f; J.oscale = 0.f; J.subg = nullptr; J.dry = dry;
      if (fix_dense) { J.m_init = mb_dense; ATTN_CALL(64, 1, AM_PLAIN, true); }
      else { J.m_init = -1e30f; ATTN_CALL(64, 1, AM_PLAIN, false); }
    }
  }
  const float lam = p.lam[o * 2], osc = p.lam[o * 2 + 1];
#pragma unroll 1
  for (int part = 0; part < 2; ++part) {
    const int gshift = part ? 6 : 7, nv = (32 / nx) << gshift;
#pragma unroll 1
    for (int v = bi; v < nv; v += nbx) {
      const int j = ((bx + nx * (v >> gshift)) << gshift) + (v & ((1 << gshift) - 1));
      int qb, hh, seq0, S;
      if (!part) { qb = j & 127; hh = (j >> 7) & 3; seq0 = (j >> 9) * 8192; S = 8192; }
      else { qb = j & 63; hh = (j >> 6) & 3; seq0 = NTOKP + (j >> 8) * 4096; S = 4096; }
      const int mp = wid & 1, sub = wid >> 1, t0 = seq0 + qb * 64 + sub * 32;
      AttnJob J;
      J.q = p.u + (size_t)t0 * UW + 768 + (2 * hh + mp) * 64;
      J.o = p.u + (size_t)t0 * UW + 768 + hh * 128; J.z = p.u + (size_t)t0 * UW + 2560 + 512 + hh * 128;
      J.k[0] = p.u + (size_t)seq0 * UW + 1280 + (2 * hh) * 64; J.k[1] = J.k[0] + 64; J.v = p.u + (size_t)seq0 * UW + 1792 + hh * 128; J.ldk = J.ldv = UW;
      J.tile_lo = 0; J.tile_hi = S >> 6; J.l_init = 0.f; J.qpos0 = 0; J.lam = lam; J.oscale = osc; J.subg = p.diff_subln_g + o * 128; J.dry = dry;
      if (fix_diff) { J.m_init = mb_diff; ATTN_CALL(128, 2, AM_DIFF, true); }
      else { J.m_init = -1e30f; ATTN_CALL(128, 2, AM_DIFF, false); }
    }
  }
  mem_jobs(lds, p, layer, dry);
}

DI void phase_norm(const Params& p) {
  const int gw = blockIdx.x * 8 + __builtin_amdgcn_readfirstlane(ltid() >> 6), nw = gridDim.x * 8;
  norm_rows(p.out, p.xb, p.rstd, 0, NTOK, gw, nw);
}

#define XB_TMO      128
#define XB_XCNT(j)  (256  + 64 * (j))
#define XB_XSUB(j)  (1280 + 64 * (j))
#define XB_XGEN(j)  (2304 + 64 * (j))
#define XB_TOP      3328
#define XB_TOPGEN   3392
#define XB_STATE    4096
#define XB_WORDS    8192
#define XB_SPIN_CAP (1u << 18)
DI unsigned xb_ld(unsigned* p) { return __hip_atomic_load(p, __ATOMIC_RELAXED, __HIP_MEMORY_SCOPE_AGENT); }
DI unsigned xb_add(unsigned* p, unsigned v) { return __hip_atomic_fetch_add(p, v, __ATOMIC_RELAXED, __HIP_MEMORY_SCOPE_AGENT); }
DI unsigned xb_xcc_id() { return (unsigned)__builtin_amdgcn_s_getreg((3 << 11) | 20) & 0xFu; }
#define XB_SPIN(cond, bar) do { unsigned _sp = 0; while (cond) { __builtin_amdgcn_s_sleep(1); \
    if ((++_sp & 255u) == 0u) { if (xb_ld(&(bar)[XB_TMO])) break; if (_sp > XB_SPIN_CAP) { atomicAdd(&(bar)[XB_TMO], 1u); break; } } } } while (0)
DI void xb_census(unsigned* bar, unsigned x, unsigned& nloc, unsigned& nx) {
  const unsigned G = gridDim.x;
  unsigned sum, cnt, mine, sp = 0u;
  for (;;) {
    sum = 0u; cnt = 0u; mine = 0u;
#pragma unroll
    for (unsigned j = 0; j < 16; ++j) { const unsigned c = xb_ld(&bar[XB_XCNT(j)]); sum += c; cnt += (c > 0u) ? 1u : 0u; mine = (j == x) ? c : mine; }
    if (sum == G) break;
    __builtin_amdgcn_s_sleep(1);
    if ((++sp & 255u) == 0u) { if (xb_ld(&bar[XB_TMO])) break; if (sp > XB_SPIN_CAP) { atomicAdd(&bar[XB_TMO], 1u); break; } }
  }
  nloc = mine > 0u ? mine : 1u; nx = cnt > 0u ? cnt : 1u;
}
DI void xcd_barrier(unsigned* bar) {
  asm volatile("s_waitcnt vmcnt(0)" ::: "memory");
  __syncthreads();
  if (threadIdx.x == 0) {
    __builtin_amdgcn_s_waitcnt(0);
    const unsigned x = xb_xcc_id();
    unsigned* st = bar + XB_STATE + 2 * blockIdx.x;
    unsigned nloc = xb_ld(st), nx = xb_ld(st + 1);
    if (nloc == 0u) { xb_census(bar, x, nloc, nx); __hip_atomic_store(st, nloc, __ATOMIC_RELAXED, __HIP_MEMORY_SCOPE_AGENT); __hip_atomic_store(st + 1, nx, __ATOMIC_RELAXED, __HIP_MEMORY_SCOPE_AGENT); }
    const unsigned old = xb_add(&bar[XB_XSUB(x)], 1u);
    const unsigned gen = old / nloc;
    if (old + 1u == (gen + 1u) * nloc) {
      __builtin_amdgcn_fence(__ATOMIC_RELEASE, "agent");
      asm volatile("s_waitcnt vmcnt(0)" ::: "memory");
      const unsigned og = xb_add(&bar[XB_TOP], 1u);
      const unsigned tg = og / nx;
      if (og + 1u == (tg + 1u) * nx) xb_add(&bar[XB_TOPGEN], 1u);
      else XB_SPIN(xb_ld(&bar[XB_TOPGEN]) == tg, bar);
      __builtin_amdgcn_fence(__ATOMIC_ACQUIRE, "agent");
      xb_add(&bar[XB_XGEN(x)], 1u);
      asm volatile("s_waitcnt vmcnt(0)" ::: "memory");
    } else {
      XB_SPIN(xb_ld(&bar[XB_XGEN(x)]) == gen, bar);
      __builtin_amdgcn_fence(__ATOMIC_ACQUIRE, "agent");
      asm volatile("s_waitcnt vmcnt(0)" ::: "memory");
    }
  }
  __syncthreads();
}

__global__ void __launch_bounds__(NTHREADS, 2) fwd_kernel(Params p) {
  __shared__ __attribute__((aligned(16))) char lds[LDS_BYTES];
  if (threadIdx.x == 0) (void)xb_add(&p.bar[XB_XCNT(xb_xcc_id())], 1u);
  int ph = p.phase_lo;
  if (ph == 0) {
    phase_prep(lds, p);
    ph = 1;
#if !MULTI_LAUNCH
    if (ph < p.phase_hi) cg::this_grid().sync();
#endif
  }
  for (; ph < p.phase_hi; ++ph) {
    {
      const int l = (ph - 1) / 3, s = (ph - 1) - 3 * l;
      if (s == 0) {
        if (l == 0) { GemmDesc g{p.memb, p.wt_mem, DM, DM, 16, 8, 0, 0}; gemm_phase<EPI_MEM>(lds, p, g, 0); }
        GemmDesc g{p.xb, p.wt_in + (size_t)l * UW * DM, DM, DM, NTOK / 256, UW / 256, 0, 0};
        const int nrep = ((p.probe >> 2) & 1) + 1;
#pragma unroll 1
        for (int rep = 0; rep < nrep; ++rep) gemm_phase<EPI_IN>(lds, p, g, l);
      } else if (s == 1) {
        const int nrep = ((l & 1) ? (p.probe & 1) : ((p.probe >> 1) & 1)) + 1;
#pragma unroll 1
        for (int rep = 0; rep < nrep; ++rep) {
          const int dry = rep + 1 < nrep;
          if (rep == 0) {
            float* z = p.rstd + ((l + 1) & 1) * NTOK;
            for (int i = blockIdx.x * NTHREADS + ltid(); i < NTOK; i += gridDim.x * NTHREADS) z[i] = 0.f;
          }
          if (__builtin_amdgcn_readfirstlane(ltid()) >= 256) __builtin_amdgcn_s_setprio(1);
          if (l & 1) phase_mix_odd(lds, p, l, dry); else phase_mix_even(lds, p, l, dry);
          __builtin_amdgcn_s_setprio(0);
        }
      } else if (s == 2) {
        GemmDesc g{p.u, p.wt_out + (size_t)l * DM * MIXW, UW, MIXW, NTOK / 256, DM / 256, 1, (l & 1) ? 768 : 1536};
        gemm_phase<EPI_OUT>(lds, p, g, l);
      }
    }
#if !MULTI_LAUNCH
    if (ph + 1 < p.phase_hi) xcd_barrier(p.bar);
#endif
  }
}

extern "C" void kernel_launch(void* const* d_in, const int* in_sizes, int n_in, void* d_out, int out_size, void* d_ws, size_t ws_size,
                              hipStream_t stream) {
  static int grid_blocks = 0;
  if (!grid_blocks) {
    int dev = 0, cus = 0, per_cu = 0;
    hipGetDevice(&dev);
    hipDeviceGetAttribute(&cus, hipDeviceAttributeMultiprocessorCount, dev);
    hipOccupancyMaxActiveBlocksPerMultiprocessor(&per_cu, fwd_kernel, NTHREADS, 0);
    if (per_cu > 1) per_cu = 1;
    if (per_cu < 1) per_cu = 1;
    int cap = cus * per_cu; if (cap > 256) cap = 256;
    grid_blocks = 8; while (grid_blocks * 2 <= cap) grid_blocks *= 2;
  }
  Params p{};
  p.xp = (const float*)d_in[0]; p.xs = (const float*)d_in[1]; p.memp = (const float*)d_in[2]; p.mems = (const float*)d_in[3];
  p.norm_g = (const float*)d_in[4]; p.w_in = (const float*)d_in[5]; p.w_out = (const float*)d_in[6]; p.mem_norm_g = (const float*)d_in[7];
  p.w_mem_kv = (const float*)d_in[8]; p.mem_qk_g = (const float*)d_in[9]; p.conv_w = (const float*)d_in[10]; p.swa_qk_g = (const float*)d_in[11];
  p.swa_sink = (const float*)d_in[12]; p.ax_qk_g = (const float*)d_in[13]; p.diff_qk_g = (const float*)d_in[14]; p.diff_lambda = (const float*)d_in[15];
  p.diff_subln_g = (const float*)d_in[16];
  p.out = (float*)d_out;
  char* w = (char*)d_ws; size_t off = 0;
  auto take = [&](size_t bytes) { char* r = w + off; off += (bytes + 255) & ~(size_t)255; return r; };
  p.u = (bf16_t*)take((size_t)NTOK * UW * 2);
  p.xb = (bf16_t*)take((size_t)NTOK * DM * 2);
  p.wt_in = (bf16_t*)take((size_t)4 * UW * DM * 2);
  p.wt_out = (bf16_t*)take((size_t)4 * DM * MIXW * 2);
  p.wt_mem = (bf16_t*)take((size_t)2048 * DM * 2);
  p.memb = (bf16_t*)take((size_t)4096 * DM * 2);
  p.memkv = (bf16_t*)take((size_t)4096 * 2048 * 2);
  p.rstd = (float*)take((size_t)NTOK * 4 * 2);
  p.rstd_mem = (float*)take(4096 * 4);
  p.tab1c = (float*)take(8192 * 32 * 4); p.tab1s = (float*)take(8192 * 32 * 4);
  p.tabac = (float*)take(128 * 16 * 4); p.tabas = (float*)take(128 * 16 * 4);
  p.lam = (float*)take(256);
  p.bar = (unsigned*)take(XB_WORDS * 4);
  if (off > ws_size) { fprintf(stderr, "workspace too small: need %zu have %zu\n", off, ws_size); return; }
#if MULTI_LAUNCH
  for (int ph = 0; ph < NPHASE; ++ph) {
    p.phase_lo = ph; p.phase_hi = ph + 1;
    hipLaunchKernelGGL(fwd_kernel, dim3(grid_blocks), dim3(NTHREADS), 0, stream, p);
  }
#else
  hipMemsetAsync(p.bar, 0, XB_WORDS * 4, stream);
  p.phase_lo = 0; p.phase_hi = NPHASE; p.probe = PROBE_ODD | (PROBE_EVEN << 1) | (PROBE_GIN << 2);
  void* args[] = {&p};
  hipError_t e = hipLaunchCooperativeKernel((void*)fwd_kernel, dim3(grid_blocks), dim3(NTHREADS), args, 0, stream);
  if (e != hipSuccess) fprintf(stderr, "cooperative launch failed: %s (grid %d)\n", hipGetErrorString(e), grid_blocks);
#endif
}
```
